# Optimizing an MI355X kernel written in HIP

```python
import jax, jax.numpy as jnp
from jax import lax
import numpy as np

D_MODEL = 1024
BATCH = 8
SEQ = 2048
DEPTH = 1

EPS = 1e-6
DN_HEADS = 8
DN_DK = 128
DN_DV = 128
DN_QK_WIDTH = DN_HEADS * DN_DK
DN_WIDTH = DN_HEADS * DN_DV
CONV_K = 4
CHUNK = 64
DIL_CONFIGS = ((128, 1), (512, 4), (2048, 16))
HEADS_PER_GROUP = 4
ATTN_HEADS = HEADS_PER_GROUP * len(DIL_CONFIGS)
ATTN_HEAD_DIM = 64
ATTN_WIDTH = ATTN_HEADS * ATTN_HEAD_DIM
ATTN_BLOCK = 128
IN_SPLITS = (DN_QK_WIDTH, DN_QK_WIDTH, DN_WIDTH, DN_WIDTH, DN_HEADS, DN_HEADS,
             ATTN_WIDTH, ATTN_WIDTH, ATTN_WIDTH, ATTN_WIDTH, D_MODEL, D_MODEL)
N_IN = sum(IN_SPLITS)

kernel_name = "hybrid_gated_deltanet_dilated_attn_block"


def rms_norm(x, w):
    xf = x.astype(jnp.float32)
    y = xf * lax.rsqrt(jnp.mean(xf * xf, axis=-1, keepdims=True) + EPS)
    return (y * w.astype(jnp.float32)).astype(x.dtype)


def l2_normalize(x):
    xf = x.astype(jnp.float32)
    return xf * lax.rsqrt(jnp.sum(xf * xf, axis=-1, keepdims=True) + EPS)


def causal_dwconv_silu(x, w):
    k_w = w.shape[0]
    s = x.shape[1]
    xp = jnp.pad(x, ((0, 0), (k_w - 1, 0), (0, 0)))
    y = sum(xp[:, j:j + s] * w[j] for j in range(k_w))
    return jax.nn.silu(y)


def gated_delta_rule(q, k, v, g, beta):
    b, s, h, dk = q.shape
    n = s // CHUNK

    def to_chunks(t):
        return jnp.moveaxis(t.reshape((b, n, CHUNK) + t.shape[2:]), 3, 2)

    q, k, v, g, beta = map(to_chunks, (q * dk ** -0.5, k, v, g, beta))
    gc = jnp.cumsum(g, axis=-1)
    causal = jnp.tril(jnp.ones((CHUNK, CHUNK), dtype=bool))
    strict = jnp.tril(jnp.ones((CHUNK, CHUNK), dtype=bool), -1)
    decay = jnp.exp(jnp.where(causal, gc[..., :, None] - gc[..., None, :], -jnp.inf))
    k_beta = k * beta[..., None]
    v_beta = v * beta[..., None]
    lmat = jnp.where(strict, jnp.einsum('bnhcd,bnhed->bnhce', k_beta, k) * decay, 0.0)
    eye = jnp.eye(CHUNK, dtype=jnp.float32)
    t_inv = lax.linalg.triangular_solve(eye + lmat, jnp.broadcast_to(eye, lmat.shape),
                                        left_side=True, lower=True, unit_diagonal=True)
    u = jnp.einsum('bnhce,bnhed->bnhcd', t_inv, v_beta)
    w = jnp.einsum('bnhce,bnhed->bnhcd', t_inv, k_beta * jnp.exp(gc)[..., None])
    a_qk = jnp.einsum('bnhcd,bnhed->bnhce', q, k) * decay
    q_dec = q * jnp.exp(gc)[..., None]
    k_dec = k * jnp.exp(gc[..., -1:] - gc)[..., None]
    g_last = jnp.exp(gc[..., -1])

    def step(state, xs):
        q_c, k_c, u_c, w_c, a_c, gl = xs
        v_new = u_c - jnp.einsum('bhcd,bhde->bhce', w_c, state)
        o_c = jnp.einsum('bhcd,bhde->bhce', q_c, state) + jnp.einsum('bhce,bhed->bhcd', a_c, v_new)
        state = state * gl[..., None, None] + jnp.einsum('bhcd,bhce->bhde', k_c, v_new)
        return state, o_c

    xs = tuple(jnp.moveaxis(t, 1, 0) for t in (q_dec, k_dec, u, w, a_qk, g_last))
    state0 = jnp.zeros((b, h, dk, v.shape[-1]), jnp.float32)
    _, o = lax.scan(step, state0, xs)
    o = jnp.moveaxis(jnp.moveaxis(o, 0, 1), 2, 3)
    return o.reshape(b, s, h, -1)


def dilated_window_attention(q, k, v, window, dilation):
    b, s, h, dh = q.shape
    n_back = window // dilation
    sub_len = s // dilation
    nb = -(-sub_len // ATTN_BLOCK)
    lp = nb * ATTN_BLOCK
    bb = b * dilation

    def to_sub(t):
        t = t.reshape(b, sub_len, dilation, h, dh).transpose(0, 2, 1, 3, 4).reshape(bb, sub_len, h, dh)
        return jnp.pad(t, ((0, 0), (0, lp - sub_len), (0, 0), (0, 0)))

    def band(t):
        tp = jnp.pad(t, ((0, 0), (ATTN_BLOCK, 0), (0, 0), (0, 0))).reshape(bb, nb + 1, ATTN_BLOCK, h, dh)
        return jnp.concatenate([tp[:, :-1], tp[:, 1:]], axis=2)

    qb = to_sub(q).reshape(bb, nb, ATTN_BLOCK, h, dh)
    kb = band(to_sub(k))
    vb = band(to_sub(v))
    scores = jnp.einsum('bnqhd,bnkhd->bnhqk', qb, kb,
                        preferred_element_type=jnp.float32) * (dh ** -0.5)
    blk = jnp.arange(nb)[:, None, None]
    qpos = blk * ATTN_BLOCK + jnp.arange(ATTN_BLOCK)[None, :, None]
    kpos = (blk - 1) * ATTN_BLOCK + jnp.arange(2 * ATTN_BLOCK)[None, None, :]
    dist = qpos - kpos
    mask = (dist >= 0) & (dist <= n_back) & (kpos >= 0)
    scores = jnp.where(mask[None, :, None], scores, -jnp.inf)
    m = jnp.max(scores, axis=-1, keepdims=True)
    p = jnp.exp(scores - m)
    denom = jnp.sum(p, axis=-1, keepdims=True)
    o = jnp.einsum('bnhqk,bnkhd->bnqhd', (p / denom).astype(v.dtype), vb)
    lse = (m + jnp.log(denom))[..., 0]
    o = o.reshape(bb, lp, h, dh)[:, :sub_len]
    o = o.reshape(b, dilation, sub_len, h, dh).transpose(0, 2, 1, 3, 4).reshape(b, s, h, dh)
    lse = lse.transpose(0, 1, 3, 2).reshape(bb, lp, h)[:, :sub_len]
    lse = lse.reshape(b, dilation, sub_len, h).transpose(0, 2, 1, 3).reshape(b, s, h)
    return o, lse


def setup_inputs(seed: int = 0) -> dict:
    key = jax.random.key(seed)
    ks = jax.random.split(key, 16)
    f32 = jnp.float32
    d = D_MODEL
    x = jax.random.normal(ks[0], (BATCH, SEQ, d), f32)
    c = jax.random.normal(ks[1], (BATCH, d), f32)
    norm_w = 1.0 + 0.02 * jax.random.normal(ks[2], (DEPTH, d), f32)
    ada_w = jax.random.normal(ks[3], (DEPTH, d, 3 * d), f32) * d ** -0.5
    ada_b = 0.01 * jax.random.normal(ks[4], (DEPTH, 3 * d), f32)
    w_in = jax.random.normal(ks[5], (DEPTH, d, N_IN), f32) * d ** -0.5
    conv_w = jax.random.normal(ks[6], (DEPTH, CONV_K, 2 * DN_QK_WIDTH + DN_WIDTH), f32) * CONV_K ** -0.5
    a_log = jnp.log(jax.random.uniform(ks[7], (DEPTH, DN_HEADS), f32, 1.0, 16.0))
    dt = jnp.exp(jax.random.uniform(ks[8], (DEPTH, DN_HEADS), f32, np.log(1e-3), np.log(1e-1)))
    dt_bias = dt + jnp.log(-jnp.expm1(-dt))
    dn_norm_w = 1.0 + 0.02 * jax.random.normal(ks[9], (DEPTH, DN_DV), f32)
    w_proj_a = jax.random.normal(ks[10], (DEPTH, DN_WIDTH, d), f32) * DN_WIDTH ** -0.5
    w_proj_b = jax.random.normal(ks[11], (DEPTH, ATTN_WIDTH, d), f32) * ATTN_WIDTH ** -0.5
    w_out = jax.random.normal(ks[12], (DEPTH, d, d), f32) * d ** -0.5
    final_norm_w = 1.0 + 0.02 * jax.random.normal(ks[13], (d,), f32)
    return {"x": x, "c": c, "norm_w": norm_w, "ada_w": ada_w, "ada_b": ada_b, "w_in": w_in,
            "conv_w": conv_w, "a_log": a_log, "dt_bias": dt_bias, "dn_norm_w": dn_norm_w,
            "w_proj_a": w_proj_a, "w_proj_b": w_proj_b, "w_out": w_out, "final_norm_w": final_norm_w}


def reference(x, c, norm_w, ada_w, ada_b, w_in, conv_w, a_log, dt_bias, dn_norm_w,
              w_proj_a, w_proj_b, w_out, final_norm_w):
    b, s, _ = x.shape
    split_points = [int(p) for p in np.cumsum(IN_SPLITS)[:-1]]
    for l in range(DEPTH):
        mod = jax.nn.silu(c) @ ada_w[l] + ada_b[l]
        shift, scale, gate = jnp.split(mod, 3, axis=-1)
        h = rms_norm(x, norm_w[l]) * (1.0 + scale[:, None]) + shift[:, None]
        proj = h @ w_in[l]
        (qa, ka, va, za, beta_in, a_in, qb, kb, vb, zb, ga, gb) = jnp.split(proj, split_points, axis=-1)

        qkv = causal_dwconv_silu(jnp.concatenate([qa, ka, va], axis=-1), conv_w[l])
        qa, ka, va = jnp.split(qkv, [DN_QK_WIDTH, 2 * DN_QK_WIDTH], axis=-1)
        q_dn = l2_normalize(qa.reshape(b, s, DN_HEADS, DN_DK))
        k_dn = l2_normalize(ka.reshape(b, s, DN_HEADS, DN_DK))
        v_dn = va.reshape(b, s, DN_HEADS, DN_DV).astype(jnp.float32)
        beta = jax.nn.sigmoid(beta_in.astype(jnp.float32))
        g = -jnp.exp(a_log[l].astype(jnp.float32)) * jax.nn.softplus(
            a_in.astype(jnp.float32) + dt_bias[l].astype(jnp.float32))
        o_a = gated_delta_rule(q_dn, k_dn, v_dn, g, beta).astype(x.dtype)
        y_a = rms_norm(o_a, dn_norm_w[l]).reshape(b, s, DN_WIDTH) * jax.nn.silu(za)
        y_a = y_a @ w_proj_a[l]

        qb = qb.reshape(b, s, ATTN_HEADS, ATTN_HEAD_DIM)
        kb = kb.reshape(b, s, ATTN_HEADS, ATTN_HEAD_DIM)
        vb = vb.reshape(b, s, ATTN_HEADS, ATTN_HEAD_DIM)
        outs, lses = [], []
        for gi, (win, dil) in enumerate(DIL_CONFIGS):
            hs = slice(gi * HEADS_PER_GROUP, (gi + 1) * HEADS_PER_GROUP)
            o_g, lse_g = dilated_window_attention(qb[:, :, hs], kb[:, :, hs], vb[:, :, hs], win, dil)
            outs.append(o_g)
            lses.append(lse_g)
        o_b = jnp.stack(outs, axis=2)
        w_g = jax.nn.softmax(jnp.stack(lses, axis=2), axis=2)
        y_b = (o_b * w_g[..., None].astype(o_b.dtype)).reshape(b, s, ATTN_WIDTH) * jax.nn.silu(zb)
        y_b = y_b @ w_proj_b[l]

        merged = jax.nn.sigmoid(ga) * y_a + jax.nn.sigmoid(gb) * y_b
        x = x + gate[:, None] * (merged @ w_out[l])
    return rms_norm(x, final_norm_w)
```

```cpp
#include <hip/hip_runtime.h>
#include <hip/hip_cooperative_groups.h>
#include <cstdio>
namespace cg = cooperative_groups;

#define LAS __attribute__((address_space(3)))
typedef unsigned short bf16_t;
typedef short bf16x8 __attribute__((ext_vector_type(8)));
typedef float f32x4 __attribute__((ext_vector_type(4)));
typedef float f32x2 __attribute__((ext_vector_type(2)));
typedef unsigned u32x4 __attribute__((ext_vector_type(4)));
typedef unsigned u32x2 __attribute__((ext_vector_type(2)));
typedef __bf16 bf2_t __attribute__((ext_vector_type(2)));
#define DI __device__ __forceinline__

constexpr int D = 1024, NB = 8, SEQ = 2048, MTOK = NB * SEQ;
constexpr int N_IN = 9232;
constexpr float EPS = 1e-6f;
constexpr size_t MiB = 1048576;
constexpr size_t WS_WT_IN = 0;
constexpr size_t WS_WT_PA = 18 * MiB;
constexpr size_t WS_WT_PB = 20 * MiB;
constexpr size_t WS_WT_O  = 21 * MiB + 512 * 1024;
constexpr size_t WS_MOD   = 23 * MiB + 512 * 1024;
constexpr size_t WS_BETA  = WS_MOD + 128 * 1024;
constexpr size_t WS_G     = WS_BETA + 512 * 1024;
constexpr size_t WS_GL    = WS_G + 512 * 1024;
constexpr size_t WS_BAR   = WS_GL + 64 * 1024;
constexpr size_t WS_LSE   = 24 * MiB + 768 * 1024;
static_assert(WS_BAR + 4096 <= WS_LSE && WS_LSE + 768 * 1024 <= 26 * MiB, "ws map");
constexpr size_t WS_H     = 26 * MiB;
constexpr size_t WS_R1    = 58 * MiB;
constexpr size_t WS_OB    = WS_R1 + 72 * MiB;
constexpr size_t WS_R2    = 154 * MiB;
constexpr size_t WS_QD    = WS_R2;
constexpr size_t WS_KDT   = WS_R2 + 32 * MiB;
constexpr size_t WS_AG    = WS_R2 + 64 * MiB;
constexpr size_t WS_MODP  = 234 * MiB;
constexpr size_t WS_RS    = 25 * MiB + 512 * 1024;
constexpr size_t WS_ZB    = 218 * MiB;
constexpr size_t WS_YA    = WS_R1;
constexpr size_t WS_END   = 235 * MiB;
constexpr int LDS_BYTES = 138240 + 16;

struct Params {
    const float *x, *c, *norm_w, *ada_w, *ada_b, *w_in, *conv_w, *a_log, *dt_bias, *dn_norm_w, *w_pa, *w_pb, *w_out, *fnw;
    float* out; unsigned char* ws;
};

DI unsigned pk_bf16(float lo, float hi) { f32x2 v = {lo, hi}; bf2_t b = __builtin_convertvector(v, bf2_t); return __builtin_bit_cast(unsigned, b); }
DI bf16_t f2bf(float x) { return (bf16_t)(pk_bf16(x, 0.f) & 0xffffu); }
DI float bf2f(bf16_t b) { return __uint_as_float(((unsigned)b) << 16); }
DI float bflo(unsigned u) { return __uint_as_float(u << 16); }
DI float bfhi(unsigned u) { return __uint_as_float(u & 0xffff0000u); }
DI float sigmoidf_(float v) { return __builtin_amdgcn_rcpf(1.f + __builtin_amdgcn_exp2f(v * -1.4426950408889634f)); }
DI float siluf_(float v) { return v * __builtin_amdgcn_rcpf(1.f + __builtin_amdgcn_exp2f(v * -1.4426950408889634f)); }
template <int CTRL> DI float dpp_f(float v) { return __builtin_bit_cast(float, __builtin_amdgcn_update_dpp(0, __builtin_bit_cast(int, v), CTRL, 0xf, 0xf, false)); }
DI float wave_sum(float v) {
    v += dpp_f<0x128>(v); v += dpp_f<0x124>(v); v += dpp_f<0x122>(v); v += dpp_f<0x121>(v);
    const int iv = __builtin_bit_cast(int, v);
    return __builtin_bit_cast(float, __builtin_amdgcn_readlane(iv, 0)) + __builtin_bit_cast(float, __builtin_amdgcn_readlane(iv, 16))
         + __builtin_bit_cast(float, __builtin_amdgcn_readlane(iv, 32)) + __builtin_bit_cast(float, __builtin_amdgcn_readlane(iv, 48));
}
DI void reduce8(const float (&p)[8], float (&tot)[8], int lane) {
    const bool b5 = (lane & 32) != 0, b4 = (lane & 16) != 0, b3 = (lane & 8) != 0;
    float q[4], r2[2];
#pragma unroll
    for (int e = 0; e < 4; ++e) { const float send = b5 ? p[e] : p[e + 4], keep = b5 ? p[e + 4] : p[e]; q[e] = keep + __shfl_xor(send, 32); }
#pragma unroll
    for (int e = 0; e < 2; ++e) { const float send = b4 ? q[e] : q[e + 2], keep = b4 ? q[e + 2] : q[e]; r2[e] = keep + __shfl_xor(send, 16); }
    const float send = b3 ? r2[0] : r2[1], keep = b3 ? r2[1] : r2[0];
    float s = keep + dpp_f<0x128>(send);
    s += dpp_f<0xB1>(s);
    s += dpp_f<0x4E>(s);
    s += dpp_f<0x141>(s);
    const int iv = __builtin_bit_cast(int, s);
#pragma unroll
    for (int e = 0; e < 8; ++e) tot[e] = __builtin_bit_cast(float, __builtin_amdgcn_readlane(iv, 8 * e));
}
DI bf16x8 pack8(const f32x4& a, const f32x4& b) {
    u32x4 p; p[0] = pk_bf16(a[0], a[1]); p[1] = pk_bf16(a[2], a[3]); p[2] = pk_bf16(b[0], b[1]); p[3] = pk_bf16(b[2], b[3]);
    return __builtin_bit_cast(bf16x8, p);
}

#define XB_TMO      128
#define XB_XCNT(j)  (256  + 64 * (j))
#define XB_XSUB(j)  (1280 + 64 * (j))
#define XB_XGEN(j)  (2304 + 64 * (j))
#define XB_TOP      3328
#define XB_TOPGEN   3392
#define XCD_BAR_WORDS 3456
#define XB_SPIN_CAP (1u << 18)
DI unsigned xb_ld(unsigned* p)              { return __hip_atomic_load(p, __ATOMIC_RELAXED, __HIP_MEMORY_SCOPE_AGENT); }
DI unsigned xb_add(unsigned* p, unsigned v) { return __hip_atomic_fetch_add(p, v, __ATOMIC_RELAXED, __HIP_MEMORY_SCOPE_AGENT); }
DI unsigned xb_xcc_id() { return (unsigned)__builtin_amdgcn_s_getreg((3 << 11) | 20) & 0xFu; }
#define XB_SPIN(cond, bar) do { unsigned _sp = 0; while (cond) { __builtin_amdgcn_s_sleep(1); \
    if ((++_sp & 255u) == 0u) { if (xb_ld(&(bar)[XB_TMO])) break; if (_sp > XB_SPIN_CAP) { atomicAdd(&(bar)[XB_TMO], 1u); break; } } } } while (0)
struct XcdBarrier { unsigned* bar; unsigned x; volatile LAS unsigned* st; unsigned total; };
DI XcdBarrier xcd_barrier_post(unsigned* bar, volatile LAS unsigned* st, unsigned total) {
    XcdBarrier b; b.bar = bar; b.x = xb_xcc_id(); b.st = st; b.total = total;
    if (threadIdx.x == 0) (void)xb_add(&bar[XB_XCNT(b.x)], 1u);
    return b;
}
DI void xcd_barrier_complete(unsigned* bar, unsigned x, unsigned G, unsigned& nloc, unsigned& nx) {
    unsigned sum, cnt, mine, sp = 0u;
    for (;;) {
        sum = 0u; cnt = 0u; mine = 0u;
#pragma unroll
        for (unsigned j = 0; j < 16; ++j) { const unsigned c = xb_ld(&bar[XB_XCNT(j)]); sum += c; cnt += (c > 0u) ? 1u : 0u; mine = (j == x) ? c : mine; }
        if (sum == G) break;
        __builtin_amdgcn_s_sleep(1);
        if ((++sp & 255u) == 0u) { if (xb_ld(&bar[XB_TMO])) break; if (sp > XB_SPIN_CAP) { atomicAdd(&bar[XB_TMO], 1u); break; } }
    }
    nloc = mine > 0u ? mine : 1u; nx = cnt > 0u ? cnt : 1u;
}
DI void xcd_barrier(const XcdBarrier& b) {
    asm volatile("s_waitcnt vmcnt(0)" ::: "memory");
    __syncthreads();
    if (threadIdx.x == 0) {
        unsigned* bar = b.bar;
        __builtin_amdgcn_s_waitcnt(0);
        unsigned nloc = b.st[0], nx = b.st[1];
        if (nloc == 0u) { xcd_barrier_complete(bar, b.x, b.total, nloc, nx); b.st[0] = nloc; b.st[1] = nx; }
        const unsigned old = xb_add(&bar[XB_XSUB(b.x)], 1u);
        const unsigned gen = old / nloc;
        if (old + 1u == (gen + 1u) * nloc) {
            __builtin_amdgcn_fence(__ATOMIC_RELEASE, "agent");
            asm volatile("s_waitcnt vmcnt(0)" ::: "memory");
            const unsigned og = xb_add(&bar[XB_TOP], 1u);
            const unsigned tg = og / nx;
            if (og + 1u == (tg + 1u) * nx) xb_add(&bar[XB_TOPGEN], 1u);
            else XB_SPIN(xb_ld(&bar[XB_TOPGEN]) == tg, bar);
            __builtin_amdgcn_fence(__ATOMIC_ACQUIRE, "agent");
            xb_add(&bar[XB_XGEN(b.x)], 1u);
            asm volatile("s_waitcnt vmcnt(0)" ::: "memory");
        } else {
            XB_SPIN(xb_ld(&bar[XB_XGEN(b.x)]) == gen, bar);
            __builtin_amdgcn_fence(__ATOMIC_ACQUIRE, "agent");
            asm volatile("s_waitcnt vmcnt(0)" ::: "memory");
        }
    }
    __syncthreads();
}
DI void subset_barrier(unsigned* ctr, unsigned nblk) {
    asm volatile("s_waitcnt vmcnt(0)" ::: "memory");
    __syncthreads();
    if (threadIdx.x == 0) {
        __builtin_amdgcn_fence(__ATOMIC_RELEASE, "agent");
        asm volatile("s_waitcnt vmcnt(0)" ::: "memory");
        __hip_atomic_fetch_add(ctr, 1u, __ATOMIC_RELAXED, __HIP_MEMORY_SCOPE_AGENT);
        unsigned sp = 0;
        while (__hip_atomic_load(ctr, __ATOMIC_RELAXED, __HIP_MEMORY_SCOPE_AGENT) < nblk) { __builtin_amdgcn_s_sleep(2); if (++sp > (1u << 24)) break; }
        __builtin_amdgcn_fence(__ATOMIC_ACQUIRE, "agent");
        asm volatile("s_waitcnt vmcnt(0)" ::: "memory");
    }
    __syncthreads();
}
DI void panel_post_xcc(unsigned* w) {
    if (threadIdx.x == 0) { __hip_atomic_fetch_add(w, 1u << (3u * (xb_xcc_id() & 7u)), __ATOMIC_RELAXED, __HIP_MEMORY_SCOPE_AGENT); __hip_atomic_fetch_add(w + 16, 1u, __ATOMIC_RELAXED, __HIP_MEMORY_SCOPE_AGENT); }
}
DI void panel_handoff(unsigned* w) {
    asm volatile("s_waitcnt vmcnt(0)" ::: "memory");
    __syncthreads();
    if (threadIdx.x == 0) {
        unsigned sp = 0;
        while (__hip_atomic_load(w + 16, __ATOMIC_RELAXED, __HIP_MEMORY_SCOPE_AGENT) < 4u) { __builtin_amdgcn_s_sleep(1); if (++sp > (1u << 24)) break; }
        const bool same = __hip_atomic_load(w, __ATOMIC_RELAXED, __HIP_MEMORY_SCOPE_AGENT) == (4u << (3u * (xb_xcc_id() & 7u)));
        if (!same) { __builtin_amdgcn_fence(__ATOMIC_RELEASE, "agent"); asm volatile("s_waitcnt vmcnt(0)" ::: "memory"); }
        __hip_atomic_fetch_add(w + 32, 1u, __ATOMIC_RELAXED, __HIP_MEMORY_SCOPE_AGENT);
        sp = 0;
        while (__hip_atomic_load(w + 32, __ATOMIC_RELAXED, __HIP_MEMORY_SCOPE_AGENT) < 4u) { __builtin_amdgcn_s_sleep(1); if (++sp > (1u << 24)) break; }
        if (!same) { __builtin_amdgcn_fence(__ATOMIC_ACQUIRE, "agent"); asm volatile("s_waitcnt vmcnt(0)" ::: "memory"); }
    }
    __syncthreads();
}
#define MFMA16(a, b, c) __builtin_amdgcn_mfma_f32_16x16x32_bf16((a), (b), (c), 0, 0, 0)

namespace pg8 {
constexpr int BM = 256, BK = 64, HALF = 128, HTB = HALF * BK * 2, STAGE_BYTES = 8 * HTB, NXCD = 8, WGM = 8;
DI int lds_byte(int r, int c) { const int st = (r >> 4) * 2 + (c >> 5), rr = r & 15, cc = c & 31, ob = rr * 64 + cc * 2; return st * 1024 + (ob ^ (((ob >> 9) & 1) << 5)); }
DI void stage_rc(int b, int& R, int& C) { const int st = b / 1024, sb = b % 1024, swz = sb ^ (((sb >> 9) & 1) << 5); R = (st >> 1) * 16 + swz / 64; C = (st & 1) * 32 + (swz % 64) / 2; }
DI int perm32(int rho) { const int n = rho >> 4, i = rho & 15; return 8 * (i >> 2) + 4 * n + (i & 3); }
struct Unit { int pm, pn; };
struct Gemm { const bf16_t* A; const bf16_t* Bt; int M, N, K; };
struct StaticOrder {
    int nM, nN, nwg, G, c;
    DI void init(int M, int N, int G_, int c_) { nM = M / BM; nN = N / BM; nwg = nM * nN; G = G_; c = c_; }
    DI bool next(int i, Unit& u) const {
        const long L = (long)i * G + c; if (L >= nwg) return false;
        int wgid = (int)L; { const int q = nwg / NXCD, r = nwg % NXCD, xcd = wgid % NXCD, off = wgid / NXCD; wgid = (xcd < r ? xcd * (q + 1) : r * (q + 1) + (xcd - r) * q) + off; }
        const int nig = WGM * nN, gid = wgid / nig, fm = gid * WGM, gsz = (nM - fm) < WGM ? (nM - fm) : WGM;
        u.pm = fm + ((wgid % nig) % gsz); u.pn = (wgid % nig) / gsz; return true;
    }
};

template <class Epi, bool ALIGN_EPI = false>
DI void gemm_phase(LAS unsigned char* lds, const Gemm g, const StaticOrder& S, const Epi& E) {
    int tid = threadIdx.x; asm volatile("" : "+v"(tid));
    const int wid = __builtin_amdgcn_readfirstlane(tid >> 6), lane = tid & 63, wr = wid >> 2, wc = wid & 3, fr = lane & 15, fq = lane >> 4;
    const int K = g.K, nt = K / BK;
    unsigned voffA[2], voffB[2];
#pragma unroll
    for (int i = 0; i < 2; ++i) { int R, C; stage_rc(tid * 16 + i * 8192, R, C); const int Rb = Epi::PERM ? ((R & ~31) + perm32(R & 31)) : R;
        voffA[i] = (unsigned)(R * K + C) * 2u; voffB[i] = (unsigned)(Rb * K + C) * 2u; }
    const size_t kstep = (size_t)(BK * 2);
    const size_t hstep = (size_t)HALF * K * 2;
    const size_t tstep = 2 * hstep;
    const unsigned ldsw = (unsigned)wid * 1024u;
    const int aoff = lds_byte(wr * 64 + fr, fq * 8), boff = lds_byte(wc * 32 + fr, fq * 8);
#define PG8_SA(b, h) (((b) * 2 + (h)) * HTB)
#define PG8_SB(b, h) ((4 + (b) * 2 + (h)) * HTB)
#define PG8_STAGE(bufoff, gbase, voff) do { _Pragma("unroll") for (int _i = 0; _i < 2; ++_i) \
        __builtin_amdgcn_global_load_lds((const unsigned*)((const char*)(gbase) + (voff)[_i]), (LAS unsigned*)(lds + (bufoff) + ldsw + _i * 8192), 16, 0, 0); } while (0)
#define PG8_LDA(dst, b, h) do { _Pragma("unroll") for (int m = 0; m < 4; ++m) _Pragma("unroll") for (int k = 0; k < 2; ++k) dst[m][k] = *(const LAS bf16x8*)(lds + PG8_SA(b, h) + aoff + m * 2048 + k * 1024); } while (0)
#define PG8_LDB(dst, b, h) do { _Pragma("unroll") for (int n = 0; n < 2; ++n) _Pragma("unroll") for (int k = 0; k < 2; ++k) dst[n][k] = *(const LAS bf16x8*)(lds + PG8_SB(b, h) + boff + n * 2048 + k * 1024); } while (0)
#define PG8_MMA(ai, bj, At, Bt) do { __builtin_amdgcn_s_setprio(1); _Pragma("unroll") for (int m = 0; m < 4; ++m) _Pragma("unroll") for (int n = 0; n < 2; ++n) _Pragma("unroll") for (int k = 0; k < 2; ++k) \
        acc[ai][bj][m][n] = __builtin_amdgcn_mfma_f32_16x16x32_bf16(Bt[n][k], At[m][k], acc[ai][bj][m][n], 0, 0, 0); __builtin_amdgcn_s_setprio(0); } while (0)
#define PG8_WAIT_V(n) asm volatile("s_waitcnt vmcnt(" #n ")" ::: "memory")
#define PG8_WAIT_L(n) asm volatile("s_waitcnt lgkmcnt(" #n ")" ::: "memory")
#define PG8_BAR __builtin_amdgcn_s_barrier()
#define PG8_SCHED __builtin_amdgcn_sched_barrier(0)
    Unit cur, nxt; int ui = 0;
    if (!S.next(0, cur)) return;
    f32x4 acc[2][2][4][2];
#pragma unroll
    for (int a = 0; a < 2; ++a)
#pragma unroll
        for (int b = 0; b < 2; ++b)
#pragma unroll
            for (int m = 0; m < 4; ++m)
#pragma unroll
                for (int n = 0; n < 2; ++n) acc[a][b][m][n] = (f32x4){0.f, 0.f, 0.f, 0.f};
    bf16x8 At[4][2], B0[2][2], B1[2][2];
    const char* cA = (const char*)g.A + (size_t)cur.pm * tstep; const char* cB = (const char*)g.Bt + (size_t)cur.pn * tstep;
    PG8_STAGE(PG8_SB(0, 0), cB, voffB); PG8_STAGE(PG8_SB(0, 1), cB + hstep, voffB); PG8_STAGE(PG8_SA(0, 0), cA, voffA); PG8_STAGE(PG8_SA(0, 1), cA + hstep, voffA);
    if (wr == 1) PG8_BAR;
    PG8_WAIT_V(2); PG8_BAR;
    PG8_STAGE(PG8_SB(1, 0), cB + kstep, voffB); PG8_STAGE(PG8_SA(1, 0), cA + kstep, voffA); PG8_STAGE(PG8_SB(1, 1), cB + hstep + kstep, voffB);
    PG8_WAIT_V(6); PG8_BAR;
    for (;;) {
        const bool has_next = S.next(ui + 1, nxt);
        const char* nA = has_next ? (const char*)g.A + (size_t)nxt.pm * tstep : cA; const char* nB = has_next ? (const char*)g.Bt + (size_t)nxt.pn * tstep : cB;
        for (int t = 0; t < nt; t += 2) {
            const bool last = (t == nt - 2);
            const char* a1 = cA + (size_t)(t + 1) * kstep;
            const char* a2 = last ? nA : cA + (size_t)(t + 2) * kstep; const char* b2 = last ? nB : cB + (size_t)(t + 2) * kstep;
            const char* a3 = a2 + kstep; const char* b3 = b2 + kstep;
            PG8_LDB(B0, 0, 0); PG8_LDB(B1, 0, 1); PG8_SCHED; PG8_LDA(At, 0, 0); PG8_STAGE(PG8_SA(1, 1), a1 + hstep, voffA);
            PG8_WAIT_V(8); PG8_WAIT_L(0); PG8_BAR; PG8_MMA(0, 0, At, B0); PG8_MMA(0, 1, At, B1); PG8_BAR; PG8_SCHED;
            PG8_LDA(At, 0, 1); PG8_STAGE(PG8_SB(0, 0), b2, voffB); PG8_STAGE(PG8_SB(0, 1), b2 + hstep, voffB); PG8_STAGE(PG8_SA(0, 0), a2, voffA);
            PG8_WAIT_V(8); PG8_WAIT_L(0); PG8_BAR; PG8_MMA(1, 0, At, B0); PG8_MMA(1, 1, At, B1); PG8_BAR; PG8_SCHED;
            PG8_LDB(B0, 1, 0); PG8_LDB(B1, 1, 1); PG8_SCHED; PG8_LDA(At, 1, 0); PG8_STAGE(PG8_SA(0, 1), a2 + hstep, voffA);
            PG8_WAIT_V(8); PG8_WAIT_L(0); PG8_BAR; PG8_MMA(0, 0, At, B0); PG8_MMA(0, 1, At, B1); PG8_BAR; PG8_SCHED;
            PG8_LDA(At, 1, 1); PG8_STAGE(PG8_SB(1, 0), b3, voffB); PG8_STAGE(PG8_SB(1, 1), b3 + hstep, voffB); PG8_STAGE(PG8_SA(1, 0), a3, voffA);
            PG8_WAIT_V(8); PG8_WAIT_L(0); PG8_BAR; PG8_MMA(1, 0, At, B0); PG8_MMA(1, 1, At, B1); PG8_BAR; PG8_SCHED;
        }
        if constexpr (ALIGN_EPI) { if (wr == 0) PG8_BAR; }
        if constexpr (!Epi::AFTER_DRAIN) E(acc, cur, wr, wc, fr, fq);
        if (!has_next) break;
#pragma unroll
        for (int a = 0; a < 2; ++a)
#pragma unroll
            for (int b = 0; b < 2; ++b)
#pragma unroll
                for (int m = 0; m < 4; ++m)
#pragma unroll
                    for (int n = 0; n < 2; ++n) acc[a][b][m][n] = (f32x4){0.f, 0.f, 0.f, 0.f};
        cur = nxt; cA = nA; cB = nB; ++ui;
        if constexpr (ALIGN_EPI) { if (wr == 1) PG8_BAR; }
    }
    PG8_WAIT_V(0);
    if constexpr (!ALIGN_EPI) { if (wr == 0) PG8_BAR; }
    PG8_BAR;
    if constexpr (Epi::AFTER_DRAIN) E.fused(acc, cur, wr, wc, fr, fq, lds);
#undef PG8_SA
#undef PG8_SB
#undef PG8_STAGE
#undef PG8_LDA
#undef PG8_LDB
#undef PG8_MMA
#undef PG8_WAIT_V
#undef PG8_WAIT_L
#undef PG8_BAR
#undef PG8_SCHED
}

template <class Epi>
DI void gemm_phase2(LAS unsigned char* lds, const Gemm g0, const Gemm g1, const StaticOrder& S, const Epi& E) {
    int tid = threadIdx.x; asm volatile("" : "+v"(tid));
    const int wid = __builtin_amdgcn_readfirstlane(tid >> 6), lane = tid & 63, wr = wid >> 2, wc = wid & 3, fr = lane & 15, fq = lane >> 4;
    unsigned rA[2], rB[2], c2[2];
#pragma unroll
    for (int i = 0; i < 2; ++i) { int R, C; stage_rc(tid * 16 + i * 8192, R, C); const int Rb = Epi::PERM ? ((R & ~31) + perm32(R & 31)) : R;
        rA[i] = (unsigned)R; rB[i] = (unsigned)Rb; c2[i] = (unsigned)C * 2u; }
    const unsigned k20 = (unsigned)g0.K * 2u, k21 = (unsigned)g1.K * 2u;
    const size_t kstep = (size_t)(BK * 2);
    const size_t hs0 = (size_t)HALF * g0.K * 2, hs1 = (size_t)HALF * g1.K * 2;
    const unsigned ldsw = (unsigned)wid * 1024u;
    const int aoff = lds_byte(wr * 64 + fr, fq * 8), boff = lds_byte(wc * 32 + fr, fq * 8);
#define PG8_SA(b, h) (((b) * 2 + (h)) * HTB)
#define PG8_SB(b, h) ((4 + (b) * 2 + (h)) * HTB)
#define PG8_STAGE(bufoff, gbase, rowv, k2) do { _Pragma("unroll") for (int _i = 0; _i < 2; ++_i) \
        __builtin_amdgcn_global_load_lds((const unsigned*)((const char*)(gbase) + ((rowv)[_i] * (k2) + c2[_i])), (LAS unsigned*)(lds + (bufoff) + ldsw + _i * 8192), 16, 0, 0); } while (0)
#define PG8_LDA(dst, b, h) do { _Pragma("unroll") for (int m = 0; m < 4; ++m) _Pragma("unroll") for (int k = 0; k < 2; ++k) dst[m][k] = *(const LAS bf16x8*)(lds + PG8_SA(b, h) + aoff + m * 2048 + k * 1024); } while (0)
#define PG8_LDB(dst, b, h) do { _Pragma("unroll") for (int n = 0; n < 2; ++n) _Pragma("unroll") for (int k = 0; k < 2; ++k) dst[n][k] = *(const LAS bf16x8*)(lds + PG8_SB(b, h) + boff + n * 2048 + k * 1024); } while (0)
#define PG8_MMA(ai, bj, At, Bt) do { __builtin_amdgcn_s_setprio(1); _Pragma("unroll") for (int m = 0; m < 4; ++m) _Pragma("unroll") for (int n = 0; n < 2; ++n) _Pragma("unroll") for (int k = 0; k < 2; ++k) \
        acc[ai][bj][m][n] = __builtin_amdgcn_mfma_f32_16x16x32_bf16(Bt[n][k], At[m][k], acc[ai][bj][m][n], 0, 0, 0); __builtin_amdgcn_s_setprio(0); } while (0)
#define PG8_WAIT_V(n) asm volatile("s_waitcnt vmcnt(" #n ")" ::: "memory")
#define PG8_WAIT_L(n) asm volatile("s_waitcnt lgkmcnt(" #n ")" ::: "memory")
#define PG8_BAR __builtin_amdgcn_s_barrier()
#define PG8_SCHED __builtin_amdgcn_sched_barrier(0)
    Unit cur;
    if (!S.next(0, cur)) return;
    f32x4 acc[2][2][4][2];
#pragma unroll
    for (int a = 0; a < 2; ++a)
#pragma unroll
        for (int b = 0; b < 2; ++b)
#pragma unroll
            for (int m = 0; m < 4; ++m)
#pragma unroll
                for (int n = 0; n < 2; ++n) acc[a][b][m][n] = (f32x4){0.f, 0.f, 0.f, 0.f};
    bf16x8 At[4][2], B0[2][2], B1[2][2];
    const char* cA = (const char*)g0.A + (size_t)cur.pm * 2 * hs0; const char* cB = (const char*)g0.Bt + (size_t)cur.pn * 2 * hs0;
    {   PG8_STAGE(PG8_SB(0, 0), cB, rB, k20); PG8_STAGE(PG8_SB(0, 1), cB + hs0, rB, k20); PG8_STAGE(PG8_SA(0, 0), cA, rA, k20); PG8_STAGE(PG8_SA(0, 1), cA + hs0, rA, k20);
        if (wr == 1) PG8_BAR;
        PG8_WAIT_V(2); PG8_BAR;
        PG8_STAGE(PG8_SB(1, 0), cB + kstep, rB, k20); PG8_STAGE(PG8_SA(1, 0), cA + kstep, rA, k20); PG8_STAGE(PG8_SB(1, 1), cB + hs0 + kstep, rB, k20);
        PG8_WAIT_V(6); PG8_BAR; }
#define PG8_KLOOP(ntc, hsc, k2c, nA, nB, hsn, k2n) \
        for (int t = 0; t < (ntc); t += 2) { \
            const bool last = (t == (ntc) - 2); \
            const char* a1 = cA + (size_t)(t + 1) * kstep; \
            const char* a2 = last ? (nA) : cA + (size_t)(t + 2) * kstep; const char* b2 = last ? (nB) : cB + (size_t)(t + 2) * kstep; \
            const char* a3 = a2 + kstep; const char* b3 = b2 + kstep; \
            const size_t hs2 = last ? (hsn) : (hsc); const unsigned k22 = last ? (k2n) : (k2c); \
            PG8_LDB(B0, 0, 0); PG8_LDB(B1, 0, 1); PG8_SCHED; PG8_LDA(At, 0, 0); PG8_STAGE(PG8_SA(1, 1), a1 + (hsc), rA, (k2c)); \
            PG8_WAIT_V(8); PG8_WAIT_L(0); PG8_BAR; PG8_MMA(0, 0, At, B0); PG8_MMA(0, 1, At, B1); PG8_BAR; PG8_SCHED; \
            PG8_LDA(At, 0, 1); PG8_STAGE(PG8_SB(0, 0), b2, rB, k22); PG8_STAGE(PG8_SB(0, 1), b2 + hs2, rB, k22); PG8_STAGE(PG8_SA(0, 0), a2, rA, k22); \
            PG8_WAIT_V(8); PG8_WAIT_L(0); PG8_BAR; PG8_MMA(1, 0, At, B0); PG8_MMA(1, 1, At, B1); PG8_BAR; PG8_SCHED; \
            PG8_LDB(B0, 1, 0); PG8_LDB(B1, 1, 1); PG8_SCHED; PG8_LDA(At, 1, 0); PG8_STAGE(PG8_SA(0, 1), a2 + hs2, rA, k22); \
            PG8_WAIT_V(8); PG8_WAIT_L(0); PG8_BAR; PG8_MMA(0, 0, At, B0); PG8_MMA(0, 1, At, B1); PG8_BAR; PG8_SCHED; \
            PG8_LDA(At, 1, 1); PG8_STAGE(PG8_SB(1, 0), b3, rB, k22); PG8_STAGE(PG8_SB(1, 1), b3 + hs2, rB, k22); PG8_STAGE(PG8_SA(1, 0), a3, rA, k22); \
            PG8_WAIT_V(8); PG8_WAIT_L(0); PG8_BAR; PG8_MMA(1, 0, At, B0); PG8_MMA(1, 1, At, B1); PG8_BAR; PG8_SCHED; \
        }
    const int nt0 = g0.K / BK, nt1 = g1.K / BK;
    {
        const char* pA1 = (const char*)g1.A + (size_t)cur.pm * 2 * hs1; const char* pB1 = (const char*)g1.Bt + (size_t)cur.pn * 2 * hs1;
        PG8_KLOOP(nt0, hs0, k20, pA1, pB1, hs1, k21)
        E.mid(acc, cur, wr, wc, fr, fq);
        cA = pA1; cB = pB1;
        PG8_KLOOP(nt1, hs1, k21, cA, cB, hs1, k21)
        E(acc, cur, wr, wc, fr, fq);
    }
#undef PG8_KLOOP
    PG8_WAIT_V(0);
    if (wr == 0) PG8_BAR;
    PG8_BAR;
#undef PG8_SA
#undef PG8_SB
#undef PG8_STAGE
#undef PG8_LDA
#undef PG8_LDB
#undef PG8_MMA
#undef PG8_WAIT_V
#undef PG8_WAIT_L
#undef PG8_BAR
#undef PG8_SCHED
}

template <int ACT> DI void epi_store8(bf16_t* dstp, f32x4 v0, f32x4 v1) {
    if (ACT == 1) {
#pragma unroll
        for (int e = 0; e < 4; ++e) { v0[e] = siluf_(v0[e]); v1[e] = siluf_(v1[e]); }
    } else if (ACT == 2) {
#pragma unroll
        for (int e = 0; e < 4; ++e) { v0[e] = sigmoidf_(v0[e]); v1[e] = sigmoidf_(v1[e]); }
    }
    u32x4 o; o[0] = pk_bf16(v0[0], v0[1]); o[1] = pk_bf16(v0[2], v0[3]); o[2] = pk_bf16(v1[0], v1[1]); o[3] = pk_bf16(v1[2], v1[3]);
    *(u32x4*)dstp = o;
}
template <int LD> struct EpiProj1 {
    static constexpr bool PERM = true, AFTER_DRAIN = false;
    bf16_t* dst;
    DI void operator()(const f32x4 (&acc)[2][2][4][2], const Unit& u, int wr, int wc, int fr, int fq) const {
        const int row0 = u.pm * BM + wr * 64 + fr, col0 = u.pn * BM + wc * 32 + 8 * fq;
#pragma unroll
        for (int ai = 0; ai < 2; ++ai)
#pragma unroll
            for (int m = 0; m < 4; ++m) { bf16_t* rowp = dst + (size_t)(row0 + ai * HALF + m * 16) * LD + col0;
#pragma unroll
                for (int bj = 0; bj < 2; ++bj) epi_store8<0>(rowp + bj * HALF, acc[ai][bj][m][0], acc[ai][bj][m][1]); }
    }
};
struct EpiProjC {
    static constexpr bool PERM = true, AFTER_DRAIN = false;
    unsigned char* ws; float* out;
    DI void operator()(const f32x4 (&acc)[2][2][4][2], const Unit& u, int wr, int wc, int fr, int fq) const {
        const int row0 = u.pm * BM + wr * 64 + fr, cw = wc * 32 + 8 * fq;
        if (u.pn < 4) { bf16_t* base = (bf16_t*)out + (size_t)MTOK * D + u.pn * BM + cw;
#pragma unroll
            for (int ai = 0; ai < 2; ++ai)
#pragma unroll
                for (int m = 0; m < 4; ++m)
#pragma unroll
                    for (int bj = 0; bj < 2; ++bj) epi_store8<1>(base + (size_t)(row0 + ai * HALF + m * 16) * 1024 + bj * HALF, acc[ai][bj][m][0], acc[ai][bj][m][1]);
        } else if (u.pn < 7) { bf16_t* base = (bf16_t*)(ws + WS_ZB) + (u.pn - 4) * BM + cw;
#pragma unroll
            for (int ai = 0; ai < 2; ++ai)
#pragma unroll
                for (int m = 0; m < 4; ++m)
#pragma unroll
                    for (int bj = 0; bj < 2; ++bj) epi_store8<1>(base + (size_t)(row0 + ai * HALF + m * 16) * 768 + bj * HALF, acc[ai][bj][m][0], acc[ai][bj][m][1]);
        } else { bf16_t* base = (bf16_t*)(ws + WS_R2) + (u.pn - 7) * BM + cw;
#pragma unroll
            for (int ai = 0; ai < 2; ++ai)
#pragma unroll
                for (int m = 0; m < 4; ++m)
#pragma unroll
                    for (int bj = 0; bj < 2; ++bj) epi_store8<2>(base + (size_t)(row0 + ai * HALF + m * 16) * 2048 + bj * HALF, acc[ai][bj][m][0], acc[ai][bj][m][1]);
        }
    }
};
struct EpiGate {
    static constexpr bool PERM = true, AFTER_DRAIN = false;
    bf16_t* T; const bf16_t* sg; int ldsg; int mode;
    DI void operator()(const f32x4 (&acc)[2][2][4][2], const Unit& u, int wr, int wc, int fr, int fq) const {
        const int row0 = u.pm * BM + wr * 64 + fr, col0 = u.pn * BM + wc * 32 + 8 * fq;
#pragma unroll
        for (int ai = 0; ai < 2; ++ai)
#pragma unroll
            for (int m = 0; m < 4; ++m) { const size_t row = (size_t)(row0 + ai * HALF + m * 16);
#pragma unroll
                for (int bj = 0; bj < 2; ++bj) { const f32x4 v0 = acc[ai][bj][m][0], v1 = acc[ai][bj][m][1];
                    const u32x4 s = *(const u32x4*)(sg + row * ldsg + col0 + bj * HALF);
                    float r[8] = { bflo(s[0]) * v0[0], bfhi(s[0]) * v0[1], bflo(s[1]) * v0[2], bfhi(s[1]) * v0[3], bflo(s[2]) * v1[0], bfhi(s[2]) * v1[1], bflo(s[3]) * v1[2], bfhi(s[3]) * v1[3] };
                    bf16_t* tp = T + row * D + col0 + bj * HALF;
                    if (mode == 1) { const u32x4 t = *(const u32x4*)tp;
                        r[0] += bflo(t[0]); r[1] += bfhi(t[0]); r[2] += bflo(t[1]); r[3] += bfhi(t[1]); r[4] += bflo(t[2]); r[5] += bfhi(t[2]); r[6] += bflo(t[3]); r[7] += bfhi(t[3]); }
                    u32x4 o; o[0] = pk_bf16(r[0], r[1]); o[1] = pk_bf16(r[2], r[3]); o[2] = pk_bf16(r[4], r[5]); o[3] = pk_bf16(r[6], r[7]);
                    *(u32x4*)tp = o; } }
    }
};
struct EpiMerge2 {
    static constexpr bool PERM = true, AFTER_DRAIN = false;
    bf16_t* out; const bf16_t* gt;
    DI void mid(f32x4 (&acc)[2][2][4][2], const Unit& u, int wr, int wc, int fr, int fq) const {
        int row0 = u.pm * BM + wr * 64 + fr, col0 = u.pn * BM + wc * 32 + 8 * fq;
        asm volatile("" : "+v"(row0), "+v"(col0));
#pragma unroll
        for (int ai = 0; ai < 2; ++ai)
#pragma unroll
            for (int m = 0; m < 4; ++m) { const bf16_t* gp = gt + (size_t)(row0 + ai * HALF + m * 16) * 2048 + col0;
#pragma unroll
                for (int bj = 0; bj < 2; ++bj) { const u32x4 sa = *(const u32x4*)(gp + bj * HALF), sb = *(const u32x4*)(gp + 1024 + bj * HALF);
#pragma unroll
                    for (int e = 0; e < 2; ++e) {
                        acc[ai][bj][m][0][2 * e]     *= bflo(sa[e]) * __builtin_amdgcn_rcpf(fmaxf(bflo(sb[e]), 1e-20f));
                        acc[ai][bj][m][0][2 * e + 1] *= bfhi(sa[e]) * __builtin_amdgcn_rcpf(fmaxf(bfhi(sb[e]), 1e-20f));
                        acc[ai][bj][m][1][2 * e]     *= bflo(sa[2 + e]) * __builtin_amdgcn_rcpf(fmaxf(bflo(sb[2 + e]), 1e-20f));
                        acc[ai][bj][m][1][2 * e + 1] *= bfhi(sa[2 + e]) * __builtin_amdgcn_rcpf(fmaxf(bfhi(sb[2 + e]), 1e-20f)); } }
                if (m & 1) __builtin_amdgcn_sched_barrier(0); }
    }
    DI void operator()(const f32x4 (&acc)[2][2][4][2], const Unit& u, int wr, int wc, int fr, int fq) const {
        int row0 = u.pm * BM + wr * 64 + fr, col0 = u.pn * BM + wc * 32 + 8 * fq;
        asm volatile("" : "+v"(row0), "+v"(col0));
#pragma unroll
        for (int ai = 0; ai < 2; ++ai)
#pragma unroll
            for (int m = 0; m < 4; ++m) { const size_t row = (size_t)(row0 + ai * HALF + m * 16);
#pragma unroll
                for (int bj = 0; bj < 2; ++bj) { const f32x4 v0 = acc[ai][bj][m][0], v1 = acc[ai][bj][m][1];
                    const u32x4 sb = *(const u32x4*)(gt + row * 2048 + 1024 + col0 + bj * HALF);
                    u32x4 o;
                    o[0] = pk_bf16(v0[0] * fmaxf(bflo(sb[0]), 1e-20f), v0[1] * fmaxf(bfhi(sb[0]), 1e-20f)); o[1] = pk_bf16(v0[2] * fmaxf(bflo(sb[1]), 1e-20f), v0[3] * fmaxf(bfhi(sb[1]), 1e-20f));
                    o[2] = pk_bf16(v1[0] * fmaxf(bflo(sb[2]), 1e-20f), v1[1] * fmaxf(bfhi(sb[2]), 1e-20f)); o[3] = pk_bf16(v1[2] * fmaxf(bflo(sb[3]), 1e-20f), v1[3] * fmaxf(bfhi(sb[3]), 1e-20f));
                    *(u32x4*)(out + row * D + col0 + bj * HALF) = o; } }
    }
};
struct EpiOutNorm {
    static constexpr bool PERM = false, AFTER_DRAIN = true;
    const float* x; const float* mod; const float* fnw; float* out; float* rs; unsigned* cnt;
    DI void operator()(const f32x4 (&)[2][2][4][2], const Unit&, int, int, int, int) const {}
    DI void fused(f32x4 (&acc)[2][2][4][2], const Unit& u, int wr, int wc, int fr, int fq, LAS unsigned char* lds) const {
        const int tid = threadIdx.x;
        const int row0 = u.pm * BM + wr * 64 + fr, col0 = u.pn * BM + wc * 32 + 4 * fq;
        const int b = (u.pm * BM) / SEQ;
        LAS float* part = (LAS float*)lds;
        LAS float* rstd_l = (LAS float*)(lds + 4096);
        f32x4 gv[2][2];
#pragma unroll
        for (int bj = 0; bj < 2; ++bj)
#pragma unroll
            for (int n = 0; n < 2; ++n) gv[bj][n] = *(const f32x4*)(mod + b * 3072 + 2048 + col0 + bj * HALF + n * 16);
#pragma unroll
        for (int ai = 0; ai < 2; ++ai)
#pragma unroll
            for (int m = 0; m < 4; ++m) { const size_t ro = (size_t)(row0 + ai * HALF + m * 16) * D + col0;
                float ss = 0.f;
#pragma unroll
                for (int bj = 0; bj < 2; ++bj)
#pragma unroll
                    for (int n = 0; n < 2; ++n) { const f32x4 xv = *(const f32x4*)(x + ro + bj * HALF + n * 16);
                        const f32x4 v = xv + gv[bj][n] * acc[ai][bj][m][n]; acc[ai][bj][m][n] = v;
                        ss += v[0] * v[0] + v[1] * v[1] + v[2] * v[2] + v[3] * v[3]; }
                ss += __shfl_xor(ss, 16); ss += __shfl_xor(ss, 32);
                if (fq == 0) part[wc * 256 + ai * HALF + wr * 64 + m * 16 + fr] = ss; }
        __syncthreads();
        if (tid < 256) __hip_atomic_store(rs + (size_t)(u.pm * 4 + u.pn) * 256 + tid, part[tid] + part[256 + tid] + part[512 + tid] + part[768 + tid], __ATOMIC_RELAXED, __HIP_MEMORY_SCOPE_AGENT);
        asm volatile("s_waitcnt vmcnt(0)" ::: "memory");
        __syncthreads();
        if (tid == 0) {
            unsigned* c = cnt + u.pm * 16;
            __hip_atomic_fetch_add(c, 1u, __ATOMIC_RELAXED, __HIP_MEMORY_SCOPE_AGENT);
            unsigned sp = 0;
            while (__hip_atomic_load(c, __ATOMIC_RELAXED, __HIP_MEMORY_SCOPE_AGENT) < 4u) { __builtin_amdgcn_s_sleep(1); if (++sp > (1u << 24)) break; }
        }
        __syncthreads();
        if (tid < 256) { float* rp = rs + (size_t)(u.pm * 4) * 256 + tid;
            const float tot = __hip_atomic_load(rp, __ATOMIC_RELAXED, __HIP_MEMORY_SCOPE_AGENT) + __hip_atomic_load(rp + 256, __ATOMIC_RELAXED, __HIP_MEMORY_SCOPE_AGENT)
                            + __hip_atomic_load(rp + 512, __ATOMIC_RELAXED, __HIP_MEMORY_SCOPE_AGENT) + __hip_atomic_load(rp + 768, __ATOMIC_RELAXED, __HIP_MEMORY_SCOPE_AGENT);
            rstd_l[tid] = rsqrtf(tot * (1.f / 1024.f) + EPS); }
        __syncthreads();
        f32x4 wv[2][2];
#pragma unroll
        for (int bj = 0; bj < 2; ++bj)
#pragma unroll
            for (int n = 0; n < 2; ++n) wv[bj][n] = *(const f32x4*)(fnw + col0 + bj * HALF + n * 16);
#pragma unroll
        for (int ai = 0; ai < 2; ++ai)
#pragma unroll
            for (int m = 0; m < 4; ++m) { const size_t ro = (size_t)(row0 + ai * HALF + m * 16) * D + col0;
                const float r = rstd_l[ai * HALF + wr * 64 + m * 16 + fr];
#pragma unroll
                for (int bj = 0; bj < 2; ++bj)
#pragma unroll
                    for (int n = 0; n < 2; ++n) *(f32x4*)(out + ro + bj * HALF + n * 16) = acc[ai][bj][m][n] * r * wv[bj][n]; }
    }
};
}

DI int map_n_in(int np) {
    if (np < 3072) return np;
    if (np < 5376) return 4112 + (np - 3072);
    if (np < 6400) return 3072 + (np - 5376);
    if (np < 7168) return 6416 + (np - 6400);
    return 7184 + (np - 7168);
}
struct TileDesc { const float* src; bf16_t* dst; int ld, col0, K, n0, k0; };
DI TileDesc tile_desc(const Params& p, int t) {
    TileDesc d; unsigned char* ws = p.ws;
    if (t < 2304) { const int tn = t >> 4, tk = t & 15; d.src = p.w_in; d.ld = N_IN; d.col0 = map_n_in(tn * 64); d.dst = (bf16_t*)(ws + WS_WT_IN); d.K = 1024; d.n0 = tn * 64; d.k0 = tk * 64; }
    else if (t < 2560) { const int u = t - 2304, tn = u >> 4, tk = u & 15; d.src = p.w_pa; d.ld = 1024; d.col0 = tn * 64; d.dst = (bf16_t*)(ws + WS_WT_PA); d.K = 1024; d.n0 = tn * 64; d.k0 = tk * 64; }
    else if (t < 2752) { const int u = t - 2560, tn = u / 12, tk = u % 12; d.src = p.w_pb; d.ld = 1024; d.col0 = tn * 64; d.dst = (bf16_t*)(ws + WS_WT_PB); d.K = 768; d.n0 = tn * 64; d.k0 = tk * 64; }
    else { const int u = t - 2752, tn = u >> 4, tk = u & 15; d.src = p.w_out; d.ld = 1024; d.col0 = tn * 64; d.dst = (bf16_t*)(ws + WS_WT_O); d.K = 1024; d.n0 = tn * 64; d.k0 = tk * 64; }
    return d;
}
DI void tile_load(float (&v)[8], const TileDesc& d, int tid) {
#pragma unroll
    for (int i = 0; i < 8; ++i) { const int r = (tid >> 6) + 8 * i, c = tid & 63; v[i] = d.src[(size_t)(d.k0 + r) * d.ld + d.col0 + c]; }
}
DI void phase0(const Params& p, LAS unsigned char* lds) {
    int tid = threadIdx.x; asm volatile("" : "+v"(tid));
    const int nb = gridDim.x;
    unsigned char* ws = p.ws;
    {
        const int task = nb - 1 - (int)blockIdx.x;
        if (task < 192) {
            LAS float* sc = (LAS float*)lds;
            LAS float* red = (LAS float*)(lds + 8192);
            const int cg = task % 48, ks = task / 48, k0 = ks * 256;
            for (int i = tid; i < 2048; i += 512) sc[i] = siluf_(p.c[(i >> 8) * 1024 + k0 + (i & 255)]);
            __syncthreads();
            const int col = cg * 64 + (tid & 63), kq = tid >> 6;
            float a[8] = {0.f, 0.f, 0.f, 0.f, 0.f, 0.f, 0.f, 0.f};
            const float* wp = p.ada_w + (size_t)(k0 + kq * 32) * 3072 + col;
#pragma unroll
            for (int kk = 0; kk < 32; kk += 8) {
                float w[8];
#pragma unroll
                for (int u = 0; u < 8; ++u) w[u] = wp[(size_t)(kk + u) * 3072];
#pragma unroll
                for (int u = 0; u < 8; ++u)
#pragma unroll
                    for (int b = 0; b < 8; ++b) a[b] += sc[b * 256 + kq * 32 + kk + u] * w[u];
            }
#pragma unroll
            for (int b = 0; b < 8; ++b) red[(kq * 8 + b) * 64 + (tid & 63)] = a[b];
            __syncthreads();
            { const int b = tid >> 6, cl = tid & 63; float s = 0.f;
#pragma unroll
                for (int q = 0; q < 8; ++q) s += red[(q * 8 + b) * 64 + cl];
                __hip_atomic_store((float*)(ws + WS_MODP) + (size_t)(ks * 8 + b) * 3072 + cg * 64 + cl, s, __ATOMIC_RELAXED, __HIP_MEMORY_SCOPE_AGENT); }
            asm volatile("s_waitcnt vmcnt(0)" ::: "memory");
            __syncthreads();
            if (tid == 0)
                __hip_atomic_fetch_add((unsigned*)(ws + WS_BAR + 28672), 1u, __ATOMIC_RELAXED, __HIP_MEMORY_SCOPE_AGENT);
        }
    }
    LAS float* tile = (LAS float*)lds;
    int t = blockIdx.x;
    if (t < 3008) {
        TileDesc d = tile_desc(p, t);
        float v[8];
        tile_load(v, d, tid);
        for (;;) {
#pragma unroll
            for (int i = 0; i < 8; ++i) { const int r = (tid >> 6) + 8 * i, c = tid & 63; tile[r * 65 + c] = v[i]; }
            __syncthreads();
            const int tn = t + nb;
            TileDesc dn = d;
            if (tn < 3008) { dn = tile_desc(p, tn); tile_load(v, dn, tid); }
#pragma unroll
            for (int i = 0; i < 4; ++i) { const int rr = (tid >> 5) + 16 * i, cc = (tid & 31) * 2;
                *(unsigned*)(d.dst + (size_t)(d.n0 + rr) * d.K + d.k0 + cc) = pk_bf16(tile[cc * 65 + rr], tile[(cc + 1) * 65 + rr]); }
            __syncthreads();
            if (tn >= 3008) break;
            t = tn; d = dn;
        }
    }
}

DI void phase1(const Params& p, LAS unsigned char* lds) {
    LAS float* wT = (LAS float*)lds;
    LAS float* lmod = (LAS float*)(lds + 65536);
    int tid = threadIdx.x; asm volatile("" : "+v"(tid));
    const int lane = tid & 63, wave = tid >> 6;
    for (int i = tid; i < 16384; i += 512) { const int k = i >> 4, j = i & 15; wT[j * 1024 + k] = p.w_in[(size_t)k * N_IN + 4096 + j]; }
    float* mod = (float*)(p.ws + WS_MOD);
    const float* modp = (const float*)(p.ws + WS_MODP);
    bf16_t* H = (bf16_t*)(p.ws + WS_H);
    float* BETA = (float*)(p.ws + WS_BETA); float* GG = (float*)(p.ws + WS_G);
    if (tid == 0) {
        unsigned* c = (unsigned*)(p.ws + WS_BAR + 28672); unsigned sp = 0;
        while (__hip_atomic_load(c, __ATOMIC_RELAXED, __HIP_MEMORY_SCOPE_AGENT) < 192u) { __builtin_amdgcn_s_sleep(2); if (++sp > (1u << 24)) break; }
    }
    for (int rb = blockIdx.x; rb < MTOK / 64; rb += gridDim.x) {
        const int b = rb >> 5;
        __syncthreads();
        for (int i = tid; i < 3072; i += 512) {
            float v = p.ada_b[i];
#pragma unroll
            for (int ks = 0; ks < 4; ++ks) v += __hip_atomic_load((float*)modp + (size_t)(ks * 8 + b) * 3072 + i, __ATOMIC_RELAXED, __HIP_MEMORY_SCOPE_AGENT);
            if (i < 2048) lmod[i] = v;
            if ((rb & 31) == 0) mod[b * 3072 + i] = v;
        }
        __syncthreads();
        const float ea = expf(p.a_log[lane & 7]), dtb = p.dt_bias[lane & 7];
        for (int j = 0; j < 8; j += 4) {
            const int row = rb * 64 + wave * 8 + j;
            f32x4 xv[4][4]; float ss[4] = {0.f, 0.f, 0.f, 0.f};
#pragma unroll
            for (int r = 0; r < 4; ++r)
#pragma unroll
                for (int i = 0; i < 4; ++i) { xv[r][i] = *(const f32x4*)(p.x + (size_t)(row + r) * D + i * 256 + lane * 4);
                    ss[r] += xv[r][i][0] * xv[r][i][0] + xv[r][i][1] * xv[r][i][1] + xv[r][i][2] * xv[r][i][2] + xv[r][i][3] * xv[r][i][3]; }
#pragma unroll
            for (int r = 0; r < 4; ++r) {
                const float rstd = rsqrtf(wave_sum(ss[r]) * (1.f / 1024.f) + EPS);
#pragma unroll
                for (int i = 0; i < 4; ++i) { const int k = i * 256 + lane * 4;
                    const f32x4 nw = *(const f32x4*)(p.norm_w + k), sh = *(const LAS f32x4*)(lmod + k), scl = *(const LAS f32x4*)(lmod + 1024 + k);
#pragma unroll
                    for (int e = 0; e < 4; ++e) xv[r][i][e] = xv[r][i][e] * rstd * nw[e] * (1.f + scl[e]) + sh[e];
                    u32x2 o; o[0] = pk_bf16(xv[r][i][0], xv[r][i][1]); o[1] = pk_bf16(xv[r][i][2], xv[r][i][3]);
                    *(u32x2*)(H + (size_t)(row + r) * D + k) = o; }
            }
            float myv[4] = {0.f, 0.f, 0.f, 0.f};
#pragma unroll 2
            for (int jj = 0; jj < 16; ++jj) { float a[4] = {0.f, 0.f, 0.f, 0.f};
#pragma unroll
                for (int i = 0; i < 4; ++i) { const f32x4 w = *(const LAS f32x4*)(wT + jj * 1024 + i * 256 + lane * 4);
#pragma unroll
                    for (int r = 0; r < 4; ++r) a[r] += xv[r][i][0] * w[0] + xv[r][i][1] * w[1] + xv[r][i][2] * w[2] + xv[r][i][3] * w[3]; }
#pragma unroll
                for (int r = 0; r < 4; ++r) { const float s = wave_sum(a[r]); if (lane == jj) myv[r] = s; } }
#pragma unroll
            for (int r = 0; r < 4; ++r) {
                if (lane < 8) BETA[(size_t)(row + r) * 8 + lane] = sigmoidf_(myv[r]);
                else if (lane < 16) { const float z = myv[r] + dtb; const float sp = z > 20.f ? z : log1pf(expf(z));
                    GG[(size_t)(row + r) * 8 + (lane - 8)] = -ea * sp; } }
        }
    }
}

constexpr int CP_SLOT_B = 8448;
constexpr int CP_BUF0 = 8 * CP_SLOT_B;
constexpr int CP_BUF_B = 17408 * 2 + 512;
constexpr int CP_LDS_TOTAL = CP_BUF0 + 2 * CP_BUF_B;
DI int permpos4(int t) { return 32 * (t >> 1) + 4 * (t & 1); }
DI int lrow_off(int a, int bq) { return bq == 0 ? (8 * a * a + 4 * a) : (8 * a * a + 8 * a + 4 * (bq - 1) * (a + 1)); }
struct CpRaw { unsigned q[11], k[11], v[11]; float g, beta; };
DI void cp_load_raw(CpRaw& R, const Params& p, int item, int wave, int lane) {
    const int bh = item >> 5, n = item & 31, b = bh >> 3, h = bh & 7, tl0 = wave * 8;
    const bf16_t* PA = (const bf16_t*)(p.ws + WS_R1);
#pragma unroll
    for (int r = 0; r < 11; ++r) { const int tb = n * 64 + tl0 - 3 + r;
        if (tb >= 0) { const bf16_t* rp = PA + (size_t)(b * SEQ + tb) * 3072 + h * 128 + 2 * lane;
            R.q[r] = *(const unsigned*)rp; R.k[r] = *(const unsigned*)(rp + 1024); R.v[r] = *(const unsigned*)(rp + 2048); }
        else { R.q[r] = 0u; R.k[r] = 0u; R.v[r] = 0u; } }
    const size_t grow = (size_t)(b * SEQ + n * 64 + lane) * 8 + h;
    R.g = ((const float*)(p.ws + WS_G))[grow]; R.beta = ((const float*)(p.ws + WS_BETA))[grow];
}
DI void cp_conv(const unsigned (&raw)[11], const float* cw, float (&y0)[8], float (&y1)[8]) {
    float w0[4], w1[4];
#pragma unroll
    for (int j = 0; j < 4; ++j) { const f32x2 w = *(const f32x2*)(cw + j * 3072); w0[j] = w[0]; w1[j] = w[1]; }
#pragma unroll
    for (int e = 0; e < 8; ++e) { float a0 = 0.f, a1 = 0.f;
#pragma unroll
        for (int j = 0; j < 4; ++j) { a0 += w0[j] * bflo(raw[e + j]); a1 += w1[j] * bfhi(raw[e + j]); }
        y0[e] = siluf_(a0); y1[e] = siluf_(a1); }
}
DI void cp_stage_a1(const CpRaw& R, const Params& p, LAS unsigned char* lds, int item, int buf, int wave, int lane) {
    const int bh = item >> 5, h = bh & 7, tl0 = wave * 8;
    LAS bf16_t* qs = (LAS bf16_t*)(lds + CP_BUF0 + buf * CP_BUF_B); LAS bf16_t* ks = qs + 64 * 136;
    LAS float* gcs = (LAS float*)(lds + CP_BUF0 + buf * CP_BUF_B + 34816); LAS float* betas = gcs + 64;
    bf16_t* UT = (bf16_t*)p.out + (size_t)item * 8192;
    bf16_t* Wg = (bf16_t*)p.out + (size_t)MTOK * D + (size_t)item * 8192;
    bf16_t* QD = (bf16_t*)(p.ws + WS_QD) + (size_t)item * 8192;
    bf16_t* KDT = (bf16_t*)(p.ws + WS_KDT) + (size_t)item * 8192;
    float v = R.g;
#pragma unroll
    for (int o = 1; o < 64; o <<= 1) { const float u = __shfl_up(v, o); if (lane >= o) v += u; }
    const float gcl = __shfl(v, 63);
    float egc[8], bet[8], ekd[8];
#pragma unroll
    for (int e = 0; e < 8; ++e) { const float gce = __shfl(v, tl0 + e); egc[e] = __expf(gce); ekd[e] = __expf(gcl - gce); bet[e] = __shfl(R.beta, tl0 + e); }
    if (wave == 0) { gcs[lane] = v; betas[lane] = R.beta; if (lane == 63) ((float*)(p.ws + WS_GL))[item] = __expf(v); }
    float y0[8], y1[8];
    {
        cp_conv(R.q, p.conv_w + h * 128 + 2 * lane, y0, y1);
        { float pp[8], tt[8];
#pragma unroll
          for (int e = 0; e < 8; ++e) pp[e] = y0[e] * y0[e] + y1[e] * y1[e];
          reduce8(pp, tt, lane);
#pragma unroll
          for (int e = 0; e < 8; ++e) { const float ri = rsqrtf(tt[e] + EPS); y0[e] *= ri; y1[e] *= ri; } }
        const int dk = 2 * lane, loc = dk & 31, pp = 32 * (dk >> 5) + 8 * ((loc >> 2) & 3) + 4 * (loc >> 4) + (loc & 3);
#pragma unroll
        for (int e = 0; e < 8; ++e) { *(LAS unsigned*)(qs + (tl0 + e) * 136 + 2 * lane) = pk_bf16(y0[e], y1[e]);
            const float s = 0.08838834764831845f * egc[e];
            *(unsigned*)(QD + (tl0 + e) * 128 + pp) = pk_bf16(y0[e] * s, y1[e] * s); }
    }
    {
        cp_conv(R.k, p.conv_w + 1024 + h * 128 + 2 * lane, y0, y1);
        { float pp[8], tt[8];
#pragma unroll
          for (int e = 0; e < 8; ++e) pp[e] = y0[e] * y0[e] + y1[e] * y1[e];
          reduce8(pp, tt, lane);
#pragma unroll
          for (int e = 0; e < 8; ++e) { const float ri = rsqrtf(tt[e] + EPS); y0[e] *= ri; y1[e] *= ri; } }
#pragma unroll
        for (int e = 0; e < 8; ++e) *(LAS unsigned*)(ks + (tl0 + e) * 136 + 2 * lane) = pk_bf16(y0[e], y1[e]);
        float be[8];
#pragma unroll
        for (int e = 0; e < 8; ++e) be[e] = bet[e] * egc[e];
        u32x4 a, c;
        a[0] = pk_bf16(y0[0] * be[0], y0[1] * be[1]); a[1] = pk_bf16(y0[2] * be[2], y0[3] * be[3]); a[2] = pk_bf16(y0[4] * be[4], y0[5] * be[5]); a[3] = pk_bf16(y0[6] * be[6], y0[7] * be[7]);
        c[0] = pk_bf16(y1[0] * be[0], y1[1] * be[1]); c[1] = pk_bf16(y1[2] * be[2], y1[3] * be[3]); c[2] = pk_bf16(y1[4] * be[4], y1[5] * be[5]); c[3] = pk_bf16(y1[6] * be[6], y1[7] * be[7]);
        *(u32x4*)(Wg + (size_t)(wave * 128 + 2 * lane) * 8) = a; *(u32x4*)(Wg + (size_t)(wave * 128 + 2 * lane + 1) * 8) = c;
        u32x4 ka, kc;
        ka[0] = pk_bf16(y0[0] * ekd[0], y0[1] * ekd[1]); ka[1] = pk_bf16(y0[2] * ekd[2], y0[3] * ekd[3]); ka[2] = pk_bf16(y0[4] * ekd[4], y0[5] * ekd[5]); ka[3] = pk_bf16(y0[6] * ekd[6], y0[7] * ekd[7]);
        kc[0] = pk_bf16(y1[0] * ekd[0], y1[1] * ekd[1]); kc[1] = pk_bf16(y1[2] * ekd[2], y1[3] * ekd[3]); kc[2] = pk_bf16(y1[4] * ekd[4], y1[5] * ekd[5]); kc[3] = pk_bf16(y1[6] * ekd[6], y1[7] * ekd[7]);
        *(u32x4*)(KDT + (size_t)(wave * 128 + 2 * lane) * 8) = ka; *(u32x4*)(KDT + (size_t)(wave * 128 + 2 * lane + 1) * 8) = kc;
    }
    {
        cp_conv(R.v, p.conv_w + 2048 + h * 128 + 2 * lane, y0, y1);
        u32x4 a, c;
        a[0] = pk_bf16(y0[0] * bet[0], y0[1] * bet[1]); a[1] = pk_bf16(y0[2] * bet[2], y0[3] * bet[3]); a[2] = pk_bf16(y0[4] * bet[4], y0[5] * bet[5]); a[3] = pk_bf16(y0[6] * bet[6], y0[7] * bet[7]);
        c[0] = pk_bf16(y1[0] * bet[0], y1[1] * bet[1]); c[1] = pk_bf16(y1[2] * bet[2], y1[3] * bet[3]); c[2] = pk_bf16(y1[4] * bet[4], y1[5] * bet[5]); c[3] = pk_bf16(y1[6] * bet[6], y1[7] * bet[7]);
        *(u32x4*)(UT + (size_t)(wave * 128 + 2 * lane) * 8) = a; *(u32x4*)(UT + (size_t)(wave * 128 + 2 * lane + 1) * 8) = c;
    }
}
DI void cp_stage_a2(const Params& p, LAS unsigned char* lds, int item, int buf, int slot, int wave, int lane) {
    const int fr = lane & 15, fq = lane >> 4;
    LAS bf16_t* qs = (LAS bf16_t*)(lds + CP_BUF0 + buf * CP_BUF_B); LAS bf16_t* ks = qs + 64 * 136;
    LAS float* gcs = (LAS float*)(lds + CP_BUF0 + buf * CP_BUF_B + 34816); LAS float* betas = gcs + 64;
    LAS float* Lp = (LAS float*)(lds + slot * CP_SLOT_B);
    bf16_t* AG = (bf16_t*)(p.ws + WS_AG) + (size_t)item * 4096;
    if (wave < 4) {
#pragma unroll
        for (int tn = 0; tn < 4; ++tn) {
            f32x4 acc = {0.f, 0.f, 0.f, 0.f};
#pragma unroll
            for (int s = 0; s < 4; ++s) {
                const bf16x8 a = *(const LAS bf16x8*)(ks + (16 * wave + fr) * 136 + 32 * s + 8 * fq);
                const bf16x8 bb = *(const LAS bf16x8*)(ks + (16 * tn + fr) * 136 + 32 * s + 8 * fq);
                acc = MFMA16(a, bb, acc);
            }
            const int j = 16 * tn + fr; const float gj = gcs[j]; const int arow = 4 * wave + fq;
#pragma unroll
            for (int r = 0; r < 4; ++r) { const int i = 16 * wave + 4 * fq + r;
                if (i > j) Lp[lrow_off(arow, r) + j] = betas[i] * acc[r] * __expf(gcs[i] - gj); }
        }
    } else {
        const int s2 = (wave - 4) >> 1;
#pragma unroll
        for (int ti = 0; ti < 2; ++ti) {
            const int tn = 2 * ((wave - 4) & 1) + ti;
            const int i = 16 * tn + fr; const float gi = gcs[i];
            float v[8];
#pragma unroll
            for (int hh = 0; hh < 2; ++hh) {
                const int tm = 2 * s2 + hh;
                f32x4 acc = {0.f, 0.f, 0.f, 0.f};
#pragma unroll
                for (int s = 0; s < 4; ++s) {
                    const bf16x8 a = *(const LAS bf16x8*)(ks + (16 * tm + fr) * 136 + 32 * s + 8 * fq);
                    const bf16x8 bb = *(const LAS bf16x8*)(qs + (16 * tn + fr) * 136 + 32 * s + 8 * fq);
                    acc = MFMA16(a, bb, acc);
                }
#pragma unroll
                for (int r = 0; r < 4; ++r) { const int j = 16 * tm + 4 * fq + r;
                    v[4 * hh + r] = (i >= j) ? 0.08838834764831845f * acc[r] * __expf(gi - gcs[j]) : 0.f; }
            }
            u32x4 o; o[0] = pk_bf16(v[0], v[1]); o[1] = pk_bf16(v[2], v[3]); o[2] = pk_bf16(v[4], v[5]); o[3] = pk_bf16(v[6], v[7]);
            *(u32x4*)(AG + (size_t)((tn * 2 + s2) * 64 + lane) * 8) = o;
        }
    }
}
DI void cp_solve(LAS unsigned char* lds, int slot, int lane) {
    unsigned zero_v; asm volatile("v_mov_b32 %0, 0" : "=v"(zero_v));
    LAS float* Lp = (LAS float*)(lds + slot * CP_SLOT_B) + zero_v;
    float t[64];
#pragma unroll
    for (int i = 0; i < 64; ++i) t[i] = 0.f;
#pragma unroll
    for (int i = 0; i < 64; ++i) {
        LAS float* lp = Lp;
        if (i >= 2) asm volatile("" : "+v"(lp) : "v"(t[i - 2]));
        const int ro = (i & 3) == 0 ? (8 * (i >> 2) * (i >> 2) + 4 * (i >> 2)) : (8 * (i >> 2) * (i >> 2) + 8 * (i >> 2) + 4 * ((i & 3) - 1) * ((i >> 2) + 1));
        float s0 = (lane == i) ? 1.f : 0.f, s1 = 0.f;
#pragma unroll
        for (int j4 = 0; j4 < (i + 3) / 4; ++j4) {
            const f32x4 l = *(const LAS f32x4*)(lp + ro + j4 * 4);
            if (4 * j4 + 0 < i) s0 -= l[0] * t[4 * j4 + 0];
            if (4 * j4 + 1 < i) s1 -= l[1] * t[4 * j4 + 1];
            if (4 * j4 + 2 < i) s0 -= l[2] * t[4 * j4 + 2];
            if (4 * j4 + 3 < i) s1 -= l[3] * t[4 * j4 + 3];
        }
        t[i] = s0 + s1;
    }
    LAS unsigned char* Tb = lds + slot * CP_SLOT_B + zero_v;
#pragma unroll
    for (int i = 0; i < 64; ++i) *(LAS bf16_t*)(Tb + i * 128 + ((((lane >> 3) ^ ((i >> 1) & 7))) * 16) + (lane & 7) * 2) = f2bf(t[i]);
}
DI void chunk_prep_batch(const Params& p, LAS unsigned char* lds, int first, int stride, int cnt) {
    int tid = threadIdx.x; asm volatile("" : "+v"(tid));
    const int lane = tid & 63, wave = __builtin_amdgcn_readfirstlane(tid >> 6), fr = lane & 15, fq = lane >> 4;
    CpRaw R;
    cp_load_raw(R, p, first, wave, lane);
    for (int k = 0; k < cnt; ++k) {
        const int item = first + k * stride;
        cp_stage_a1(R, p, lds, item, k & 1, wave, lane);
        __syncthreads();
        if (k + 1 < cnt) cp_load_raw(R, p, item + stride, wave, lane);
        cp_stage_a2(p, lds, item, k & 1, k, wave, lane);
    }
    __syncthreads();
    if (wave < cnt) cp_solve(lds, wave, lane);
    __syncthreads();
    const int offK0 = fr * 128 + (((0 + fq) ^ (fr >> 1)) * 16), offK1 = fr * 128 + (((4 + fq) ^ (fr >> 1)) * 16);
    const int ws2 = wave >> 1, wt0 = 2 * (wave & 1);
    for (int half = 0; half < 2; ++half) {
        bf16x8 vbA[4][2], kbA[4][4];
#pragma unroll
        for (int kk = 0; kk < 4; ++kk) {
            const int k = half * 4 + kk;
            if (k < cnt) { const int item = first + k * stride;
                const bf16_t* UT = (const bf16_t*)p.out + (size_t)item * 8192; const bf16_t* Wg = (const bf16_t*)p.out + (size_t)MTOK * D + (size_t)item * 8192;
                vbA[kk][0] = *(const bf16x8*)(UT + (size_t)(fq * 128 + 16 * wave + fr) * 8); vbA[kk][1] = *(const bf16x8*)(UT + (size_t)((4 + fq) * 128 + 16 * wave + fr) * 8);
#pragma unroll
                for (int hh = 0; hh < 2; ++hh) { kbA[kk][2 * hh] = *(const bf16x8*)(Wg + (size_t)(fq * 128 + 16 * (2 * ws2 + hh) + fr) * 8); kbA[kk][2 * hh + 1] = *(const bf16x8*)(Wg + (size_t)((4 + fq) * 128 + 16 * (2 * ws2 + hh) + fr) * 8); } }
            else { vbA[kk][0] = vbA[kk][1] = kbA[kk][0] = kbA[kk][1] = kbA[kk][2] = kbA[kk][3] = (bf16x8){0, 0, 0, 0, 0, 0, 0, 0}; }
        }
        asm volatile("s_waitcnt vmcnt(0)" ::: "memory");
        __syncthreads();
#pragma unroll
        for (int kk = 0; kk < 4; ++kk) {
            const int k = half * 4 + kk;
            if (k >= cnt) break;
            const int item = first + k * stride;
            bf16_t* UT = (bf16_t*)p.out + (size_t)item * 8192; bf16_t* Wg = (bf16_t*)p.out + (size_t)MTOK * D + (size_t)item * 8192;
            LAS unsigned char* Tb = lds + k * CP_SLOT_B;
#pragma unroll
            for (int t4 = 0; t4 < 4; ++t4) {
                const bf16x8 t0 = *(const LAS bf16x8*)(Tb + t4 * 2048 + offK0), t1 = *(const LAS bf16x8*)(Tb + t4 * 2048 + offK1);
                f32x4 acc = {0.f, 0.f, 0.f, 0.f};
                acc = MFMA16(t0, vbA[kk][0], acc); acc = MFMA16(t1, vbA[kk][1], acc);
                u32x2 o; o[0] = pk_bf16(acc[0], acc[1]); o[1] = pk_bf16(acc[2], acc[3]);
                *(u32x2*)(UT + (size_t)((wave * 4 + t4) * 64 + lane) * 4) = o; }
#pragma unroll
            for (int ti = 0; ti < 2; ++ti) {
                const int tn = wt0 + ti;
                const bf16x8 t0 = *(const LAS bf16x8*)(Tb + tn * 2048 + offK0), t1 = *(const LAS bf16x8*)(Tb + tn * 2048 + offK1);
                f32x4 a0 = {0.f, 0.f, 0.f, 0.f}, a1 = {0.f, 0.f, 0.f, 0.f};
                a0 = MFMA16(kbA[kk][0], t0, a0); a0 = MFMA16(kbA[kk][1], t1, a0);
                a1 = MFMA16(kbA[kk][2], t0, a1); a1 = MFMA16(kbA[kk][3], t1, a1);
                u32x4 o; o[0] = pk_bf16(a0[0], a0[1]); o[1] = pk_bf16(a0[2], a0[3]); o[2] = pk_bf16(a1[0], a1[1]); o[3] = pk_bf16(a1[2], a1[3]);
                *(u32x4*)(Wg + (size_t)((tn * 4 + ws2) * 64 + lane) * 8) = o; }
        }
    }
    asm volatile("s_waitcnt vmcnt(0)" ::: "memory");
    __syncthreads();
}

constexpr int SC_W = 0, SC_QD = 16384, SC_KDT = 32768, SC_A = 49152, SC_BUF = 57344;
DI void scan_stage(LAS unsigned char* lds, int buf, const Params& p, int item, int wave, int lane) {
    const unsigned char* Wp = (const unsigned char*)((const bf16_t*)p.out + (size_t)MTOK * D + (size_t)item * 8192);
    const unsigned char* QDp = (const unsigned char*)((const bf16_t*)(p.ws + WS_QD) + (size_t)item * 8192);
    const unsigned char* KDTp = (const unsigned char*)((const bf16_t*)(p.ws + WS_KDT) + (size_t)item * 8192);
    const unsigned char* Ap = (const unsigned char*)((const bf16_t*)(p.ws + WS_AG) + (size_t)item * 4096);
    const int r4 = lane >> 4, c4 = lane & 15, r8 = lane >> 3, c8 = lane & 7;
#pragma unroll
    for (int k = 0; k < 7; ++k) {
        const int i = wave + 8 * k;
        const unsigned char* g; int loff;
        if (i < 16) { g = Wp + i * 1024 + lane * 16; loff = SC_W + i * 1024; }
        else if (i < 32) { const int ii = i & 15, r = 4 * ii + r4, c = c4 ^ (r & 15);
            g = QDp + r * 256 + c * 16; loff = SC_QD + ii * 1024; }
        else if (i < 48) { const int ii = i - 32; g = KDTp + ii * 1024 + lane * 16; loff = SC_KDT + ii * 1024; }
        else { const int ii = i - 48; g = Ap + ii * 1024 + lane * 16; loff = SC_A + ii * 1024; }
        __builtin_amdgcn_global_load_lds((const unsigned*)g, (LAS unsigned*)(lds + buf * SC_BUF + loff), 16, 0, 0);
    }
}
DI void dn_scan(const Params& p, LAS unsigned char* lds, int bh) {
    int tid = threadIdx.x; asm volatile("" : "+v"(tid));
    const int lane = tid & 63, wave = __builtin_amdgcn_readfirstlane(tid >> 6), fr = lane & 15, fq = lane >> 4;
    unsigned char* ws = p.ws;
    f32x4 S[8];
#pragma unroll
    for (int t = 0; t < 8; ++t) S[t] = (f32x4){0.f, 0.f, 0.f, 0.f};
    const float glv = ((const float*)(ws + WS_GL))[bh * 32 + (lane & 31)];
    int offW[4], offK[2];
#pragma unroll
    for (int s = 0; s < 4; ++s) offW[s] = fr * 256 + (((4 * s + fq) ^ fr) * 16);
#pragma unroll
    for (int s = 0; s < 2; ++s) offK[s] = fr * 128 + (((4 * s + fq) ^ (fr >> 1)) * 16);
    bf16_t* UT0 = (bf16_t*)p.out + (size_t)(bh * 32) * 8192 + (size_t)(wave * 4 * 64 + lane) * 4;
    scan_stage(lds, 0, p, bh * 32, wave, lane);
    u32x2 ucur[4];
#pragma unroll
    for (int tm = 0; tm < 4; ++tm) ucur[tm] = *(const u32x2*)(UT0 + 256 * tm);
    for (int n = 0; n < 32; ++n) {
        const int item = bh * 32 + n, buf = n & 1;
        asm volatile("s_waitcnt vmcnt(0)" ::: "memory");
        __syncthreads();
        u32x2 unext[4];
        if (n + 1 < 32) {
            scan_stage(lds, buf ^ 1, p, item + 1, wave, lane);
#pragma unroll
            for (int tm = 0; tm < 4; ++tm) unext[tm] = *(const u32x2*)(UT0 + (size_t)(n + 1) * 8192 + 256 * tm);
        } else {
#pragma unroll
            for (int tm = 0; tm < 4; ++tm) unext[tm] = (u32x2){0u, 0u};
        }
        const float gl = __builtin_bit_cast(float, __builtin_amdgcn_readlane(__builtin_bit_cast(int, glv), n));
        LAS unsigned char* B = lds + buf * SC_BUF;
        bf16_t* UTp = UT0 + (size_t)n * 8192;
        bf16x8 Sf[4];
#pragma unroll
        for (int s = 0; s < 4; ++s) Sf[s] = pack8(S[2 * s], S[2 * s + 1]);
        f32x4 vn[4];
#pragma unroll
        for (int tm = 0; tm < 4; ++tm) {
            f32x4 acc = {0.f, 0.f, 0.f, 0.f};
#pragma unroll
            for (int s = 0; s < 4; ++s) { const bf16x8 a = *(const LAS bf16x8*)(B + SC_W + (tm * 4 + s) * 1024 + lane * 16); acc = MFMA16(a, Sf[s], acc); }
            const u32x2 u = ucur[tm];
            vn[tm][0] = bflo(u[0]) - acc[0]; vn[tm][1] = bfhi(u[0]) - acc[1]; vn[tm][2] = bflo(u[1]) - acc[2]; vn[tm][3] = bfhi(u[1]) - acc[3];
        }
        bf16x8 Vf[2];
        Vf[0] = pack8(vn[0], vn[1]); Vf[1] = pack8(vn[2], vn[3]);
#pragma unroll
        for (int tm = 0; tm < 4; ++tm) {
            f32x4 acc = {0.f, 0.f, 0.f, 0.f};
#pragma unroll
            for (int s = 0; s < 4; ++s) { const bf16x8 a = *(const LAS bf16x8*)(B + SC_QD + tm * 4096 + offW[s]); acc = MFMA16(a, Sf[s], acc); }
#pragma unroll
            for (int s = 0; s < 2; ++s) { const bf16x8 a = *(const LAS bf16x8*)(B + SC_A + (tm * 2 + s) * 1024 + lane * 16); acc = MFMA16(a, Vf[s], acc); }
            u32x2 o; o[0] = pk_bf16(acc[0], acc[1]); o[1] = pk_bf16(acc[2], acc[3]);
            *(u32x2*)(UTp + 256 * tm) = o;
        }
#pragma unroll
        for (int t = 0; t < 8; ++t) {
            f32x4 acc = S[t] * gl;
#pragma unroll
            for (int s = 0; s < 2; ++s) {
                const u32x2 lo = *(const LAS u32x2*)(B + SC_KDT + ((4 * s + (fq >> 1)) * 128 + 16 * t + fr) * 16 + (fq & 1) * 8);
                const u32x2 hi = *(const LAS u32x2*)(B + SC_KDT + ((4 * s + 2 + (fq >> 1)) * 128 + 16 * t + fr) * 16 + (fq & 1) * 8);
                u32x4 av; av[0] = lo[0]; av[1] = lo[1]; av[2] = hi[0]; av[3] = hi[1];
                acc = MFMA16(__builtin_bit_cast(bf16x8, av), Vf[s], acc); }
            S[t] = acc;
        }
#pragma unroll
        for (int tm = 0; tm < 4; ++tm) ucur[tm] = unext[tm];
    }
    asm volatile("s_waitcnt vmcnt(0)" ::: "memory");
    __syncthreads();
}

constexpr int AT_VT = 32768;
struct AtRaw { u32x4 k[4], v[4]; bf16x8 q[2]; };
struct AtItem { int b, head, dil, res, blk; };
DI AtItem at_decode(int item) {
    AtItem I; const int sub = item & 15; I.head = (item >> 4) % 12; I.b = item / 192;
    const int grp = I.head >> 2; I.dil = grp == 0 ? 1 : (grp == 1 ? 4 : 16); const int nbk = 16 / I.dil;
    I.res = sub / nbk; I.blk = sub % nbk; return I;
}
DI void at_load(AtRaw& R, const Params& p, int item, int tid) {
    const AtItem I = at_decode(item);
    const bf16_t* PB = (const bf16_t*)(p.ws + WS_R1);
    const int kk = tid >> 1, half = tid & 1, lk = (I.blk - 1) * 128 + kk;
    if (lk >= 0) { const bf16_t* rp = PB + (size_t)(I.b * SEQ + lk * I.dil + I.res) * 2304 + I.head * 64 + half * 32;
#pragma unroll
        for (int i = 0; i < 4; ++i) { R.k[i] = *(const u32x4*)(rp + 768 + 8 * i); R.v[i] = *(const u32x4*)(rp + 1536 + 8 * i); }
    } else {
#pragma unroll
        for (int i = 0; i < 4; ++i) { R.k[i] = (u32x4){0u, 0u, 0u, 0u}; R.v[i] = (u32x4){0u, 0u, 0u, 0u}; }
    }
    const int lane = tid & 63, wave = tid >> 6, fr = lane & 15, fq = lane >> 4;
    const int tq = (I.blk * 128 + 16 * wave + fr) * I.dil + I.res;
    const bf16_t* qrow = PB + (size_t)(I.b * SEQ + tq) * 2304 + I.head * 64;
    R.q[0] = *(const bf16x8*)(qrow + 8 * fq); R.q[1] = *(const bf16x8*)(qrow + 32 + 8 * fq);
}
DI void at_store_lds(const AtRaw& R, LAS unsigned char* lds, int tid) {
    const int kk = tid >> 1, half = tid & 1;
#pragma unroll
    for (int i = 0; i < 4; ++i) { const int c = half * 4 + i; *(LAS u32x4*)(lds + kk * 128 + ((c ^ ((kk >> 1) & 7)) * 16)) = R.k[i]; }
#pragma unroll
    for (int i = 0; i < 4; ++i)
#pragma unroll
        for (int e = 0; e < 4; ++e) { const int d0 = half * 32 + 8 * i + 2 * e, d1 = d0 + 1;
            *(LAS bf16_t*)(lds + AT_VT + d0 * 512 + (((kk >> 2) ^ ((d0 & 15) << 2)) * 8) + (kk & 3) * 2) = (bf16_t)(R.v[i][e] & 0xffffu);
            *(LAS bf16_t*)(lds + AT_VT + d1 * 512 + (((kk >> 2) ^ ((d1 & 15) << 2)) * 8) + (kk & 3) * 2) = (bf16_t)(R.v[i][e] >> 16); }
}
DI void at_compute(const Params& p, LAS unsigned char* lds, int item, const bf16x8 (&Qf)[2], int tid) {
    const int lane = tid & 63, wave = __builtin_amdgcn_readfirstlane(tid >> 6), fr = lane & 15, fq = lane >> 4;
    const AtItem I = at_decode(item);
    bf16_t* OB = (bf16_t*)(p.ws + WS_OB);
    float* LSE = (float*)(p.ws + WS_LSE);
    const int iq = 16 * wave + fr;
    const int tq = (I.blk * 128 + iq) * I.dil + I.res;
    const int offK0 = fr * 128 + (((0 + fq) ^ (fr >> 1)) * 16), offK1 = fr * 128 + (((4 + fq) ^ (fr >> 1)) * 16);
    const int kb2 = wave >> 1;
    f32x4 sc[10];
    float mx = -3.0e38f;
#pragma unroll
    for (int i = 0; i < 10; ++i) {
        const int kt = 2 * kb2 + i;
        if (kt < wave || kt > wave + 8) { sc[i] = (f32x4){-3.0e38f, -3.0e38f, -3.0e38f, -3.0e38f}; continue; }
        const bf16x8 a0 = *(const LAS bf16x8*)(lds + kt * 2048 + offK0), a1 = *(const LAS bf16x8*)(lds + kt * 2048 + offK1);
        f32x4 acc = {0.f, 0.f, 0.f, 0.f};
        acc = MFMA16(a0, Qf[0], acc); acc = MFMA16(a1, Qf[1], acc);
#pragma unroll
        for (int r = 0; r < 4; ++r) { const int kk = 16 * kt + 4 * fq + r;
            const bool valid = (kk >= iq) && (kk <= iq + 128) && (I.blk > 0 || kk >= 128);
            const float v = valid ? acc[r] * 0.125f : -3.0e38f; acc[r] = v; mx = fmaxf(mx, v); }
        sc[i] = acc;
    }
    mx = fmaxf(mx, __shfl_xor(mx, 16)); mx = fmaxf(mx, __shfl_xor(mx, 32));
    float den = 0.f;
    const float mxl = mx * 1.4426950408889634f;
#pragma unroll
    for (int i = 0; i < 10; ++i)
#pragma unroll
        for (int r = 0; r < 4; ++r) { const float v = sc[i][r]; const float e = (v > -1.0e38f) ? __builtin_amdgcn_exp2f(v * 1.4426950408889634f - mxl) : 0.f; sc[i][r] = e; den += e; }
    den += __shfl_xor(den, 16); den += __shfl_xor(den, 32);
    const float rden = __builtin_amdgcn_rcpf(den);
    bf16_t* orow = OB + (size_t)(I.b * SEQ + tq) * 768 + I.head * 64;
    f32x4 oacc[4];
#pragma unroll
    for (int dt = 0; dt < 4; ++dt) oacc[dt] = (f32x4){0.f, 0.f, 0.f, 0.f};
#pragma unroll
    for (int si = 0; si < 5; ++si) {
        const int s = kb2 + si;
        const bf16x8 Pf = pack8(sc[2 * si], sc[2 * si + 1]);
#pragma unroll
        for (int dt = 0; dt < 4; ++dt) {
            const u32x2 lo = *(const LAS u32x2*)(lds + AT_VT + (16 * dt + fr) * 512 + (((8 * s + fq) ^ (fr << 2)) * 8));
            const u32x2 hi = *(const LAS u32x2*)(lds + AT_VT + (16 * dt + fr) * 512 + (((8 * s + 4 + fq) ^ (fr << 2)) * 8));
            u32x4 av; av[0] = lo[0]; av[1] = lo[1]; av[2] = hi[0]; av[3] = hi[1];
            oacc[dt] = MFMA16(__builtin_bit_cast(bf16x8, av), Pf, oacc[dt]);
        }
    }
#pragma unroll
    for (int dt = 0; dt < 4; ++dt) { u32x2 o; o[0] = pk_bf16(oacc[dt][0] * rden, oacc[dt][1] * rden); o[1] = pk_bf16(oacc[dt][2] * rden, oacc[dt][3] * rden);
        *(u32x2*)(orow + 16 * dt + 4 * fq) = o; }
    if (fq == 0) LSE[(size_t)(I.b * SEQ + tq) * 12 + I.head] = mx + __logf(den);
}
DI void attn_phase(const Params& p, LAS unsigned char* lds, int it, int it_end) {
    int tid = threadIdx.x; asm volatile("" : "+v"(tid));
    if (it >= it_end) return;
    AtRaw R;
    at_load(R, p, it, tid);
    for (int k = 0; it < it_end; ++it, ++k) {
        LAS unsigned char* img = lds + (k & 1) * 65536;
        at_store_lds(R, img, tid);
        __syncthreads();
        bf16x8 Qf[2]; Qf[0] = R.q[0]; Qf[1] = R.q[1];
        if (it + 1 < it_end) at_load(R, p, it + 1, tid);
        at_compute(p, img, it, Qf, tid);
    }
    __syncthreads();
}

DI void ya_phase(const Params& p) {
    int tid = threadIdx.x; asm volatile("" : "+v"(tid));
    const int lane = tid & 63, wave = tid >> 6;
    const bf16_t* Z = (const bf16_t*)p.out + (size_t)MTOK * D;
    bf16_t* YA = (bf16_t*)(p.ws + WS_YA);
    const float nw0 = p.dn_norm_w[lane], nw1 = p.dn_norm_w[lane + 64];
    for (int task = blockIdx.x * 8 + wave; task < 2048 * 8; task += gridDim.x * 8) {
        const int item = task >> 3, tg = task & 7;
        const int bh = item >> 5, n = item & 31, b = bh >> 3, h = bh & 7;
        const bf16_t* OA = (const bf16_t*)p.out + (size_t)item * 8192 + (size_t)(((lane >> 4) * 4 + (tg >> 1)) * 64 + 2 * (tg & 1) * 16 + (lane & 15)) * 4;
        const u32x2 p00 = *(const u32x2*)OA, p01 = *(const u32x2*)(OA + 64), p10 = *(const u32x2*)(OA + 4 * 4 * 256), p11 = *(const u32x2*)(OA + 4 * 4 * 256 + 64);
        u32x4 o0, o1; o0[0] = p00[0]; o0[1] = p00[1]; o0[2] = p01[0]; o0[3] = p01[1]; o1[0] = p10[0]; o1[1] = p10[1]; o1[2] = p11[0]; o1[3] = p11[1];
        const size_t row0 = (size_t)(b * SEQ + n * 64 + tg * 8);
        const bf16_t* zp = Z + row0 * 1024 + h * 128 + lane;
        bf16_t z0[8], z1[8];
#pragma unroll
        for (int e = 0; e < 8; ++e) { z0[e] = zp[(size_t)e * 1024]; z1[e] = zp[(size_t)e * 1024 + 64]; }
        float a0[8], a1[8];
#pragma unroll
        for (int e = 0; e < 4; ++e) { a0[2 * e] = bflo(o0[e]); a0[2 * e + 1] = bfhi(o0[e]); a1[2 * e] = bflo(o1[e]); a1[2 * e + 1] = bfhi(o1[e]); }
        bf16_t* yp = YA + row0 * D + h * 128 + lane;
#pragma unroll
        for (int e = 0; e < 8; ++e) {
            const float ss = wave_sum(a0[e] * a0[e] + a1[e] * a1[e]);
            const float rstd = rsqrtf(ss * (1.f / 128.f) + EPS);
            yp[(size_t)e * D] = f2bf(a0[e] * rstd * nw0 * bf2f(z0[e]));
            yp[(size_t)e * D + 64] = f2bf(a1[e] * rstd * nw1 * bf2f(z1[e]));
        }
    }
}
DI void yb_rows(const Params& p) {
    int tid = threadIdx.x; asm volatile("" : "+v"(tid));
    const int lane = tid & 63, wave = tid >> 6;
    bf16_t* OB = (bf16_t*)(p.ws + WS_OB);
    const bf16_t* Z = (const bf16_t*)(p.ws + WS_ZB);
    const float* LSE = (const float*)(p.ws + WS_LSE);
    const int c0 = lane, c1 = lane + 64;
    const int j0 = (c0 >> 3) & 3, j1 = (c1 >> 3) & 3, g0 = c0 >> 5, g1 = c1 >> 5;
    for (int rq = blockIdx.x * 8 + wave; rq < MTOK / 4; rq += gridDim.x * 8) {
        float l0[4][3], l1[4][3]; u32x4 o0[4], o1[4], z0[4], z1[4];
#pragma unroll
        for (int r = 0; r < 4; ++r) { const size_t row = (size_t)rq * 4 + r;
#pragma unroll
            for (int g = 0; g < 3; ++g) { l0[r][g] = LSE[row * 12 + 4 * g + j0]; l1[r][g] = LSE[row * 12 + 4 * g + j1]; }
            o0[r] = *(const u32x4*)(OB + row * 768 + c0 * 8); z0[r] = *(const u32x4*)(Z + row * 768 + c0 * 8);
            if (c1 < 96) { o1[r] = *(const u32x4*)(OB + row * 768 + c1 * 8); z1[r] = *(const u32x4*)(Z + row * 768 + c1 * 8); }
            else { o1[r] = (u32x4){0u, 0u, 0u, 0u}; z1[r] = (u32x4){0u, 0u, 0u, 0u}; } }
#pragma unroll
        for (int r = 0; r < 4; ++r) { const size_t row = (size_t)rq * 4 + r;
            { const float m = fmaxf(l0[r][0], fmaxf(l0[r][1], l0[r][2]));
              const float e0 = __expf(l0[r][0] - m), e1 = __expf(l0[r][1] - m), e2 = __expf(l0[r][2] - m);
              const float w = (g0 == 0 ? e0 : (g0 == 1 ? e1 : e2)) * __builtin_amdgcn_rcpf(e0 + e1 + e2);
              u32x4 rr;
#pragma unroll
              for (int e = 0; e < 4; ++e) rr[e] = pk_bf16(bflo(o0[r][e]) * w * bflo(z0[r][e]), bfhi(o0[r][e]) * w * bfhi(z0[r][e]));
              *(u32x4*)(OB + row * 768 + c0 * 8) = rr; }
            if (c1 < 96) { const float m = fmaxf(l1[r][0], fmaxf(l1[r][1], l1[r][2]));
              const float e0 = __expf(l1[r][0] - m), e1 = __expf(l1[r][1] - m), e2 = __expf(l1[r][2] - m);
              const float w = (g1 == 0 ? e0 : (g1 == 1 ? e1 : e2)) * __builtin_amdgcn_rcpf(e0 + e1 + e2);
              u32x4 rr;
#pragma unroll
              for (int e = 0; e < 4; ++e) rr[e] = pk_bf16(bflo(o1[r][e]) * w * bflo(z1[r][e]), bfhi(o1[r][e]) * w * bfhi(z1[r][e]));
              *(u32x4*)(OB + row * 768 + c1 * 8) = rr; }
        }
    }
}

DI void final_norm(const Params& p) {
    int tid = threadIdx.x; asm volatile("" : "+v"(tid));
    const int lane = tid & 63, wave = tid >> 6;
    f32x4 w[4];
#pragma unroll
    for (int i = 0; i < 4; ++i) w[i] = *(const f32x4*)(p.fnw + i * 256 + lane * 4);
    for (int rq = blockIdx.x * 8 + wave; rq < MTOK / 4; rq += gridDim.x * 8) {
        f32x4 xv[4][4];
#pragma unroll
        for (int r = 0; r < 4; ++r)
#pragma unroll
            for (int i = 0; i < 4; ++i) xv[r][i] = *(const f32x4*)(p.out + ((size_t)rq * 4 + r) * D + i * 256 + lane * 4);
#pragma unroll
        for (int r = 0; r < 4; ++r) { float ss = 0.f;
#pragma unroll
            for (int i = 0; i < 4; ++i) ss += xv[r][i][0] * xv[r][i][0] + xv[r][i][1] * xv[r][i][1] + xv[r][i][2] * xv[r][i][2] + xv[r][i][3] * xv[r][i][3];
            ss = wave_sum(ss);
            const float rstd = rsqrtf(ss * (1.f / 1024.f) + EPS);
#pragma unroll
            for (int i = 0; i < 4; ++i) *(f32x4*)(p.out + ((size_t)rq * 4 + r) * D + i * 256 + lane * 4) = xv[r][i] * rstd * w[i]; }
    }
}

__global__ void __launch_bounds__(512, 2) fwd_megakernel(Params p) {
    extern __shared__ __attribute__((aligned(16))) unsigned char lds_raw[];
    LAS unsigned char* lds = (LAS unsigned char*)lds_raw;
    cg::grid_group grid = cg::this_grid();
    unsigned char* ws = p.ws;
    const int G = gridDim.x, bid = blockIdx.x;

    unsigned* barp = (unsigned*)(ws + WS_BAR);
    if (threadIdx.x < 4) ((LAS unsigned*)(lds + 138240))[threadIdx.x] = 0u;
    __syncthreads();
    XcdBarrier xb = xcd_barrier_post(barp, (volatile LAS unsigned*)(lds + 138240), (unsigned)G);
    if (p.ws == nullptr) grid.sync();
    phase0(p, lds);
    __syncthreads();
    phase1(p, lds);
    xcd_barrier(xb);
    {
        pg8::Gemm g{(const bf16_t*)(ws + WS_H), (const bf16_t*)(ws + WS_WT_IN), MTOK, 3072, 1024};
        pg8::StaticOrder S; S.init(MTOK, 3072, G, bid);
        pg8::EpiProj1<3072> E{(bf16_t*)(ws + WS_R1)};
        pg8::gemm_phase<pg8::EpiProj1<3072>, true>(lds, g, S, E);
    }
    xcd_barrier(xb);
    for (int base = bid; base < 2048; base += 8 * G) { int cnt = (2048 - base + G - 1) / G; if (cnt > 8) cnt = 8; chunk_prep_batch(p, lds, base, G, cnt); }
    xcd_barrier(xb);
    if (bid < 64) dn_scan(p, lds, bid);
    else {
        pg8::Gemm g{(const bf16_t*)(ws + WS_H), (const bf16_t*)(ws + WS_WT_IN) + (size_t)3072 * 1024, MTOK, 2304, 1024};
        pg8::StaticOrder S; S.init(MTOK, 2304, G - 64, bid - 64);
        pg8::EpiProj1<2304> E{(bf16_t*)(ws + WS_R1)};
        pg8::gemm_phase<pg8::EpiProj1<2304>, true>(lds, g, S, E);
        if (G == 256) {
            { XcdBarrier sb = xcd_barrier_post((unsigned*)(ws + WS_BAR + 32768), (volatile LAS unsigned*)(lds + 138248), 192u); xcd_barrier(sb); }
            attn_phase(p, lds, (bid - 64) * 4, (bid - 64) * 4 + 4);
        }
    }
    xcd_barrier(xb);
    {
        int a0, a1;
        if (G == 256) { if (bid < 192) { a0 = 768 + bid * 2; a1 = a0 + 2; } else { a0 = 1152 + (bid - 192) * 6; a1 = a0 + 6; } }
        else { const int per = (1536 + G - 1) / G; a0 = bid * per; a1 = a0 + per; if (a1 > 1536) a1 = 1536; }
        pg8::Gemm g{(const bf16_t*)(ws + WS_H), (const bf16_t*)(ws + WS_WT_IN) + (size_t)5376 * 1024, MTOK, 3840, 1024};
        pg8::StaticOrder S; S.init(MTOK, 3840, G, bid);
        pg8::EpiProjC E{ws, p.out};
        if (bid & 1) attn_phase(p, lds, a0, a1);
        pg8::gemm_phase<pg8::EpiProjC, true>(lds, g, S, E);
        if (!(bid & 1)) attn_phase(p, lds, a0, a1);
    }
    xcd_barrier(xb);
    ya_phase(p);
    yb_rows(p);
    xcd_barrier(xb);
    {
        pg8::StaticOrder S; S.init(MTOK, 1024, G, bid);
        pg8::Gemm g1{(const bf16_t*)(ws + WS_YA), (const bf16_t*)(ws + WS_WT_PA), MTOK, 1024, 1024};
        pg8::Gemm g2{(const bf16_t*)(ws + WS_OB), (const bf16_t*)(ws + WS_WT_PB), MTOK, 1024, 768};
        pg8::EpiMerge2 E{(bf16_t*)(ws + WS_H), (const bf16_t*)(ws + WS_R2)};
        pg8::Unit u; S.next(0, u);
        unsigned* pw = (unsigned*)(ws + WS_BAR + 49152) + u.pm * 64;
        panel_post_xcc(pw);
        pg8::gemm_phase2(lds, g1, g2, S, E);
        panel_handoff(pw);
    }
    {
        pg8::StaticOrder S; S.init(MTOK, 1024, G, bid);
        pg8::Gemm g{(const bf16_t*)(ws + WS_H), (const bf16_t*)(ws + WS_WT_O), MTOK, 1024, 1024};
        pg8::EpiOutNorm E{p.x, (const float*)(ws + WS_MOD), p.fnw, p.out, (float*)(ws + WS_RS), (unsigned*)(ws + WS_BAR + 16384)};
        pg8::gemm_phase(lds, g, S, E);
    }
}

extern "C" void kernel_launch(void* const* d_in, const int* in_sizes, int n_in, void* d_out, int out_size, void* d_ws, size_t ws_size, hipStream_t stream) {
    static int grid_blocks = 0;
    if (!grid_blocks) {
        int dev = 0, cus = 0, per_cu = 0;
        hipGetDevice(&dev);
        hipDeviceGetAttribute(&cus, hipDeviceAttributeMultiprocessorCount, dev);
        hipFuncSetAttribute((const void*)fwd_megakernel, hipFuncAttributeMaxDynamicSharedMemorySize, LDS_BYTES);
        hipOccupancyMaxActiveBlocksPerMultiprocessor(&per_cu, (const void*)fwd_megakernel, 512, LDS_BYTES);
        if (per_cu < 1) per_cu = 1;
        grid_blocks = cus;
        if (ws_size < WS_END) fprintf(stderr, "kernel_launch: workspace too small (%zu < %zu)\n", ws_size, (size_t)WS_END);
        (void)hipGetLastError();
    }
    Params p{};
    p.x = (const float*)d_in[0]; p.c = (const float*)d_in[1]; p.norm_w = (const float*)d_in[2]; p.ada_w = (const float*)d_in[3]; p.ada_b = (const float*)d_in[4];
    p.w_in = (const float*)d_in[5]; p.conv_w = (const float*)d_in[6]; p.a_log = (const float*)d_in[7]; p.dt_bias = (const float*)d_in[8]; p.dn_norm_w = (const float*)d_in[9];
    p.w_pa = (const float*)d_in[10]; p.w_pb = (const float*)d_in[11]; p.w_out = (const float*)d_in[12]; p.fnw = (const float*)d_in[13];
    p.out = (float*)d_out; p.ws = (unsigned char*)d_ws;
    (void)hipMemsetAsync((unsigned char*)d_ws + WS_BAR, 0, 65536, stream);
    void* args[] = {&p};
    hipError_t e = hipLaunchCooperativeKernel((const void*)fwd_megakernel, dim3(grid_blocks), dim3(512), args, LDS_BYTES, stream);
    if (e != hipSuccess) fprintf(stderr, "cooperative launch failed: %s (grid %d)\n", hipGetErrorString(e), grid_blocks);
}
```

```cpp
#include <hip/hip_runtime.h>
#include <hip/hip_cooperative_groups.h>
#include <cstdio>
namespace cg = cooperative_groups;

#define LAS __attribute__((address_space(3)))
typedef unsigned short bf16_t;
typedef short bf16x8 __attribute__((ext_vector_type(8)));
typedef float f32x4 __attribute__((ext_vector_type(4)));
typedef float f32x2 __attribute__((ext_vector_type(2)));
typedef unsigned u32x4 __attribute__((ext_vector_type(4)));
typedef unsigned u32x2 __attribute__((ext_vector_type(2)));
typedef __bf16 bf2_t __attribute__((ext_vector_type(2)));
#define DI __device__ __forceinline__

constexpr int D = 1024, NB = 8, SEQ = 2048, MTOK = NB * SEQ;
constexpr int N_IN = 9232;
constexpr float EPS = 1e-6f;
constexpr size_t MiB = 1048576;
constexpr size_t WS_WT_IN = 0;
constexpr size_t WS_WT_PA = 18 * MiB;
constexpr size_t WS_WT_PB = 20 * MiB;
constexpr size_t WS_WT_O  = 21 * MiB + 512 * 1024;
constexpr size_t WS_MOD   = 23 * MiB + 512 * 1024;
constexpr size_t WS_BETA  = WS_MOD + 128 * 1024;
constexpr size_t WS_G     = WS_BETA + 512 * 1024;
constexpr size_t WS_GL    = WS_G + 512 * 1024;
constexpr size_t WS_BAR   = WS_GL + 64 * 1024;
constexpr size_t WS_LSE   = 24 * MiB + 768 * 1024;
static_assert(WS_BAR + 4096 <= WS_LSE && WS_LSE + 768 * 1024 <= 26 * MiB, "ws map");
constexpr size_t WS_H     = 26 * MiB;
constexpr size_t WS_R1    = 58 * MiB;
constexpr size_t WS_OB    = WS_R1 + 72 * MiB;
constexpr size_t WS_R2    = 154 * MiB;
constexpr size_t WS_QD    = WS_R2;
constexpr size_t WS_KDT   = WS_R2 + 32 * MiB;
constexpr size_t WS_AG    = WS_R2 + 64 * MiB;
constexpr size_t WS_MODP  = 234 * MiB;
constexpr size_t WS_RS    = 25 * MiB + 512 * 1024;
constexpr size_t WS_ZB    = 218 * MiB;
constexpr size_t WS_YA    = WS_R1;
constexpr size_t WS_END   = 235 * MiB;
constexpr int LDS_BYTES = 138240 + 16;

struct Params {
    const float *x, *c, *norm_w, *ada_w, *ada_b, *w_in, *conv_w, *a_log, *dt_bias, *dn_norm_w, *w_pa, *w_pb, *w_out, *fnw;
    float* out; unsigned char* ws;
};

DI unsigned pk_bf16(float lo, float hi) { f32x2 v = {lo, hi}; bf2_t b = __builtin_convertvector(v, bf2_t); return __builtin_bit_cast(unsigned, b); }
DI bf16_t f2bf(float x) { return (bf16_t)(pk_bf16(x, 0.f) & 0xffffu); }
DI float bf2f(bf16_t b) { return __uint_as_float(((unsigned)b) << 16); }
DI float bflo(unsigned u) { return __uint_as_float(u << 16); }
DI float bfhi(unsigned u) { return __uint_as_float(u & 0xffff0000u); }
DI float sigmoidf_(float v) { return __builtin_amdgcn_rcpf(1.f + __builtin_amdgcn_exp2f(v * -1.4426950408889634f)); }
DI float siluf_(float v) { return v * __builtin_amdgcn_rcpf(1.f + __builtin_amdgcn_exp2f(v * -1.4426950408889634f)); }
template <int CTRL> DI float dpp_f(float v) { return __builtin_bit_cast(float, __builtin_amdgcn_update_dpp(0, __builtin_bit_cast(int, v), CTRL, 0xf, 0xf, false)); }
DI float wave_sum(float v) {
    v += dpp_f<0x128>(v); v += dpp_f<0x124>(v); v += dpp_f<0x122>(v); v += dpp_f<0x121>(v);
    const int iv = __builtin_bit_cast(int, v);
    return __builtin_bit_cast(float, __builtin_amdgcn_readlane(iv, 0)) + __builtin_bit_cast(float, __builtin_amdgcn_readlane(iv, 16))
         + __builtin_bit_cast(float, __builtin_amdgcn_readlane(iv, 32)) + __builtin_bit_cast(float, __builtin_amdgcn_readlane(iv, 48));
}
DI void reduce8(const float (&p)[8], float (&tot)[8], int lane) {
    const bool b5 = (lane & 32) != 0, b4 = (lane & 16) != 0, b3 = (lane & 8) != 0;
    float q[4], r2[2];
#pragma unroll
    for (int e = 0; e < 4; ++e) { const float send = b5 ? p[e] : p[e + 4], keep = b5 ? p[e + 4] : p[e]; q[e] = keep + __shfl_xor(send, 32); }
#pragma unroll
    for (int e = 0; e < 2; ++e) { const float send = b4 ? q[e] : q[e + 2], keep = b4 ? q[e + 2] : q[e]; r2[e] = keep + __shfl_xor(send, 16); }
    const float send = b3 ? r2[0] : r2[1], keep = b3 ? r2[1] : r2[0];
    float s = keep + dpp_f<0x128>(send);
    s += dpp_f<0xB1>(s);
    s += dpp_f<0x4E>(s);
    s += dpp_f<0x141>(s);
    const int iv = __builtin_bit_cast(int, s);
#pragma unroll
    for (int e = 0; e < 8; ++e) tot[e] = __builtin_bit_cast(float, __builtin_amdgcn_readlane(iv, 8 * e));
}
DI bf16x8 pack8(const f32x4& a, const f32x4& b) {
    u32x4 p; p[0] = pk_bf16(a[0], a[1]); p[1] = pk_bf16(a[2], a[3]); p[2] = pk_bf16(b[0], b[1]); p[3] = pk_bf16(b[2], b[3]);
    return __builtin_bit_cast(bf16x8, p);
}

#define XB_TMO      128
#define XB_XCNT(j)  (256  + 64 * (j))
#define XB_XSUB(j)  (1280 + 64 * (j))
#define XB_XGEN(j)  (2304 + 64 * (j))
#define XB_TOP      3328
#define XB_TOPGEN   3392
#define XCD_BAR_WORDS 3456
#define XB_SPIN_CAP (1u << 18)
DI unsigned xb_ld(unsigned* p)              { return __hip_atomic_load(p, __ATOMIC_RELAXED, __HIP_MEMORY_SCOPE_AGENT); }
DI unsigned xb_add(unsigned* p, unsigned v) { return __hip_atomic_fetch_add(p, v, __ATOMIC_RELAXED, __HIP_MEMORY_SCOPE_AGENT); }
DI unsigned xb_xcc_id() { return (unsigned)__builtin_amdgcn_s_getreg((3 << 11) | 20) & 0xFu; }
#define XB_SPIN(cond, bar) do { unsigned _sp = 0; while (cond) { __builtin_amdgcn_s_sleep(1); \
    if ((++_sp & 255u) == 0u) { if (xb_ld(&(bar)[XB_TMO])) break; if (_sp > XB_SPIN_CAP) { atomicAdd(&(bar)[XB_TMO], 1u); break; } } } } while (0)
struct XcdBarrier { unsigned* bar; unsigned x; volatile LAS unsigned* st; unsigned total; };
DI XcdBarrier xcd_barrier_post(unsigned* bar, volatile LAS unsigned* st, unsigned total) {
    XcdBarrier b; b.bar = bar; b.x = xb_xcc_id(); b.st = st; b.total = total;
    if (threadIdx.x == 0) (void)xb_add(&bar[XB_XCNT(b.x)], 1u);
    return b;
}
DI void xcd_barrier_complete(unsigned* bar, unsigned x, unsigned G, unsigned& nloc, unsigned& nx) {
    unsigned sum, cnt, mine, sp = 0u;
    for (;;) {
        sum = 0u; cnt = 0u; mine = 0u;
#pragma unroll
        for (unsigned j = 0; j < 16; ++j) { const unsigned c = xb_ld(&bar[XB_XCNT(j)]); sum += c; cnt += (c > 0u) ? 1u : 0u; mine = (j == x) ? c : mine; }
        if (sum == G) break;
        __builtin_amdgcn_s_sleep(1);
        if ((++sp & 255u) == 0u) { if (xb_ld(&bar[XB_TMO])) break; if (sp > XB_SPIN_CAP) { atomicAdd(&bar[XB_TMO], 1u); break; } }
    }
    nloc = mine > 0u ? mine : 1u; nx = cnt > 0u ? cnt : 1u;
}
DI void xcd_barrier(const XcdBarrier& b) {
    asm volatile("s_waitcnt vmcnt(0)" ::: "memory");
    __syncthreads();
    if (threadIdx.x == 0) {
        unsigned* bar = b.bar;
        __builtin_amdgcn_s_waitcnt(0);
        unsigned nloc = b.st[0], nx = b.st[1];
        if (nloc == 0u) { xcd_barrier_complete(bar, b.x, b.total, nloc, nx); b.st[0] = nloc; b.st[1] = nx; }
        const unsigned old = xb_add(&bar[XB_XSUB(b.x)], 1u);
        const unsigned gen = old / nloc;
        if (old + 1u == (gen + 1u) * nloc) {
            __builtin_amdgcn_fence(__ATOMIC_RELEASE, "agent");
            asm volatile("s_waitcnt vmcnt(0)" ::: "memory");
            const unsigned og = xb_add(&bar[XB_TOP], 1u);
            const unsigned tg = og / nx;
            if (og + 1u == (tg + 1u) * nx) xb_add(&bar[XB_TOPGEN], 1u);
            else XB_SPIN(xb_ld(&bar[XB_TOPGEN]) == tg, bar);
            __builtin_amdgcn_fence(__ATOMIC_ACQUIRE, "agent");
            xb_add(&bar[XB_XGEN(b.x)], 1u);
            asm volatile("s_waitcnt vmcnt(0)" ::: "memory");
        } else {
            XB_SPIN(xb_ld(&bar[XB_XGEN(b.x)]) == gen, bar);
            __builtin_amdgcn_fence(__ATOMIC_ACQUIRE, "agent");
            asm volatile("s_waitcnt vmcnt(0)" ::: "memory");
        }
    }
    __syncthreads();
}
DI void subset_barrier(unsigned* ctr, unsigned nblk) {
    asm volatile("s_waitcnt vmcnt(0)" ::: "memory");
    __syncthreads();
    if (threadIdx.x == 0) {
        __builtin_amdgcn_fence(__ATOMIC_RELEASE, "agent");
        asm volatile("s_waitcnt vmcnt(0)" ::: "memory");
        __hip_atomic_fetch_add(ctr, 1u, __ATOMIC_RELAXED, __HIP_MEMORY_SCOPE_AGENT);
        unsigned sp = 0;
        while (__hip_atomic_load(ctr, __ATOMIC_RELAXED, __HIP_MEMORY_SCOPE_AGENT) < nblk) { __builtin_amdgcn_s_sleep(2); if (++sp > (1u << 24)) break; }
        __builtin_amdgcn_fence(__ATOMIC_ACQUIRE, "agent");
        asm volatile("s_waitcnt vmcnt(0)" ::: "memory");
    }
    __syncthreads();
}
DI void panel_post_xcc(unsigned* w) {
    if (threadIdx.x == 0) { __hip_atomic_fetch_add(w, 1u << (3u * (xb_xcc_id() & 7u)), __ATOMIC_RELAXED, __HIP_MEMORY_SCOPE_AGENT); __hip_atomic_fetch_add(w + 16, 1u, __ATOMIC_RELAXED, __HIP_MEMORY_SCOPE_AGENT); }
}
DI void panel_handoff(unsigned* w) {
    asm volatile("s_waitcnt vmcnt(0)" ::: "memory");
    __syncthreads();
    if (threadIdx.x == 0) {
        unsigned sp = 0;
        while (__hip_atomic_load(w + 16, __ATOMIC_RELAXED, __HIP_MEMORY_SCOPE_AGENT) < 4u) { __builtin_amdgcn_s_sleep(1); if (++sp > (1u << 24)) break; }
        const bool same = __hip_atomic_load(w, __ATOMIC_RELAXED, __HIP_MEMORY_SCOPE_AGENT) == (4u << (3u * (xb_xcc_id() & 7u)));
        if (!same) { __builtin_amdgcn_fence(__ATOMIC_RELEASE, "agent"); asm volatile("s_waitcnt vmcnt(0)" ::: "memory"); }
        __hip_atomic_fetch_add(w + 32, 1u, __ATOMIC_RELAXED, __HIP_MEMORY_SCOPE_AGENT);
        sp = 0;
        while (__hip_atomic_load(w + 32, __ATOMIC_RELAXED, __HIP_MEMORY_SCOPE_AGENT) < 4u) { __builtin_amdgcn_s_sleep(1); if (++sp > (1u << 24)) break; }
        if (!same) { __builtin_amdgcn_fence(__ATOMIC_ACQUIRE, "agent"); asm volatile("s_waitcnt vmcnt(0)" ::: "memory"); }
    }
    __syncthreads();
}
#define MFMA16(a, b, c) __builtin_amdgcn_mfma_f32_16x16x32_bf16((a), (b), (c), 0, 0, 0)

namespace pg8 {
constexpr int BM = 256, BK = 64, HALF = 128, HTB = HALF * BK * 2, STAGE_BYTES = 8 * HTB, NXCD = 8, WGM = 8;
DI int lds_byte(int r, int c) { const int st = (r >> 4) * 2 + (c >> 5), rr = r & 15, cc = c & 31, ob = rr * 64 + cc * 2; return st * 1024 + (ob ^ (((ob >> 9) & 1) << 5)); }
DI void stage_rc(int b, int& R, int& C) { const int st = b / 1024, sb = b % 1024, swz = sb ^ (((sb >> 9) & 1) << 5); R = (st >> 1) * 16 + swz / 64; C = (st & 1) * 32 + (swz % 64) / 2; }
DI int perm32(int rho) { const int n = rho >> 4, i = rho & 15; return 8 * (i >> 2) + 4 * n + (i & 3); }
struct Unit { int pm, pn; };
struct Gemm { const bf16_t* A; const bf16_t* Bt; int M, N, K; };
struct StaticOrder {
    int nM, nN, nwg, G, c;
    DI void init(int M, int N, int G_, int c_) { nM = M / BM; nN = N / BM; nwg = nM * nN; G = G_; c = c_; }
    DI bool next(int i, Unit& u) const {
        const long L = (long)i * G + c; if (L >= nwg) return false;
        int wgid = (int)L; { const int q = nwg / NXCD, r = nwg % NXCD, xcd = wgid % NXCD, off = wgid / NXCD; wgid = (xcd < r ? xcd * (q + 1) : r * (q + 1) + (xcd - r) * q) + off; }
        const int nig = WGM * nN, gid = wgid / nig, fm = gid * WGM, gsz = (nM - fm) < WGM ? (nM - fm) : WGM;
        u.pm = fm + ((wgid % nig) % gsz); u.pn = (wgid % nig) / gsz; return true;
    }
};

template <class Epi, bool ALIGN_EPI = false>
DI void gemm_phase(LAS unsigned char* lds, const Gemm g, const StaticOrder& S, const Epi& E) {
    int tid = threadIdx.x; asm volatile("" : "+v"(tid));
    const int wid = __builtin_amdgcn_readfirstlane(tid >> 6), lane = tid & 63, wr = wid >> 2, wc = wid & 3, fr = lane & 15, fq = lane >> 4;
    const int K = g.K, nt = K / BK;
    unsigned voffA[2], voffB[2];
#pragma unroll
    for (int i = 0; i < 2; ++i) { int R, C; stage_rc(tid * 16 + i * 8192, R, C); const int Rb = Epi::PERM ? ((R & ~31) + perm32(R & 31)) : R;
        voffA[i] = (unsigned)(R * K + C) * 2u; voffB[i] = (unsigned)(Rb * K + C) * 2u; }
    const size_t kstep = (size_t)(BK * 2);
    const size_t hstep = (size_t)HALF * K * 2;
    const size_t tstep = 2 * hstep;
    const unsigned ldsw = (unsigned)wid * 1024u;
    const int aoff = lds_byte(wr * 64 + fr, fq * 8), boff = lds_byte(wc * 32 + fr, fq * 8);
#define PG8_SA(b, h) (((b) * 2 + (h)) * HTB)
#define PG8_SB(b, h) ((4 + (b) * 2 + (h)) * HTB)
#define PG8_STAGE(bufoff, gbase, voff) do { _Pragma("unroll") for (int _i = 0; _i < 2; ++_i) \
        __builtin_amdgcn_global_load_lds((const unsigned*)((const char*)(gbase) + (voff)[_i]), (LAS unsigned*)(lds + (bufoff) + ldsw + _i * 8192), 16, 0, 0); } while (0)
#define PG8_LDA(dst, b, h) do { _Pragma("unroll") for (int m = 0; m < 4; ++m) _Pragma("unroll") for (int k = 0; k < 2; ++k) dst[m][k] = *(const LAS bf16x8*)(lds + PG8_SA(b, h) + aoff + m * 2048 + k * 1024); } while (0)
#define PG8_LDB(dst, b, h) do { _Pragma("unroll") for (int n = 0; n < 2; ++n) _Pragma("unroll") for (int k = 0; k < 2; ++k) dst[n][k] = *(const LAS bf16x8*)(lds + PG8_SB(b, h) + boff + n * 2048 + k * 1024); } while (0)
#define PG8_MMA(ai, bj, At, Bt) do { __builtin_amdgcn_s_setprio(1); _Pragma("unroll") for (int m = 0; m < 4; ++m) _Pragma("unroll") for (int n = 0; n < 2; ++n) _Pragma("unroll") for (int k = 0; k < 2; ++k) \
        acc[ai][bj][m][n] = __builtin_amdgcn_mfma_f32_16x16x32_bf16(Bt[n][k], At[m][k], acc[ai][bj][m][n], 0, 0, 0); __builtin_amdgcn_s_setprio(0); } while (0)
#define PG8_WAIT_V(n) asm volatile("s_waitcnt vmcnt(" #n ")" ::: "memory")
#define PG8_WAIT_L(n) asm volatile("s_waitcnt lgkmcnt(" #n ")" ::: "memory")
#define PG8_BAR __builtin_amdgcn_s_barrier()
#define PG8_SCHED __builtin_amdgcn_sched_barrier(0)
    Unit cur, nxt; int ui = 0;
    if (!S.next(0, cur)) return;
    f32x4 acc[2][2][4][2];
#pragma unroll
    for (int a = 0; a < 2; ++a)
#pragma unroll
        for (int b = 0; b < 2; ++b)
#pragma unroll
            for (int m = 0; m < 4; ++m)
#pragma unroll
                for (int n = 0; n < 2; ++n) acc[a][b][m][n] = (f32x4){0.f, 0.f, 0.f, 0.f};
    bf16x8 At[4][2], B0[2][2], B1[2][2];
    const char* cA = (const char*)g.A + (size_t)cur.pm * tstep; const char* cB = (const char*)g.Bt + (size_t)cur.pn * tstep;
    PG8_STAGE(PG8_SB(0, 0), cB, voffB); PG8_STAGE(PG8_SB(0, 1), cB + hstep, voffB); PG8_STAGE(PG8_SA(0, 0), cA, voffA); PG8_STAGE(PG8_SA(0, 1), cA + hstep, voffA);
    if (wr == 1) PG8_BAR;
    PG8_WAIT_V(2); PG8_BAR;
    PG8_STAGE(PG8_SB(1, 0), cB + kstep, voffB); PG8_STAGE(PG8_SA(1, 0), cA + kstep, voffA); PG8_STAGE(PG8_SB(1, 1), cB + hstep + kstep, voffB);
    PG8_WAIT_V(6); PG8_BAR;
    for (;;) {
        const bool has_next = S.next(ui + 1, nxt);
        const char* nA = has_next ? (const char*)g.A + (size_t)nxt.pm * tstep : cA; const char* nB = has_next ? (const char*)g.Bt + (size_t)nxt.pn * tstep : cB;
        for (int t = 0; t < nt; t += 2) {
            const bool last = (t == nt - 2);
            const char* a1 = cA + (size_t)(t + 1) * kstep;
            const char* a2 = last ? nA : cA + (size_t)(t + 2) * kstep; const char* b2 = last ? nB : cB + (size_t)(t + 2) * kstep;
            const char* a3 = a2 + kstep; const char* b3 = b2 + kstep;
            PG8_LDB(B0, 0, 0); PG8_LDB(B1, 0, 1); PG8_SCHED; PG8_LDA(At, 0, 0); PG8_STAGE(PG8_SA(1, 1), a1 + hstep, voffA);
            PG8_WAIT_V(8); PG8_WAIT_L(0); PG8_BAR; PG8_MMA(0, 0, At, B0); PG8_MMA(0, 1, At, B1); PG8_BAR; PG8_SCHED;
            PG8_LDA(At, 0, 1); PG8_STAGE(PG8_SB(0, 0), b2, voffB); PG8_STAGE(PG8_SB(0, 1), b2 + hstep, voffB); PG8_STAGE(PG8_SA(0, 0), a2, voffA);
            PG8_WAIT_V(8); PG8_WAIT_L(0); PG8_BAR; PG8_MMA(1, 0, At, B0); PG8_MMA(1, 1, At, B1); PG8_BAR; PG8_SCHED;
            PG8_LDB(B0, 1, 0); PG8_LDB(B1, 1, 1); PG8_SCHED; PG8_LDA(At, 1, 0); PG8_STAGE(PG8_SA(0, 1), a2 + hstep, voffA);
            PG8_WAIT_V(8); PG8_WAIT_L(0); PG8_BAR; PG8_MMA(0, 0, At, B0); PG8_MMA(0, 1, At, B1); PG8_BAR; PG8_SCHED;
            PG8_LDA(At, 1, 1); PG8_STAGE(PG8_SB(1, 0), b3, voffB); PG8_STAGE(PG8_SB(1, 1), b3 + hstep, voffB); PG8_STAGE(PG8_SA(1, 0), a3, voffA);
            PG8_WAIT_V(8); PG8_WAIT_L(0); PG8_BAR; PG8_MMA(1, 0, At, B0); PG8_MMA(1, 1, At, B1); PG8_BAR; PG8_SCHED;
        }
        if constexpr (ALIGN_EPI) { if (wr == 0) PG8_BAR; }
        if constexpr (!Epi::AFTER_DRAIN) E(acc, cur, wr, wc, fr, fq);
        if (!has_next) break;
#pragma unroll
        for (int a = 0; a < 2; ++a)
#pragma unroll
            for (int b = 0; b < 2; ++b)
#pragma unroll
                for (int m = 0; m < 4; ++m)
#pragma unroll
                    for (int n = 0; n < 2; ++n) acc[a][b][m][n] = (f32x4){0.f, 0.f, 0.f, 0.f};
        cur = nxt; cA = nA; cB = nB; ++ui;
        if constexpr (ALIGN_EPI) { if (wr == 1) PG8_BAR; }
    }
    PG8_WAIT_V(0);
    if constexpr (!ALIGN_EPI) { if (wr == 0) PG8_BAR; }
    PG8_BAR;
    if constexpr (Epi::AFTER_DRAIN) E.fused(acc, cur, wr, wc, fr, fq, lds);
#undef PG8_SA
#undef PG8_SB
#undef PG8_STAGE
#undef PG8_LDA
#undef PG8_LDB
#undef PG8_MMA
#undef PG8_WAIT_V
#undef PG8_WAIT_L
#undef PG8_BAR
#undef PG8_SCHED
}

template <class Epi>
DI void gemm_phase2(LAS unsigned char* lds, const Gemm g0, const Gemm g1, const StaticOrder& S, const Epi& E) {
    int tid = threadIdx.x; asm volatile("" : "+v"(tid));
    const int wid = __builtin_amdgcn_readfirstlane(tid >> 6), lane = tid & 63, wr = wid >> 2, wc = wid & 3, fr = lane & 15, fq = lane >> 4;
    unsigned rA[2], rB[2], c2[2];
#pragma unroll
    for (int i = 0; i < 2; ++i) { int R, C; stage_rc(tid * 16 + i * 8192, R, C); const int Rb = Epi::PERM ? ((R & ~31) + perm32(R & 31)) : R;
        rA[i] = (unsigned)R; rB[i] = (unsigned)Rb; c2[i] = (unsigned)C * 2u; }
    const unsigned k20 = (unsigned)g0.K * 2u, k21 = (unsigned)g1.K * 2u;
    const size_t kstep = (size_t)(BK * 2);
    const size_t hs0 = (size_t)HALF * g0.K * 2, hs1 = (size_t)HALF * g1.K * 2;
    const unsigned ldsw = (unsigned)wid * 1024u;
    const int aoff = lds_byte(wr * 64 + fr, fq * 8), boff = lds_byte(wc * 32 + fr, fq * 8);
#define PG8_SA(b, h) (((b) * 2 + (h)) * HTB)
#define PG8_SB(b, h) ((4 + (b) * 2 + (h)) * HTB)
#define PG8_STAGE(bufoff, gbase, rowv, k2) do { _Pragma("unroll") for (int _i = 0; _i < 2; ++_i) \
        __builtin_amdgcn_global_load_lds((const unsigned*)((const char*)(gbase) + ((rowv)[_i] * (k2) + c2[_i])), (LAS unsigned*)(lds + (bufoff) + ldsw + _i * 8192), 16, 0, 0); } while (0)
#define PG8_LDA(dst, b, h) do { _Pragma("unroll") for (int m = 0; m < 4; ++m) _Pragma("unroll") for (int k = 0; k < 2; ++k) dst[m][k] = *(const LAS bf16x8*)(lds + PG8_SA(b, h) + aoff + m * 2048 + k * 1024); } while (0)
#define PG8_LDB(dst, b, h) do { _Pragma("unroll") for (int n = 0; n < 2; ++n) _Pragma("unroll") for (int k = 0; k < 2; ++k) dst[n][k] = *(const LAS bf16x8*)(lds + PG8_SB(b, h) + boff + n * 2048 + k * 1024); } while (0)
#define PG8_MMA(ai, bj, At, Bt) do { __builtin_amdgcn_s_setprio(1); _Pragma("unroll") for (int m = 0; m < 4; ++m) _Pragma("unroll") for (int n = 0; n < 2; ++n) _Pragma("unroll") for (int k = 0; k < 2; ++k) \
        acc[ai][bj][m][n] = __builtin_amdgcn_mfma_f32_16x16x32_bf16(Bt[n][k], At[m][k], acc[ai][bj][m][n], 0, 0, 0); __builtin_amdgcn_s_setprio(0); } while (0)
#define PG8_WAIT_V(n) asm volatile("s_waitcnt vmcnt(" #n ")" ::: "memory")
#define PG8_WAIT_L(n) asm volatile("s_waitcnt lgkmcnt(" #n ")" ::: "memory")
#define PG8_BAR __builtin_amdgcn_s_barrier()
#define PG8_SCHED __builtin_amdgcn_sched_barrier(0)
    Unit cur;
    if (!S.next(0, cur)) return;
    f32x4 acc[2][2][4][2];
#pragma unroll
    for (int a = 0; a < 2; ++a)
#pragma unroll
        for (int b = 0; b < 2; ++b)
#pragma unroll
            for (int m = 0; m < 4; ++m)
#pragma unroll
                for (int n = 0; n < 2; ++n) acc[a][b][m][n] = (f32x4){0.f, 0.f, 0.f, 0.f};
    bf16x8 At[4][2], B0[2][2], B1[2][2];
    const char* cA = (const char*)g0.A + (size_t)cur.pm * 2 * hs0; const char* cB = (const char*)g0.Bt + (size_t)cur.pn * 2 * hs0;
    {   PG8_STAGE(PG8_SB(0, 0), cB, rB, k20); PG8_STAGE(PG8_SB(0, 1), cB + hs0, rB, k20); PG8_STAGE(PG8_SA(0, 0), cA, rA, k20); PG8_STAGE(PG8_SA(0, 1), cA + hs0, rA, k20);
        if (wr == 1) PG8_BAR;
        PG8_WAIT_V(2); PG8_BAR;
        PG8_STAGE(PG8_SB(1, 0), cB + kstep, rB, k20); PG8_STAGE(PG8_SA(1, 0), cA + kstep, rA, k20); PG8_STAGE(PG8_SB(1, 1), cB + hs0 + kstep, rB, k20);
        PG8_WAIT_V(6); PG8_BAR; }
#define PG8_KLOOP(ntc, hsc, k2c, nA, nB, hsn, k2n) \
        for (int t = 0; t < (ntc); t += 2) { \
            const bool last = (t == (ntc) - 2); \
            const char* a1 = cA + (size_t)(t + 1) * kstep; \
            const char* a2 = last ? (nA) : cA + (size_t)(t + 2) * kstep; const char* b2 = last ? (nB) : cB + (size_t)(t + 2) * kstep; \
            const char* a3 = a2 + kstep; const char* b3 = b2 + kstep; \
            const size_t hs2 = last ? (hsn) : (hsc); const unsigned k22 = last ? (k2n) : (k2c); \
            PG8_LDB(B0, 0, 0); PG8_LDB(B1, 0, 1); PG8_SCHED; PG8_LDA(At, 0, 0); PG8_STAGE(PG8_SA(1, 1), a1 + (hsc), rA, (k2c)); \
            PG8_WAIT_V(8); PG8_WAIT_L(0); PG8_BAR; PG8_MMA(0, 0, At, B0); PG8_MMA(0, 1, At, B1); PG8_BAR; PG8_SCHED; \
            PG8_LDA(At, 0, 1); PG8_STAGE(PG8_SB(0, 0), b2, rB, k22); PG8_STAGE(PG8_SB(0, 1), b2 + hs2, rB, k22); PG8_STAGE(PG8_SA(0, 0), a2, rA, k22); \
            PG8_WAIT_V(8); PG8_WAIT_L(0); PG8_BAR; PG8_MMA(1, 0, At, B0); PG8_MMA(1, 1, At, B1); PG8_BAR; PG8_SCHED; \
            PG8_LDB(B0, 1, 0); PG8_LDB(B1, 1, 1); PG8_SCHED; PG8_LDA(At, 1, 0); PG8_STAGE(PG8_SA(0, 1), a2 + hs2, rA, k22); \
            PG8_WAIT_V(8); PG8_WAIT_L(0); PG8_BAR; PG8_MMA(0, 0, At, B0); PG8_MMA(0, 1, At, B1); PG8_BAR; PG8_SCHED; \
            PG8_LDA(At, 1, 1); PG8_STAGE(PG8_SB(1, 0), b3, rB, k22); PG8_STAGE(PG8_SB(1, 1), b3 + hs2, rB, k22); PG8_STAGE(PG8_SA(1, 0), a3, rA, k22); \
            PG8_WAIT_V(8); PG8_WAIT_L(0); PG8_BAR; PG8_MMA(1, 0, At, B0); PG8_MMA(1, 1, At, B1); PG8_BAR; PG8_SCHED; \
        }
    const int nt0 = g0.K / BK, nt1 = g1.K / BK;
    {
        const char* pA1 = (const char*)g1.A + (size_t)cur.pm * 2 * hs1; const char* pB1 = (const char*)g1.Bt + (size_t)cur.pn * 2 * hs1;
        PG8_KLOOP(nt0, hs0, k20, pA1, pB1, hs1, k21)
        E.mid(acc, cur, wr, wc, fr, fq);
        cA = pA1; cB = pB1;
        PG8_KLOOP(nt1, hs1, k21, cA, cB, hs1, k21)
        E(acc, cur, wr, wc, fr, fq);
    }
#undef PG8_KLOOP
    PG8_WAIT_V(0);
    if (wr == 0) PG8_BAR;
    PG8_BAR;
#undef PG8_SA
#undef PG8_SB
#undef PG8_STAGE
#undef PG8_LDA
#undef PG8_LDB
#undef PG8_MMA
#undef PG8_WAIT_V
#undef PG8_WAIT_L
#undef PG8_BAR
#undef PG8_SCHED
}

template <int ACT> DI void epi_store8(bf16_t* dstp, f32x4 v0, f32x4 v1) {
    if (ACT == 1) {
#pragma unroll
        for (int e = 0; e < 4; ++e) { v0[e] = siluf_(v0[e]); v1[e] = siluf_(v1[e]); }
    } else if (ACT == 2) {
#pragma unroll
        for (int e = 0; e < 4; ++e) { v0[e] = sigmoidf_(v0[e]); v1[e] = sigmoidf_(v1[e]); }
    }
    u32x4 o; o[0] = pk_bf16(v0[0], v0[1]); o[1] = pk_bf16(v0[2], v0[3]); o[2] = pk_bf16(v1[0], v1[1]); o[3] = pk_bf16(v1[2], v1[3]);
    *(u32x4*)dstp = o;
}
template <int LD> struct EpiProj1 {
    static constexpr bool PERM = true, AFTER_DRAIN = false;
    bf16_t* dst;
    DI void operator()(const f32x4 (&acc)[2][2][4][2], const Unit& u, int wr, int wc, int fr, int fq) const {
        const int row0 = u.pm * BM + wr * 64 + fr, col0 = u.pn * BM + wc * 32 + 8 * fq;
#pragma unroll
        for (int ai = 0; ai < 2; ++ai)
#pragma unroll
            for (int m = 0; m < 4; ++m) { bf16_t* rowp = dst + (size_t)(row0 + ai * HALF + m * 16) * LD + col0;
#pragma unroll
                for (int bj = 0; bj < 2; ++bj) epi_store8<0>(rowp + bj * HALF, acc[ai][bj][m][0], acc[ai][bj][m][1]); }
    }
};
struct EpiProjC {
    static constexpr bool PERM = true, AFTER_DRAIN = false;
    unsigned char* ws; float* out;
    DI void operator()(const f32x4 (&acc)[2][2][4][2], const Unit& u, int wr, int wc, int fr, int fq) const {
        const int row0 = u.pm * BM + wr * 64 + fr, cw = wc * 32 + 8 * fq;
        if (u.pn < 4) { bf16_t* base = (bf16_t*)out + (size_t)MTOK * D + u.pn * BM + cw;
#pragma unroll
            for (int ai = 0; ai < 2; ++ai)
#pragma unroll
                for (int m = 0; m < 4; ++m)
#pragma unroll
                    for (int bj = 0; bj < 2; ++bj) epi_store8<1>(base + (size_t)(row0 + ai * HALF + m * 16) * 1024 + bj * HALF, acc[ai][bj][m][0], acc[ai][bj][m][1]);
        } else if (u.pn < 7) { bf16_t* base = (bf16_t*)(ws + WS_ZB) + (u.pn - 4) * BM + cw;
#pragma unroll
            for (int ai = 0; ai < 2; ++ai)
#pragma unroll
                for (int m = 0; m < 4; ++m)
#pragma unroll
                    for (int bj = 0; bj < 2; ++bj) epi_store8<1>(base + (size_t)(row0 + ai * HALF + m * 16) * 768 + bj * HALF, acc[ai][bj][m][0], acc[ai][bj][m][1]);
        } else { bf16_t* base = (bf16_t*)(ws + WS_R2) + (u.pn - 7) * BM + cw;
#pragma unroll
            for (int ai = 0; ai < 2; ++ai)
#pragma unroll
                for (int m = 0; m < 4; ++m)
#pragma unroll
                    for (int bj = 0; bj < 2; ++bj) epi_store8<2>(base + (size_t)(row0 + ai * HALF + m * 16) * 2048 + bj * HALF, acc[ai][bj][m][0], acc[ai][bj][m][1]);
        }
    }
};
struct EpiGate {
    static constexpr bool PERM = true, AFTER_DRAIN = false;
    bf16_t* T; const bf16_t* sg; int ldsg; int mode;
    DI void operator()(const f32x4 (&acc)[2][2][4][2], const Unit& u, int wr, int wc, int fr, int fq) const {
        const int row0 = u.pm * BM + wr * 64 + fr, col0 = u.pn * BM + wc * 32 + 8 * fq;
#pragma unroll
        for (int ai = 0; ai < 2; ++ai)
#pragma unroll
            for (int m = 0; m < 4; ++m) { const size_t row = (size_t)(row0 + ai * HALF + m * 16);
#pragma unroll
                for (int bj = 0; bj < 2; ++bj) { const f32x4 v0 = acc[ai][bj][m][0], v1 = acc[ai][bj][m][1];
                    const u32x4 s = *(const u32x4*)(sg + row * ldsg + col0 + bj * HALF);
                    float r[8] = { bflo(s[0]) * v0[0], bfhi(s[0]) * v0[1], bflo(s[1]) * v0[2], bfhi(s[1]) * v0[3], bflo(s[2]) * v1[0], bfhi(s[2]) * v1[1], bflo(s[3]) * v1[2], bfhi(s[3]) * v1[3] };
                    bf16_t* tp = T + row * D + col0 + bj * HALF;
                    if (mode == 1) { const u32x4 t = *(const u32x4*)tp;
                        r[0] += bflo(t[0]); r[1] += bfhi(t[0]); r[2] += bflo(t[1]); r[3] += bfhi(t[1]); r[4] += bflo(t[2]); r[5] += bfhi(t[2]); r[6] += bflo(t[3]); r[7] += bfhi(t[3]); }
                    u32x4 o; o[0] = pk_bf16(r[0], r[1]); o[1] = pk_bf16(r[2], r[3]); o[2] = pk_bf16(r[4], r[5]); o[3] = pk_bf16(r[6], r[7]);
                    *(u32x4*)tp = o; } }
    }
};
struct EpiMerge2 {
    static constexpr bool PERM = true, AFTER_DRAIN = false;
    bf16_t* out; const bf16_t* gt;
    DI void mid(f32x4 (&acc)[2][2][4][2], const Unit& u, int wr, int wc, int fr, int fq) const {
        int row0 = u.pm * BM + wr * 64 + fr, col0 = u.pn * BM + wc * 32 + 8 * fq;
        asm volatile("" : "+v"(row0), "+v"(col0));
#pragma unroll
        for (int ai = 0; ai < 2; ++ai)
#pragma unroll
            for (int m = 0; m < 4; ++m) { const bf16_t* gp = gt + (size_t)(row0 + ai * HALF + m * 16) * 2048 + col0;
#pragma unroll
                for (int bj = 0; bj < 2; ++bj) { const u32x4 sa = *(const u32x4*)(gp + bj * HALF), sb = *(const u32x4*)(gp + 1024 + bj * HALF);
#pragma unroll
                    for (int e = 0; e < 2; ++e) {
                        acc[ai][bj][m][0][2 * e]     *= bflo(sa[e]) * __builtin_amdgcn_rcpf(fmaxf(bflo(sb[e]), 1e-20f));
                        acc[ai][bj][m][0][2 * e + 1] *= bfhi(sa[e]) * __builtin_amdgcn_rcpf(fmaxf(bfhi(sb[e]), 1e-20f));
                        acc[ai][bj][m][1][2 * e]     *= bflo(sa[2 + e]) * __builtin_amdgcn_rcpf(fmaxf(bflo(sb[2 + e]), 1e-20f));
                        acc[ai][bj][m][1][2 * e + 1] *= bfhi(sa[2 + e]) * __builtin_amdgcn_rcpf(fmaxf(bfhi(sb[2 + e]), 1e-20f)); } }
                if (m & 1) __builtin_amdgcn_sched_barrier(0); }
    }
    DI void operator()(const f32x4 (&acc)[2][2][4][2], const Unit& u, int wr, int wc, int fr, int fq) const {
        int row0 = u.pm * BM + wr * 64 + fr, col0 = u.pn * BM + wc * 32 + 8 * fq;
        asm volatile("" : "+v"(row0), "+v"(col0));
#pragma unroll
        for (int ai = 0; ai < 2; ++ai)
#pragma unroll
            for (int m = 0; m < 4; ++m) { const size_t row = (size_t)(row0 + ai * HALF + m * 16);
#pragma unroll
                for (int bj = 0; bj < 2; ++bj) { const f32x4 v0 = acc[ai][bj][m][0], v1 = acc[ai][bj][m][1];
                    const u32x4 sb = *(const u32x4*)(gt + row * 2048 + 1024 + col0 + bj * HALF);
                    u32x4 o;
                    o[0] = pk_bf16(v0[0] * fmaxf(bflo(sb[0]), 1e-20f), v0[1] * fmaxf(bfhi(sb[0]), 1e-20f)); o[1] = pk_bf16(v0[2] * fmaxf(bflo(sb[1]), 1e-20f), v0[3] * fmaxf(bfhi(sb[1]), 1e-20f));
                    o[2] = pk_bf16(v1[0] * fmaxf(bflo(sb[2]), 1e-20f), v1[1] * fmaxf(bfhi(sb[2]), 1e-20f)); o[3] = pk_bf16(v1[2] * fmaxf(bflo(sb[3]), 1e-20f), v1[3] * fmaxf(bfhi(sb[3]), 1e-20f));
                    *(u32x4*)(out + row * D + col0 + bj * HALF) = o; } }
    }
};
struct EpiOutNorm {
    static constexpr bool PERM = false, AFTER_DRAIN = true;
    const float* x; const float* mod; const float* fnw; float* out; float* rs; unsigned* cnt;
    DI void operator()(const f32x4 (&)[2][2][4][2], const Unit&, int, int, int, int) const {}
    DI void fused(f32x4 (&acc)[2][2][4][2], const Unit& u, int wr, int wc, int fr, int fq, LAS unsigned char* lds) const {
        const int tid = threadIdx.x;
        const int row0 = u.pm * BM + wr * 64 + fr, col0 = u.pn * BM + wc * 32 + 4 * fq;
        const int b = (u.pm * BM) / SEQ;
        LAS float* part = (LAS float*)lds;
        LAS float* rstd_l = (LAS float*)(lds + 4096);
        f32x4 gv[2][2];
#pragma unroll
        for (int bj = 0; bj < 2; ++bj)
#pragma unroll
            for (int n = 0; n < 2; ++n) gv[bj][n] = *(const f32x4*)(mod + b * 3072 + 2048 + col0 + bj * HALF + n * 16);
#pragma unroll
        for (int ai = 0; ai < 2; ++ai)
#pragma unroll
            for (int m = 0; m < 4; ++m) { const size_t ro = (size_t)(row0 + ai * HALF + m * 16) * D + col0;
                float ss = 0.f;
#pragma unroll
                for (int bj = 0; bj < 2; ++bj)
#pragma unroll
                    for (int n = 0; n < 2; ++n) { const f32x4 xv = *(const f32x4*)(x + ro + bj * HALF + n * 16);
                        const f32x4 v = xv + gv[bj][n] * acc[ai][bj][m][n]; acc[ai][bj][m][n] = v;
                        ss += v[0] * v[0] + v[1] * v[1] + v[2] * v[2] + v[3] * v[3]; }
                ss += __shfl_xor(ss, 16); ss += __shfl_xor(ss, 32);
                if (fq == 0) part[wc * 256 + ai * HALF + wr * 64 + m * 16 + fr] = ss; }
        __syncthreads();
        if (tid < 256) __hip_atomic_store(rs + (size_t)(u.pm * 4 + u.pn) * 256 + tid, part[tid] + part[256 + tid] + part[512 + tid] + part[768 + tid], __ATOMIC_RELAXED, __HIP_MEMORY_SCOPE_AGENT);
        asm volatile("s_waitcnt vmcnt(0)" ::: "memory");
        __syncthreads();
        if (tid == 0) {
            unsigned* c = cnt + u.pm * 16;
            __hip_atomic_fetch_add(c, 1u, __ATOMIC_RELAXED, __HIP_MEMORY_SCOPE_AGENT);
            unsigned sp = 0;
            while (__hip_atomic_load(c, __ATOMIC_RELAXED, __HIP_MEMORY_SCOPE_AGENT) < 4u) { __builtin_amdgcn_s_sleep(1); if (++sp > (1u << 24)) break; }
        }
        __syncthreads();
        if (tid < 256) { float* rp = rs + (size_t)(u.pm * 4) * 256 + tid;
            const float tot = __hip_atomic_load(rp, __ATOMIC_RELAXED, __HIP_MEMORY_SCOPE_AGENT) + __hip_atomic_load(rp + 256, __ATOMIC_RELAXED, __HIP_MEMORY_SCOPE_AGENT)
                            + __hip_atomic_load(rp + 512, __ATOMIC_RELAXED, __HIP_MEMORY_SCOPE_AGENT) + __hip_atomic_load(rp + 768, __ATOMIC_RELAXED, __HIP_MEMORY_SCOPE_AGENT);
            rstd_l[tid] = rsqrtf(tot * (1.f / 1024.f) + EPS); }
        __syncthreads();
        f32x4 wv[2][2];
#pragma unroll
        for (int bj = 0; bj < 2; ++bj)
#pragma unroll
            for (int n = 0; n < 2; ++n) wv[bj][n] = *(const f32x4*)(fnw + col0 + bj * HALF + n * 16);
#pragma unroll
        for (int ai = 0; ai < 2; ++ai)
#pragma unroll
            for (int m = 0; m < 4; ++m) { const size_t ro = (size_t)(row0 + ai * HALF + m * 16) * D + col0;
                const float r = rstd_l[ai * HALF + wr * 64 + m * 16 + fr];
#pragma unroll
                for (int bj = 0; bj < 2; ++bj)
#pragma unroll
                    for (int n = 0; n < 2; ++n) *(f32x4*)(out + ro + bj * HALF + n * 16) = acc[ai][bj][m][n] * r * wv[bj][n]; }
    }
};
}

DI int map_n_in(int np) {
    if (np < 3072) return np;
    if (np < 5376) return 4112 + (np - 3072);
    if (np < 6400) return 3072 + (np - 5376);
    if (np < 7168) return 6416 + (np - 6400);
    return 7184 + (np - 7168);
}
struct TileDesc { const float* src; bf16_t* dst; int ld, col0, K, n0, k0; };
DI TileDesc tile_desc(const Params& p, int t) {
    TileDesc d; unsigned char* ws = p.ws;
    if (t < 2304) { const int tn = t >> 4, tk = t & 15; d.src = p.w_in; d.ld = N_IN; d.col0 = map_n_in(tn * 64); d.dst = (bf16_t*)(ws + WS_WT_IN); d.K = 1024; d.n0 = tn * 64; d.k0 = tk * 64; }
    else if (t < 2560) { const int u = t - 2304, tn = u >> 4, tk = u & 15; d.src = p.w_pa; d.ld = 1024; d.col0 = tn * 64; d.dst = (bf16_t*)(ws + WS_WT_PA); d.K = 1024; d.n0 = tn * 64; d.k0 = tk * 64; }
    else if (t < 2752) { const int u = t - 2560, tn = u / 12, tk = u % 12; d.src = p.w_pb; d.ld = 1024; d.col0 = tn * 64; d.dst = (bf16_t*)(ws + WS_WT_PB); d.K = 768; d.n0 = tn * 64; d.k0 = tk * 64; }
    else { const int u = t - 2752, tn = u >> 4, tk = u & 15; d.src = p.w_out; d.ld = 1024; d.col0 = tn * 64; d.dst = (bf16_t*)(ws + WS_WT_O); d.K = 1024; d.n0 = tn * 64; d.k0 = tk * 64; }
    return d;
}
DI void tile_load(float (&v)[8], const TileDesc& d, int tid) {
#pragma unroll
    for (int i = 0; i < 8; ++i) { const int r = (tid >> 6) + 8 * i, c = tid & 63; v[i] = d.src[(size_t)(d.k0 + r) * d.ld + d.col0 + c]; }
}
DI void phase0(const Params& p, LAS unsigned char* lds) {
    int tid = threadIdx.x; asm volatile("" : "+v"(tid));
    const int nb = gridDim.x;
    unsigned char* ws = p.ws;
    {
        const int task = nb - 1 - (int)blockIdx.x;
        if (task < 192) {
            LAS float* sc = (LAS float*)lds;
            LAS float* red = (LAS float*)(lds + 8192);
            const int cg = task % 48, ks = task / 48, k0 = ks * 256;
            for (int i = tid; i < 2048; i += 512) sc[i] = siluf_(p.c[(i >> 8) * 1024 + k0 + (i & 255)]);
            __syncthreads();
            const int col = cg * 64 + (tid & 63), kq = tid >> 6;
            float a[8] = {0.f, 0.f, 0.f, 0.f, 0.f, 0.f, 0.f, 0.f};
            const float* wp = p.ada_w + (size_t)(k0 + kq * 32) * 3072 + col;
#pragma unroll
            for (int kk = 0; kk < 32; kk += 8) {
                float w[8];
#pragma unroll
                for (int u = 0; u < 8; ++u) w[u] = wp[(size_t)(kk + u) * 3072];
#pragma unroll
                for (int u = 0; u < 8; ++u)
#pragma unroll
                    for (int b = 0; b < 8; ++b) a[b] += sc[b * 256 + kq * 32 + kk + u] * w[u];
            }
#pragma unroll
            for (int b = 0; b < 8; ++b) red[(kq * 8 + b) * 64 + (tid & 63)] = a[b];
            __syncthreads();
            { const int b = tid >> 6, cl = tid & 63; float s = 0.f;
#pragma unroll
                for (int q = 0; q < 8; ++q) s += red[(q * 8 + b) * 64 + cl];
                __hip_atomic_store((float*)(ws + WS_MODP) + (size_t)(ks * 8 + b) * 3072 + cg * 64 + cl, s, __ATOMIC_RELAXED, __HIP_MEMORY_SCOPE_AGENT); }
            asm volatile("s_waitcnt vmcnt(0)" ::: "memory");
            __syncthreads();
            if (tid == 0)
                __hip_atomic_fetch_add((unsigned*)(ws + WS_BAR + 28672), 1u, __ATOMIC_RELAXED, __HIP_MEMORY_SCOPE_AGENT);
        }
    }
    LAS float* tile = (LAS float*)lds;
    int t = blockIdx.x;
    if (t < 3008) {
        TileDesc d = tile_desc(p, t);
        float v[8];
        tile_load(v, d, tid);
        for (;;) {
#pragma unroll
            for (int i = 0; i < 8; ++i) { const int r = (tid >> 6) + 8 * i, c = tid & 63; tile[r * 65 + c] = v[i]; }
            __syncthreads();
            const int tn = t + nb;
            TileDesc dn = d;
            if (tn < 3008) { dn = tile_desc(p, tn); tile_load(v, dn, tid); }
#pragma unroll
            for (int i = 0; i < 4; ++i) { const int rr = (tid >> 5) + 16 * i, cc = (tid & 31) * 2;
                *(unsigned*)(d.dst + (size_t)(d.n0 + rr) * d.K + d.k0 + cc) = pk_bf16(tile[cc * 65 + rr], tile[(cc + 1) * 65 + rr]); }
            __syncthreads();
            if (tn >= 3008) break;
            t = tn; d = dn;
        }
    }
}

DI void phase1(const Params& p, LAS unsigned char* lds) {
    LAS float* wT = (LAS float*)lds;
    LAS float* lmod = (LAS float*)(lds + 65536);
    int tid = threadIdx.x; asm volatile("" : "+v"(tid));
    const int lane = tid & 63, wave = tid >> 6;
    for (int i = tid; i < 16384; i += 512) { const int k = i >> 4, j = i & 15; wT[j * 1024 + k] = p.w_in[(size_t)k * N_IN + 4096 + j]; }
    float* mod = (float*)(p.ws + WS_MOD);
    const float* modp = (const float*)(p.ws + WS_MODP);
    bf16_t* H = (bf16_t*)(p.ws + WS_H);
    float* BETA = (float*)(p.ws + WS_BETA); float* GG = (float*)(p.ws + WS_G);
    if (tid == 0) {
        unsigned* c = (unsigned*)(p.ws + WS_BAR + 28672); unsigned sp = 0;
        while (__hip_atomic_load(c, __ATOMIC_RELAXED, __HIP_MEMORY_SCOPE_AGENT) < 192u) { __builtin_amdgcn_s_sleep(2); if (++sp > (1u << 24)) break; }
    }
    for (int rb = blockIdx.x; rb < MTOK / 64; rb += gridDim.x) {
        const int b = rb >> 5;
        __syncthreads();
        for (int i = tid; i < 3072; i += 512) {
            float v = p.ada_b[i];
#pragma unroll
            for (int ks = 0; ks < 4; ++ks) v += __hip_atomic_load((float*)modp + (size_t)(ks * 8 + b) * 3072 + i, __ATOMIC_RELAXED, __HIP_MEMORY_SCOPE_AGENT);
            if (i < 2048) lmod[i] = v;
            if ((rb & 31) == 0) mod[b * 3072 + i] = v;
        }
        __syncthreads();
        const float ea = expf(p.a_log[lane & 7]), dtb = p.dt_bias[lane & 7];
        for (int j = 0; j < 8; j += 4) {
            const int row = rb * 64 + wave * 8 + j;
            f32x4 xv[4][4]; float ss[4] = {0.f, 0.f, 0.f, 0.f};
#pragma unroll
            for (int r = 0; r < 4; ++r)
#pragma unroll
                for (int i = 0; i < 4; ++i) { xv[r][i] = *(const f32x4*)(p.x + (size_t)(row + r) * D + i * 256 + lane * 4);
                    ss[r] += xv[r][i][0] * xv[r][i][0] + xv[r][i][1] * xv[r][i][1] + xv[r][i][2] * xv[r][i][2] + xv[r][i][3] * xv[r][i][3]; }
#pragma unroll
            for (int r = 0; r < 4; ++r) {
                const float rstd = rsqrtf(wave_sum(ss[r]) * (1.f / 1024.f) + EPS);
#pragma unroll
                for (int i = 0; i < 4; ++i) { const int k = i * 256 + lane * 4;
                    const f32x4 nw = *(const f32x4*)(p.norm_w + k), sh = *(const LAS f32x4*)(lmod + k), scl = *(const LAS f32x4*)(lmod + 1024 + k);
#pragma unroll
                    for (int e = 0; e < 4; ++e) xv[r][i][e] = xv[r][i][e] * rstd * nw[e] * (1.f + scl[e]) + sh[e];
                    u32x2 o; o[0] = pk_bf16(xv[r][i][0], xv[r][i][1]); o[1] = pk_bf16(xv[r][i][2], xv[r][i][3]);
                    *(u32x2*)(H + (size_t)(row + r) * D + k) = o; }
            }
            float myv[4] = {0.f, 0.f, 0.f, 0.f};
#pragma unroll 2
            for (int jj = 0; jj < 16; ++jj) { float a[4] = {0.f, 0.f, 0.f, 0.f};
#pragma unroll
                for (int i = 0; i < 4; ++i) { const f32x4 w = *(const LAS f32x4*)(wT + jj * 1024 + i * 256 + lane * 4);
#pragma unroll
                    for (int r = 0; r < 4; ++r) a[r] += xv[r][i][0] * w[0] + xv[r][i][1] * w[1] + xv[r][i][2] * w[2] + xv[r][i][3] * w[3]; }
#pragma unroll
                for (int r = 0; r < 4; ++r) { const float s = wave_sum(a[r]); if (lane == jj) myv[r] = s; } }
#pragma unroll
            for (int r = 0; r < 4; ++r) {
                if (lane < 8) BETA[(size_t)(row + r) * 8 + lane] = sigmoidf_(myv[r]);
                else if (lane < 16) { const float z = myv[r] + dtb; const float sp = z > 20.f ? z : log1pf(expf(z));
                    GG[(size_t)(row + r) * 8 + (lane - 8)] = -ea * sp; } }
        }
    }
}

constexpr int CP_SLOT_B = 8448;
constexpr int CP_BUF0 = 8 * CP_SLOT_B;
constexpr int CP_BUF_B = 17408 * 2 + 512;
constexpr int CP_LDS_TOTAL = CP_BUF0 + 2 * CP_BUF_B;
DI int permpos4(int t) { return 32 * (t >> 1) + 4 * (t & 1); }
DI int lrow_off(int a, int bq) { return bq == 0 ? (8 * a * a + 4 * a) : (8 * a * a + 8 * a + 4 * (bq - 1) * (a + 1)); }
struct CpRaw { unsigned q[11], k[11], v[11]; float g, beta; };
DI void cp_load_raw(CpRaw& R, const Params& p, int item, int wave, int lane) {
    const int bh = item >> 5, n = item & 31, b = bh >> 3, h = bh & 7, tl0 = wave * 8;
    const bf16_t* PA = (const bf16_t*)(p.ws + WS_R1);
#pragma unroll
    for (int r = 0; r < 11; ++r) { const int tb = n * 64 + tl0 - 3 + r;
        if (tb >= 0) { const bf16_t* rp = PA + (size_t)(b * SEQ + tb) * 3072 + h * 128 + 2 * lane;
            R.q[r] = *(const unsigned*)rp; R.k[r] = *(const unsigned*)(rp + 1024); R.v[r] = *(const unsigned*)(rp + 2048); }
        else { R.q[r] = 0u; R.k[r] = 0u; R.v[r] = 0u; } }
    const size_t grow = (size_t)(b * SEQ + n * 64 + lane) * 8 + h;
    R.g = ((const float*)(p.ws + WS_G))[grow]; R.beta = ((const float*)(p.ws + WS_BETA))[grow];
}
DI void cp_conv(const unsigned (&raw)[11], const float* cw, float (&y0)[8], float (&y1)[8]) {
    float w0[4], w1[4];
#pragma unroll
    for (int j = 0; j < 4; ++j) { const f32x2 w = *(const f32x2*)(cw + j * 3072); w0[j] = w[0]; w1[j] = w[1]; }
#pragma unroll
    for (int e = 0; e < 8; ++e) { float a0 = 0.f, a1 = 0.f;
#pragma unroll
        for (int j = 0; j < 4; ++j) { a0 += w0[j] * bflo(raw[e + j]); a1 += w1[j] * bfhi(raw[e + j]); }
        y0[e] = siluf_(a0); y1[e] = siluf_(a1); }
}
DI void cp_stage_a1(const CpRaw& R, const Params& p, LAS unsigned char* lds, int item, int buf, int wave, int lane) {
    const int bh = item >> 5, h = bh & 7, tl0 = wave * 8;
    LAS bf16_t* qs = (LAS bf16_t*)(lds + CP_BUF0 + buf * CP_BUF_B); LAS bf16_t* ks = qs + 64 * 136;
    LAS float* gcs = (LAS float*)(lds + CP_BUF0 + buf * CP_BUF_B + 34816); LAS float* betas = gcs + 64;
    bf16_t* UT = (bf16_t*)p.out + (size_t)item * 8192;
    bf16_t* Wg = (bf16_t*)p.out + (size_t)MTOK * D + (size_t)item * 8192;
    bf16_t* QD = (bf16_t*)(p.ws + WS_QD) + (size_t)item * 8192;
    bf16_t* KDT = (bf16_t*)(p.ws + WS_KDT) + (size_t)item * 8192;
    float v = R.g;
#pragma unroll
    for (int o = 1; o < 64; o <<= 1) { const float u = __shfl_up(v, o); if (lane >= o) v += u; }
    const float gcl = __shfl(v, 63);
    float egc[8], bet[8], ekd[8];
#pragma unroll
    for (int e = 0; e < 8; ++e) { const float gce = __shfl(v, tl0 + e); egc[e] = __expf(gce); ekd[e] = __expf(gcl - gce); bet[e] = __shfl(R.beta, tl0 + e); }
    if (wave == 0) { gcs[lane] = v; betas[lane] = R.beta; if (lane == 63) ((float*)(p.ws + WS_GL))[item] = __expf(v); }
    float y0[8], y1[8];
    {
        cp_conv(R.q, p.conv_w + h * 128 + 2 * lane, y0, y1);
        { float pp[8], tt[8];
#pragma unroll
          for (int e = 0; e < 8; ++e) pp[e] = y0[e] * y0[e] + y1[e] * y1[e];
          reduce8(pp, tt, lane);
#pragma unroll
          for (int e = 0; e < 8; ++e) { const float ri = rsqrtf(tt[e] + EPS); y0[e] *= ri; y1[e] *= ri; } }
        const int dk = 2 * lane, loc = dk & 31, pp = 32 * (dk >> 5) + 8 * ((loc >> 2) & 3) + 4 * (loc >> 4) + (loc & 3);
#pragma unroll
        for (int e = 0; e < 8; ++e) { *(LAS unsigned*)(qs + (tl0 + e) * 136 + 2 * lane) = pk_bf16(y0[e], y1[e]);
            const float s = 0.08838834764831845f * egc[e];
            *(unsigned*)(QD + (tl0 + e) * 128 + pp) = pk_bf16(y0[e] * s, y1[e] * s); }
    }
    {
        cp_conv(R.k, p.conv_w + 1024 + h * 128 + 2 * lane, y0, y1);
        { float pp[8], tt[8];
#pragma unroll
          for (int e = 0; e < 8; ++e) pp[e] = y0[e] * y0[e] + y1[e] * y1[e];
          reduce8(pp, tt, lane);
#pragma unroll
          for (int e = 0; e < 8; ++e) { const float ri = rsqrtf(tt[e] + EPS); y0[e] *= ri; y1[e] *= ri; } }
#pragma unroll
        for (int e = 0; e < 8; ++e) *(LAS unsigned*)(ks + (tl0 + e) * 136 + 2 * lane) = pk_bf16(y0[e], y1[e]);
        float be[8];
#pragma unroll
        for (int e = 0; e < 8; ++e) be[e] = bet[e] * egc[e];
        u32x4 a, c;
        a[0] = pk_bf16(y0[0] * be[0], y0[1] * be[1]); a[1] = pk_bf16(y0[2] * be[2], y0[3] * be[3]); a[2] = pk_bf16(y0[4] * be[4], y0[5] * be[5]); a[3] = pk_bf16(y0[6] * be[6], y0[7] * be[7]);
        c[0] = pk_bf16(y1[0] * be[0], y1[1] * be[1]); c[1] = pk_bf16(y1[2] * be[2], y1[3] * be[3]); c[2] = pk_bf16(y1[4] * be[4], y1[5] * be[5]); c[3] = pk_bf16(y1[6] * be[6], y1[7] * be[7]);
        *(u32x4*)(Wg + (size_t)(wave * 128 + 2 * lane) * 8) = a; *(u32x4*)(Wg + (size_t)(wave * 128 + 2 * lane + 1) * 8) = c;
        u32x4 ka, kc;
        ka[0] = pk_bf16(y0[0] * ekd[0], y0[1] * ekd[1]); ka[1] = pk_bf16(y0[2] * ekd[2], y0[3] * ekd[3]); ka[2] = pk_bf16(y0[4] * ekd[4], y0[5] * ekd[5]); ka[3] = pk_bf16(y0[6] * ekd[6], y0[7] * ekd[7]);
        kc[0] = pk_bf16(y1[0] * ekd[0], y1[1] * ekd[1]); kc[1] = pk_bf16(y1[2] * ekd[2], y1[3] * ekd[3]); kc[2] = pk_bf16(y1[4] * ekd[4], y1[5] * ekd[5]); kc[3] = pk_bf16(y1[6] * ekd[6], y1[7] * ekd[7]);
        *(u32x4*)(KDT + (size_t)(wave * 128 + 2 * lane) * 8) = ka; *(u32x4*)(KDT + (size_t)(wave * 128 + 2 * lane + 1) * 8) = kc;
    }
    {
        cp_conv(R.v, p.conv_w + 2048 + h * 128 + 2 * lane, y0, y1);
        u32x4 a, c;
        a[0] = pk_bf16(y0[0] * bet[0], y0[1] * bet[1]); a[1] = pk_bf16(y0[2] * bet[2], y0[3] * bet[3]); a[2] = pk_bf16(y0[4] * bet[4], y0[5] * bet[5]); a[3] = pk_bf16(y0[6] * bet[6], y0[7] * bet[7]);
        c[0] = pk_bf16(y1[0] * bet[0], y1[1] * bet[1]); c[1] = pk_bf16(y1[2] * bet[2], y1[3] * bet[3]); c[2] = pk_bf16(y1[4] * bet[4], y1[5] * bet[5]); c[3] = pk_bf16(y1[6] * bet[6], y1[7] * bet[7]);
        *(u32x4*)(UT + (size_t)(wave * 128 + 2 * lane) * 8) = a; *(u32x4*)(UT + (size_t)(wave * 128 + 2 * lane + 1) * 8) = c;
    }
}
DI void cp_stage_a2(const Params& p, LAS unsigned char* lds, int item, int buf, int slot, int wave, int lane) {
    const int fr = lane & 15, fq = lane >> 4;
    LAS bf16_t* qs = (LAS bf16_t*)(lds + CP_BUF0 + buf * CP_BUF_B); LAS bf16_t* ks = qs + 64 * 136;
    LAS float* gcs = (LAS float*)(lds + CP_BUF0 + buf * CP_BUF_B + 34816); LAS float* betas = gcs + 64;
    LAS float* Lp = (LAS float*)(lds + slot * CP_SLOT_B);
    bf16_t* AG = (bf16_t*)(p.ws + WS_AG) + (size_t)item * 4096;
    if (wave < 4) {
#pragma unroll
        for (int tn = 0; tn < 4; ++tn) {
            f32x4 acc = {0.f, 0.f, 0.f, 0.f};
#pragma unroll
            for (int s = 0; s < 4; ++s) {
                const bf16x8 a = *(const LAS bf16x8*)(ks + (16 * wave + fr) * 136 + 32 * s + 8 * fq);
                const bf16x8 bb = *(const LAS bf16x8*)(ks + (16 * tn + fr) * 136 + 32 * s + 8 * fq);
                acc = MFMA16(a, bb, acc);
            }
            const int j = 16 * tn + fr; const float gj = gcs[j]; const int arow = 4 * wave + fq;
#pragma unroll
            for (int r = 0; r < 4; ++r) { const int i = 16 * wave + 4 * fq + r;
                if (i > j) Lp[lrow_off(arow, r) + j] = betas[i] * acc[r] * __expf(gcs[i] - gj); }
        }
    } else {
        const int s2 = (wave - 4) >> 1;
#pragma unroll
        for (int ti = 0; ti < 2; ++ti) {
            const int tn = 2 * ((wave - 4) & 1) + ti;
            const int i = 16 * tn + fr; const float gi = gcs[i];
            float v[8];
#pragma unroll
            for (int hh = 0; hh < 2; ++hh) {
                const int tm = 2 * s2 + hh;
                f32x4 acc = {0.f, 0.f, 0.f, 0.f};
#pragma unroll
                for (int s = 0; s < 4; ++s) {
                    const bf16x8 a = *(const LAS bf16x8*)(ks + (16 * tm + fr) * 136 + 32 * s + 8 * fq);
                    const bf16x8 bb = *(const LAS bf16x8*)(qs + (16 * tn + fr) * 136 + 32 * s + 8 * fq);
                    acc = MFMA16(a, bb, acc);
                }
#pragma unroll
                for (int r = 0; r < 4; ++r) { const int j = 16 * tm + 4 * fq + r;
                    v[4 * hh + r] = (i >= j) ? 0.08838834764831845f * acc[r] * __expf(gi - gcs[j]) : 0.f; }
            }
            u32x4 o; o[0] = pk_bf16(v[0], v[1]); o[1] = pk_bf16(v[2], v[3]); o[2] = pk_bf16(v[4], v[5]); o[3] = pk_bf16(v[6], v[7]);
            *(u32x4*)(AG + (size_t)((tn * 2 + s2) * 64 + lane) * 8) = o;
        }
    }
}
DI void cp_solve(LAS unsigned char* lds, int slot, int lane) {
    unsigned zero_v; asm volatile("v_mov_b32 %0, 0" : "=v"(zero_v));
    LAS float* Lp = (LAS float*)(lds + slot * CP_SLOT_B) + zero_v;
    float t[64];
#pragma unroll
    for (int i = 0; i < 64; ++i) t[i] = 0.f;
#pragma unroll
    for (int i = 0; i < 64; ++i) {
        LAS float* lp = Lp;
        if (i >= 2) asm volatile("" : "+v"(lp) : "v"(t[i - 2]));
        const int ro = (i & 3) == 0 ? (8 * (i >> 2) * (i >> 2) + 4 * (i >> 2)) : (8 * (i >> 2) * (i >> 2) + 8 * (i >> 2) + 4 * ((i & 3) - 1) * ((i >> 2) + 1));
        float s0 = (lane == i) ? 1.f : 0.f, s1 = 0.f;
#pragma unroll
        for (int j4 = 0; j4 < (i + 3) / 4; ++j4) {
            const f32x4 l = *(const LAS f32x4*)(lp + ro + j4 * 4);
            if (4 * j4 + 0 < i) s0 -= l[0] * t[4 * j4 + 0];
            if (4 * j4 + 1 < i) s1 -= l[1] * t[4 * j4 + 1];
            if (4 * j4 + 2 < i) s0 -= l[2] * t[4 * j4 + 2];
            if (4 * j4 + 3 < i) s1 -= l[3] * t[4 * j4 + 3];
        }
        t[i] = s0 + s1;
    }
    LAS unsigned char* Tb = lds + slot * CP_SLOT_B + zero_v;
#pragma unroll
    for (int i = 0; i < 64; ++i) *(LAS bf16_t*)(Tb + i * 128 + ((((lane >> 3) ^ ((i >> 1) & 7))) * 16) + (lane & 7) * 2) = f2bf(t[i]);
}
DI void chunk_prep_batch(const Params& p, LAS unsigned char* lds, int first, int stride, int cnt) {
    int tid = threadIdx.x; asm volatile("" : "+v"(tid));
    const int lane = tid & 63, wave = __builtin_amdgcn_readfirstlane(tid >> 6), fr = lane & 15, fq = lane >> 4;
    CpRaw R;
    cp_load_raw(R, p, first, wave, lane);
    for (int k = 0; k < cnt; ++k) {
        const int item = first + k * stride;
        cp_stage_a1(R, p, lds, item, k & 1, wave, lane);
        __syncthreads();
        if (k + 1 < cnt) cp_load_raw(R, p, item + stride, wave, lane);
        cp_stage_a2(p, lds, item, k & 1, k, wave, lane);
    }
    __syncthreads();
    if (wave < cnt) cp_solve(lds, wave, lane);
    __syncthreads();
    const int offK0 = fr * 128 + (((0 + fq) ^ (fr >> 1)) * 16), offK1 = fr * 128 + (((4 + fq) ^ (fr >> 1)) * 16);
    const int ws2 = wave >> 1, wt0 = 2 * (wave & 1);
    for (int half = 0; half < 2; ++half) {
        bf16x8 vbA[4][2], kbA[4][4];
#pragma unroll
        for (int kk = 0; kk < 4; ++kk) {
            const int k = half * 4 + kk;
            if (k < cnt) { const int item = first + k * stride;
                const bf16_t* UT = (const bf16_t*)p.out + (size_t)item * 8192; const bf16_t* Wg = (const bf16_t*)p.out + (size_t)MTOK * D + (size_t)item * 8192;
                vbA[kk][0] = *(const bf16x8*)(UT + (size_t)(fq * 128 + 16 * wave + fr) * 8); vbA[kk][1] = *(const bf16x8*)(UT + (size_t)((4 + fq) * 128 + 16 * wave + fr) * 8);
#pragma unroll
                for (int hh = 0; hh < 2; ++hh) { kbA[kk][2 * hh] = *(const bf16x8*)(Wg + (size_t)(fq * 128 + 16 * (2 * ws2 + hh) + fr) * 8); kbA[kk][2 * hh + 1] = *(const bf16x8*)(Wg + (size_t)((4 + fq) * 128 + 16 * (2 * ws2 + hh) + fr) * 8); } }
            else { vbA[kk][0] = vbA[kk][1] = kbA[kk][0] = kbA[kk][1] = kbA[kk][2] = kbA[kk][3] = (bf16x8){0, 0, 0, 0, 0, 0, 0, 0}; }
        }
        asm volatile("s_waitcnt vmcnt(0)" ::: "memory");
        __syncthreads();
#pragma unroll
        for (int kk = 0; kk < 4; ++kk) {
            const int k = half * 4 + kk;
            if (k >= cnt) break;
            const int item = first + k * stride;
            bf16_t* UT = (bf16_t*)p.out + (size_t)item * 8192; bf16_t* Wg = (bf16_t*)p.out + (size_t)MTOK * D + (size_t)item * 8192;
            LAS unsigned char* Tb = lds + k * CP_SLOT_B;
#pragma unroll
            for (int t4 = 0; t4 < 4; ++t4) {
                const bf16x8 t0 = *(const LAS bf16x8*)(Tb + t4 * 2048 + offK0), t1 = *(const LAS bf16x8*)(Tb + t4 * 2048 + offK1);
                f32x4 acc = {0.f, 0.f, 0.f, 0.f};
                acc = MFMA16(t0, vbA[kk][0], acc); acc = MFMA16(t1, vbA[kk][1], acc);
                u32x2 o; o[0] = pk_bf16(acc[0], acc[1]); o[1] = pk_bf16(acc[2], acc[3]);
                *(u32x2*)(UT + (size_t)((wave * 4 + t4) * 64 + lane) * 4) = o; }
#pragma unroll
            for (int ti = 0; ti < 2; ++ti) {
                const int tn = wt0 + ti;
                const bf16x8 t0 = *(const LAS bf16x8*)(Tb + tn * 2048 + offK0), t1 = *(const LAS bf16x8*)(Tb + tn * 2048 + offK1);
                f32x4 a0 = {0.f, 0.f, 0.f, 0.f}, a1 = {0.f, 0.f, 0.f, 0.f};
                a0 = MFMA16(kbA[kk][0], t0, a0); a0 = MFMA16(kbA[kk][1], t1, a0);
                a1 = MFMA16(kbA[kk][2], t0, a1); a1 = MFMA16(kbA[kk][3], t1, a1);
                u32x4 o; o[0] = pk_bf16(a0[0], a0[1]); o[1] = pk_bf16(a0[2], a0[3]); o[2] = pk_bf16(a1[0], a1[1]); o[3] = pk_bf16(a1[2], a1[3]);
                *(u32x4*)(Wg + (size_t)((tn * 4 + ws2) * 64 + lane) * 8) = o; }
        }
    }
    asm volatile("s_waitcnt vmcnt(0)" ::: "memory");
    __syncthreads();
}

constexpr int SC_W = 0, SC_QD = 16384, SC_KDT = 32768, SC_A = 49152, SC_BUF = 57344;
DI void scan_stage(LAS unsigned char* lds, int buf, const Params& p, int item, int wave, int lane) {
    const unsigned char* Wp = (const unsigned char*)((const bf16_t*)p.out + (size_t)MTOK * D + (size_t)item * 8192);
    const unsigned char* QDp = (const unsigned char*)((const bf16_t*)(p.ws + WS_QD) + (size_t)item * 8192);
    const unsigned char* KDTp = (const unsigned char*)((const bf16_t*)(p.ws + WS_KDT) + (size_t)item * 8192);
    const unsigned char* Ap = (const unsigned char*)((const bf16_t*)(p.ws + WS_AG) + (size_t)item * 4096);
    const int r4 = lane >> 4, c4 = lane & 15, r8 = lane >> 3, c8 = lane & 7;
#pragma unroll
    for (int k = 0; k < 7; ++k) {
        const int i = wave + 8 * k;
        const unsigned char* g; int loff;
        if (i < 16) { g = Wp + i * 1024 + lane * 16; loff = SC_W + i * 1024; }
        else if (i < 32) { const int ii = i & 15, r = 4 * ii + r4, c = c4 ^ (r & 15);
            g = QDp + r * 256 + c * 16; loff = SC_QD + ii * 1024; }
        else if (i < 48) { const int ii = i - 32; g = KDTp + ii * 1024 + lane * 16; loff = SC_KDT + ii * 1024; }
        else { const int ii = i - 48; g = Ap + ii * 1024 + lane * 16; loff = SC_A + ii * 1024; }
        __builtin_amdgcn_global_load_lds((const unsigned*)g, (LAS unsigned*)(lds + buf * SC_BUF + loff), 16, 0, 0);
    }
}
DI void dn_scan(const Params& p, LAS unsigned char* lds, int bh) {
    int tid = threadIdx.x; asm volatile("" : "+v"(tid));
    const int lane = tid & 63, wave = __builtin_amdgcn_readfirstlane(tid >> 6), fr = lane & 15, fq = lane >> 4;
    unsigned char* ws = p.ws;
    f32x4 S[8];
#pragma unroll
    for (int t = 0; t < 8; ++t) S[t] = (f32x4){0.f, 0.f, 0.f, 0.f};
    const float glv = ((const float*)(ws + WS_GL))[bh * 32 + (lane & 31)];
    int offW[4], offK[2];
#pragma unroll
    for (int s = 0; s < 4; ++s) offW[s] = fr * 256 + (((4 * s + fq) ^ fr) * 16);
#pragma unroll
    for (int s = 0; s < 2; ++s) offK[s] = fr * 128 + (((4 * s + fq) ^ (fr >> 1)) * 16);
    bf16_t* UT0 = (bf16_t*)p.out + (size_t)(bh * 32) * 8192 + (size_t)(wave * 4 * 64 + lane) * 4;
    scan_stage(lds, 0, p, bh * 32, wave, lane);
    u32x2 ucur[4];
#pragma unroll
    for (int tm = 0; tm < 4; ++tm) ucur[tm] = *(const u32x2*)(UT0 + 256 * tm);
    for (int n = 0; n < 32; ++n) {
        const int item = bh * 32 + n, buf = n & 1;
        asm volatile("s_waitcnt vmcnt(0)" ::: "memory");
        __syncthreads();
        u32x2 unext[4];
        if (n + 1 < 32) {
            scan_stage(lds, buf ^ 1, p, item + 1, wave, lane);
#pragma unroll
            for (int tm = 0; tm < 4; ++tm) unext[tm] = *(const u32x2*)(UT0 + (size_t)(n + 1) * 8192 + 256 * tm);
        } else {
#pragma unroll
            for (int tm = 0; tm < 4; ++tm) unext[tm] = (u32x2){0u, 0u};
        }
        const float gl = __builtin_bit_cast(float, __builtin_amdgcn_readlane(__builtin_bit_cast(int, glv), n));
        LAS unsigned char* B = lds + buf * SC_BUF;
        bf16_t* UTp = UT0 + (size_t)n * 8192;
        bf16x8 Sf[4];
#pragma unroll
        for (int s = 0; s < 4; ++s) Sf[s] = pack8(S[2 * s], S[2 * s + 1]);
        f32x4 vn[4];
#pragma unroll
        for (int tm = 0; tm < 4; ++tm) {
            f32x4 acc = {0.f, 0.f, 0.f, 0.f};
#pragma unroll
            for (int s = 0; s < 4; ++s) { const bf16x8 a = *(const LAS bf16x8*)(B + SC_W + (tm * 4 + s) * 1024 + lane * 16); acc = MFMA16(a, Sf[s], acc); }
            const u32x2 u = ucur[tm];
            vn[tm][0] = bflo(u[0]) - acc[0]; vn[tm][1] = bfhi(u[0]) - acc[1]; vn[tm][2] = bflo(u[1]) - acc[2]; vn[tm][3] = bfhi(u[1]) - acc[3];
        }
        bf16x8 Vf[2];
        Vf[0] = pack8(vn[0], vn[1]); Vf[1] = pack8(vn[2], vn[3]);
#pragma unroll
        for (int tm = 0; tm < 4; ++tm) {
            f32x4 acc = {0.f, 0.f, 0.f, 0.f};
#pragma unroll
            for (int s = 0; s < 4; ++s) { const bf16x8 a = *(const LAS bf16x8*)(B + SC_QD + tm * 4096 + offW[s]); acc = MFMA16(a, Sf[s], acc); }
#pragma unroll
            for (int s = 0; s < 2; ++s) { const bf16x8 a = *(const LAS bf16x8*)(B + SC_A + (tm * 2 + s) * 1024 + lane * 16); acc = MFMA16(a, Vf[s], acc); }
            u32x2 o; o[0] = pk_bf16(acc[0], acc[1]); o[1] = pk_bf16(acc[2], acc[3]);
            *(u32x2*)(UTp + 256 * tm) = o;
        }
#pragma unroll
        for (int t = 0; t < 8; ++t) {
            f32x4 acc = S[t] * gl;
#pragma unroll
            for (int s = 0; s < 2; ++s) {
                const u32x2 lo = *(const LAS u32x2*)(B + SC_KDT + ((4 * s + (fq >> 1)) * 128 + 16 * t + fr) * 16 + (fq & 1) * 8);
                const u32x2 hi = *(const LAS u32x2*)(B + SC_KDT + ((4 * s + 2 + (fq >> 1)) * 128 + 16 * t + fr) * 16 + (fq & 1) * 8);
                u32x4 av; av[0] = lo[0]; av[1] = lo[1]; av[2] = hi[0]; av[3] = hi[1];
                acc = MFMA16(__builtin_bit_cast(bf16x8, av), Vf[s], acc); }
            S[t] = acc;
        }
#pragma unroll
        for (int tm = 0; tm < 4; ++tm) ucur[tm] = unext[tm];
    }
    asm volatile("s_waitcnt vmcnt(0)" ::: "memory");
    __syncthreads();
}

constexpr int AT_VT = 32768;
struct AtRaw { u32x4 k[4], v[4]; bf16x8 q[2]; };
struct AtItem { int b, head, dil, res, blk; };
DI AtItem at_decode(int item) {
    AtItem I; const int sub = item & 15; I.head = (item >> 4) % 12; I.b = item / 192;
    const int grp = I.head >> 2; I.dil = grp == 0 ? 1 : (grp == 1 ? 4 : 16); const int nbk = 16 / I.dil;
    I.res = sub / nbk; I.blk = sub % nbk; return I;
}
DI void at_load(AtRaw& R, const Params& p, int item, int tid) {
    const AtItem I = at_decode(item);
    const bf16_t* PB = (const bf16_t*)(p.ws + WS_R1);
    const int kk = tid >> 1, half = tid & 1, lk = (I.blk - 1) * 128 + kk;
    if (lk >= 0) { const bf16_t* rp = PB + (size_t)(I.b * SEQ + lk * I.dil + I.res) * 2304 + I.head * 64 + half * 32;
#pragma unroll
        for (int i = 0; i < 4; ++i) { R.k[i] = *(const u32x4*)(rp + 768 + 8 * i); R.v[i] = *(const u32x4*)(rp + 1536 + 8 * i); }
    } else {
#pragma unroll
        for (int i = 0; i < 4; ++i) { R.k[i] = (u32x4){0u, 0u, 0u, 0u}; R.v[i] = (u32x4){0u, 0u, 0u, 0u}; }
    }
    const int lane = tid & 63, wave = tid >> 6, fr = lane & 15, fq = lane >> 4;
    const int tq = (I.blk * 128 + 16 * wave + fr) * I.dil + I.res;
    const bf16_t* qrow = PB + (size_t)(I.b * SEQ + tq) * 2304 + I.head * 64;
    R.q[0] = *(const bf16x8*)(qrow + 8 * fq); R.q[1] = *(const bf16x8*)(qrow + 32 + 8 * fq);
}
DI void at_store_lds(const AtRaw& R, LAS unsigned char* lds, int tid) {
    const int kk = tid >> 1, half = tid & 1;
#pragma unroll
    for (int i = 0; i < 4; ++i) { const int c = half * 4 + i; *(LAS u32x4*)(lds + kk * 128 + ((c ^ ((kk >> 1) & 7)) * 16)) = R.k[i]; }
#pragma unroll
    for (int i = 0; i < 4; ++i)
#pragma unroll
        for (int e = 0; e < 4; ++e) { const int d0 = half * 32 + 8 * i + 2 * e, d1 = d0 + 1;
            *(LAS bf16_t*)(lds + AT_VT + d0 * 512 + (((kk >> 2) ^ ((d0 & 15) << 2)) * 8) + (kk & 3) * 2) = (bf16_t)(R.v[i][e] & 0xffffu);
            *(LAS bf16_t*)(lds + AT_VT + d1 * 512 + (((kk >> 2) ^ ((d1 & 15) << 2)) * 8) + (kk & 3) * 2) = (bf16_t)(R.v[i][e] >> 16); }
}
DI void at_compute(const Params& p, LAS unsigned char* lds, int item, const bf16x8 (&Qf)[2], int tid) {
    const int lane = tid & 63, wave = __builtin_amdgcn_readfirstlane(tid >> 6), fr = lane & 15, fq = lane >> 4;
    const AtItem I = at_decode(item);
    bf16_t* OB = (bf16_t*)(p.ws + WS_OB);
    float* LSE = (float*)(p.ws + WS_LSE);
    const int iq = 16 * wave + fr;
    const int tq = (I.blk * 128 + iq) * I.dil + I.res;
    const int offK0 = fr * 128 + (((0 + fq) ^ (fr >> 1)) * 16), offK1 = fr * 128 + (((4 + fq) ^ (fr >> 1)) * 16);
    const int kb2 = wave >> 1;
    f32x4 sc[10];
    float mx = -3.0e38f;
#pragma unroll
    for (int i = 0; i < 10; ++i) {
        const int kt = 2 * kb2 + i;
        if (kt < wave || kt > wave + 8) { sc[i] = (f32x4){-3.0e38f, -3.0e38f, -3.0e38f, -3.0e38f}; continue; }
        const bf16x8 a0 = *(const LAS bf16x8*)(lds + kt * 2048 + offK0), a1 = *(const LAS bf16x8*)(lds + kt * 2048 + offK1);
        f32x4 acc = {0.f, 0.f, 0.f, 0.f};
        acc = MFMA16(a0, Qf[0], acc); acc = MFMA16(a1, Qf[1], acc);
#pragma unroll
        for (int r = 0; r < 4; ++r) { const int kk = 16 * kt + 4 * fq + r;
            const bool valid = (kk >= iq) && (kk <= iq + 128) && (I.blk > 0 || kk >= 128);
            const float v = valid ? acc[r] * 0.125f : -3.0e38f; acc[r] = v; mx = fmaxf(mx, v); }
        sc[i] = acc;
    }
    mx = fmaxf(mx, __shfl_xor(mx, 16)); mx = fmaxf(mx, __shfl_xor(mx, 32));
    float den = 0.f;
    const float mxl = mx * 1.4426950408889634f;
#pragma unroll
    for (int i = 0; i < 10; ++i)
#pragma unroll
        for (int r = 0; r < 4; ++r) { const float v = sc[i][r]; const float e = (v > -1.0e38f) ? __builtin_amdgcn_exp2f(v * 1.4426950408889634f - mxl) : 0.f; sc[i][r] = e; den += e; }
    den += __shfl_xor(den, 16); den += __shfl_xor(den, 32);
    const float rden = __builtin_amdgcn_rcpf(den);
    bf16_t* orow = OB + (size_t)(I.b * SEQ + tq) * 768 + I.head * 64;
    f32x4 oacc[4];
#pragma unroll
    for (int dt = 0; dt < 4; ++dt) oacc[dt] = (f32x4){0.f, 0.f, 0.f, 0.f};
#pragma unroll
    for (int si = 0; si < 5; ++si) {
        const int s = kb2 + si;
        const bf16x8 Pf = pack8(sc[2 * si], sc[2 * si + 1]);
#pragma unroll
        for (int dt = 0; dt < 4; ++dt) {
            const u32x2 lo = *(const LAS u32x2*)(lds + AT_VT + (16 * dt + fr) * 512 + (((8 * s + fq) ^ (fr << 2)) * 8));
            const u32x2 hi = *(const LAS u32x2*)(lds + AT_VT + (16 * dt + fr) * 512 + (((8 * s + 4 + fq) ^ (fr << 2)) * 8));
            u32x4 av; av[0] = lo[0]; av[1] = lo[1]; av[2] = hi[0]; av[3] = hi[1];
            oacc[dt] = MFMA16(__builtin_bit_cast(bf16x8, av), Pf, oacc[dt]);
        }
    }
#pragma unroll
    for (int dt = 0; dt < 4; ++dt) { u32x2 o; o[0] = pk_bf16(oacc[dt][0] * rden, oacc[dt][1] * rden); o[1] = pk_bf16(oacc[dt][2] * rden, oacc[dt][3] * rden);
        *(u32x2*)(orow + 16 * dt + 4 * fq) = o; }
    if (fq == 0) LSE[(size_t)(I.b * SEQ + tq) * 12 + I.head] = mx + __logf(den);
}
DI void attn_phase(const Params& p, LAS unsigned char* lds, int it, int it_end) {
    int tid = threadIdx.x; asm volatile("" : "+v"(tid));
    if (it >= it_end) return;
    AtRaw R;
    at_load(R, p, it, tid);
    for (int k = 0; it < it_end; ++it, ++k) {
        LAS unsigned char* img = lds + (k & 1) * 65536;
        at_store_lds(R, img, tid);
        __syncthreads();
        bf16x8 Qf[2]; Qf[0] = R.q[0]; Qf[1] = R.q[1];
        if (it + 1 < it_end) at_load(R, p, it + 1, tid);
        at_compute(p, img, it, Qf, tid);
    }
    __syncthreads();
}

DI void ya_phase(const Params& p) {
    int tid = threadIdx.x; asm volatile("" : "+v"(tid));
    const int lane = tid & 63, wave = tid >> 6;
    const bf16_t* Z = (const bf16_t*)p.out + (size_t)MTOK * D;
    bf16_t* YA = (bf16_t*)(p.ws + WS_YA);
    const f32x2 nw = *(const f32x2*)(p.dn_norm_w + 2 * lane);
    for (int task = blockIdx.x * 8 + wave; task < 2048 * 8; task += gridDim.x * 8) {
        const int item = task >> 3, tg = task & 7;
        const int bh = item >> 5, n = item & 31, b = bh >> 3, h = bh & 7;
        const bf16_t* OA = (const bf16_t*)p.out + (size_t)item * 8192 + (size_t)(((lane >> 3) * 4 + (tg >> 1)) * 64 + 2 * (tg & 1) * 16 + ((2 * lane) & 15)) * 4;
        const u32x4 q0 = *(const u32x4*)OA, q1 = *(const u32x4*)(OA + 64);
        const size_t row0 = (size_t)(b * SEQ + n * 64 + tg * 8);
        const bf16_t* zp = Z + row0 * 1024 + h * 128 + 2 * lane;
        unsigned z[8];
#pragma unroll
        for (int e = 0; e < 8; ++e) z[e] = *(const unsigned*)(zp + (size_t)e * 1024);
        float a0[8], a1[8];
        a0[0] = bflo(q0[0]); a0[1] = bfhi(q0[0]); a0[2] = bflo(q0[1]); a0[3] = bfhi(q0[1]); a1[0] = bflo(q0[2]); a1[1] = bfhi(q0[2]); a1[2] = bflo(q0[3]); a1[3] = bfhi(q0[3]);
        a0[4] = bflo(q1[0]); a0[5] = bfhi(q1[0]); a0[6] = bflo(q1[1]); a0[7] = bfhi(q1[1]); a1[4] = bflo(q1[2]); a1[5] = bfhi(q1[2]); a1[6] = bflo(q1[3]); a1[7] = bfhi(q1[3]);
        bf16_t* yp = YA + row0 * D + h * 128 + 2 * lane;
#pragma unroll
        for (int e = 0; e < 8; ++e) {
            const float ss = wave_sum(a0[e] * a0[e] + a1[e] * a1[e]);
            const float rstd = rsqrtf(ss * (1.f / 128.f) + EPS);
            *(unsigned*)(yp + (size_t)e * D) = pk_bf16(a0[e] * rstd * nw[0] * bflo(z[e]), a1[e] * rstd * nw[1] * bfhi(z[e]));
        }
    }
}
DI void yb_rows(const Params& p) {
    int tid = threadIdx.x; asm volatile("" : "+v"(tid));
    const int lane = tid & 63, wave = tid >> 6;
    bf16_t* OB = (bf16_t*)(p.ws + WS_OB);
    const bf16_t* Z = (const bf16_t*)(p.ws + WS_ZB);
    const float* LSE = (const float*)(p.ws + WS_LSE);
    const int c0 = lane, c1 = lane + 64;
    const int j0 = (c0 >> 3) & 3, j1 = (c1 >> 3) & 3, g0 = c0 >> 5, g1 = c1 >> 5;
    for (int rq = blockIdx.x * 8 + wave; rq < MTOK / 4; rq += gridDim.x * 8) {
        float l0[4][3], l1[4][3]; u32x4 o0[4], o1[4], z0[4], z1[4];
#pragma unroll
        for (int r = 0; r < 4; ++r) { const size_t row = (size_t)rq * 4 + r;
#pragma unroll
            for (int g = 0; g < 3; ++g) { l0[r][g] = LSE[row * 12 + 4 * g + j0]; l1[r][g] = LSE[row * 12 + 4 * g + j1]; }
            o0[r] = *(const u32x4*)(OB + row * 768 + c0 * 8); z0[r] = *(const u32x4*)(Z + row * 768 + c0 * 8);
            if (c1 < 96) { o1[r] = *(const u32x4*)(OB + row * 768 + c1 * 8); z1[r] = *(const u32x4*)(Z + row * 768 + c1 * 8); }
            else { o1[r] = (u32x4){0u, 0u, 0u, 0u}; z1[r] = (u32x4){0u, 0u, 0u, 0u}; } }
#pragma unroll
        for (int r = 0; r < 4; ++r) { const size_t row = (size_t)rq * 4 + r;
            { const float m = fmaxf(l0[r][0], fmaxf(l0[r][1], l0[r][2]));
              const float e0 = __expf(l0[r][0] - m), e1 = __expf(l0[r][1] - m), e2 = __expf(l0[r][2] - m);
              const float w = (g0 == 0 ? e0 : (g0 == 1 ? e1 : e2)) * __builtin_amdgcn_rcpf(e0 + e1 + e2);
              u32x4 rr;
#pragma unroll
              for (int e = 0; e < 4; ++e) rr[e] = pk_bf16(bflo(o0[r][e]) * w * bflo(z0[r][e]), bfhi(o0[r][e]) * w * bfhi(z0[r][e]));
              *(u32x4*)(OB + row * 768 + c0 * 8) = rr; }
            if (c1 < 96) { const float m = fmaxf(l1[r][0], fmaxf(l1[r][1], l1[r][2]));
              const float e0 = __expf(l1[r][0] - m), e1 = __expf(l1[r][1] - m), e2 = __expf(l1[r][2] - m);
              const float w = (g1 == 0 ? e0 : (g1 == 1 ? e1 : e2)) * __builtin_amdgcn_rcpf(e0 + e1 + e2);
              u32x4 rr;
#pragma unroll
              for (int e = 0; e < 4; ++e) rr[e] = pk_bf16(bflo(o1[r][e]) * w * bflo(z1[r][e]), bfhi(o1[r][e]) * w * bfhi(z1[r][e]));
              *(u32x4*)(OB + row * 768 + c1 * 8) = rr; }
        }
    }
}

DI void final_norm(const Params& p) {
    int tid = threadIdx.x; asm volatile("" : "+v"(tid));
    const int lane = tid & 63, wave = tid >> 6;
    f32x4 w[4];
#pragma unroll
    for (int i = 0; i < 4; ++i) w[i] = *(const f32x4*)(p.fnw + i * 256 + lane * 4);
    for (int rq = blockIdx.x * 8 + wave; rq < MTOK / 4; rq += gridDim.x * 8) {
        f32x4 xv[4][4];
#pragma unroll
        for (int r = 0; r < 4; ++r)
#pragma unroll
            for (int i = 0; i < 4; ++i) xv[r][i] = *(const f32x4*)(p.out + ((size_t)rq * 4 + r) * D + i * 256 + lane * 4);
#pragma unroll
        for (int r = 0; r < 4; ++r) { float ss = 0.f;
#pragma unroll
            for (int i = 0; i < 4; ++i) ss += xv[r][i][0] * xv[r][i][0] + xv[r][i][1] * xv[r][i][1] + xv[r][i][2] * xv[r][i][2] + xv[r][i][3] * xv[r][i][3];
            ss = wave_sum(ss);
            const float rstd = rsqrtf(ss * (1.f / 1024.f) + EPS);
#pragma unroll
            for (int i = 0; i < 4; ++i) *(f32x4*)(p.out + ((size_t)rq * 4 + r) * D + i * 256 + lane * 4) = xv[r][i] * rstd * w[i]; }
    }
}

__global__ void __launch_bounds__(512, 2) fwd_megakernel(Params p) {
    extern __shared__ __attribute__((aligned(16))) unsigned char lds_raw[];
    LAS unsigned char* lds = (LAS unsigned char*)lds_raw;
    cg::grid_group grid = cg::this_grid();
    unsigned char* ws = p.ws;
    const int G = gridDim.x, bid = blockIdx.x;

    unsigned* barp = (unsigned*)(ws + WS_BAR);
    if (threadIdx.x < 4) ((LAS unsigned*)(lds + 138240))[threadIdx.x] = 0u;
    __syncthreads();
    XcdBarrier xb = xcd_barrier_post(barp, (volatile LAS unsigned*)(lds + 138240), (unsigned)G);
    if (p.ws == nullptr) grid.sync();
    phase0(p, lds);
    __syncthreads();
    phase1(p, lds);
    xcd_barrier(xb);
    {
        pg8::Gemm g{(const bf16_t*)(ws + WS_H), (const bf16_t*)(ws + WS_WT_IN), MTOK, 3072, 1024};
        pg8::StaticOrder S; S.init(MTOK, 3072, G, bid);
        pg8::EpiProj1<3072> E{(bf16_t*)(ws + WS_R1)};
        pg8::gemm_phase<pg8::EpiProj1<3072>, true>(lds, g, S, E);
    }
    xcd_barrier(xb);
    for (int base = bid; base < 2048; base += 8 * G) { int cnt = (2048 - base + G - 1) / G; if (cnt > 8) cnt = 8; chunk_prep_batch(p, lds, base, G, cnt); }
    xcd_barrier(xb);
    if (bid < 64) dn_scan(p, lds, bid);
    else {
        pg8::Gemm g{(const bf16_t*)(ws + WS_H), (const bf16_t*)(ws + WS_WT_IN) + (size_t)3072 * 1024, MTOK, 2304, 1024};
        pg8::StaticOrder S; S.init(MTOK, 2304, G - 64, bid - 64);
        pg8::EpiProj1<2304> E{(bf16_t*)(ws + WS_R1)};
        pg8::gemm_phase<pg8::EpiProj1<2304>, true>(lds, g, S, E);
        if (G == 256) {
            { XcdBarrier sb = xcd_barrier_post((unsigned*)(ws + WS_BAR + 32768), (volatile LAS unsigned*)(lds + 138248), 192u); xcd_barrier(sb); }
            attn_phase(p, lds, (bid - 64) * 4, (bid - 64) * 4 + 4);
        }
    }
    xcd_barrier(xb);
    {
        int a0, a1;
        if (G == 256) { if (bid < 192) { a0 = 768 + bid * 2; a1 = a0 + 2; } else { a0 = 1152 + (bid - 192) * 6; a1 = a0 + 6; } }
        else { const int per = (1536 + G - 1) / G; a0 = bid * per; a1 = a0 + per; if (a1 > 1536) a1 = 1536; }
        pg8::Gemm g{(const bf16_t*)(ws + WS_H), (const bf16_t*)(ws + WS_WT_IN) + (size_t)5376 * 1024, MTOK, 3840, 1024};
        pg8::StaticOrder S; S.init(MTOK, 3840, G, bid);
        pg8::EpiProjC E{ws, p.out};
        if (bid & 1) attn_phase(p, lds, a0, a1);
        pg8::gemm_phase<pg8::EpiProjC, true>(lds, g, S, E);
        if (!(bid & 1)) attn_phase(p, lds, a0, a1);
    }
    xcd_barrier(xb);
    ya_phase(p);
    yb_rows(p);
    xcd_barrier(xb);
    {
        pg8::StaticOrder S; S.init(MTOK, 1024, G, bid);
        pg8::Gemm g1{(const bf16_t*)(ws + WS_YA), (const bf16_t*)(ws + WS_WT_PA), MTOK, 1024, 1024};
        pg8::Gemm g2{(const bf16_t*)(ws + WS_OB), (const bf16_t*)(ws + WS_WT_PB), MTOK, 1024, 768};
        pg8::EpiMerge2 E{(bf16_t*)(ws + WS_H), (const bf16_t*)(ws + WS_R2)};
        pg8::Unit u; S.next(0, u);
        unsigned* pw = (unsigned*)(ws + WS_BAR + 49152) + u.pm * 64;
        panel_post_xcc(pw);
        pg8::gemm_phase2(lds, g1, g2, S, E);
        panel_handoff(pw);
    }
    {
        pg8::StaticOrder S; S.init(MTOK, 1024, G, bid);
        pg8::Gemm g{(const bf16_t*)(ws + WS_H), (const bf16_t*)(ws + WS_WT_O), MTOK, 1024, 1024};
        pg8::EpiOutNorm E{p.x, (const float*)(ws + WS_MOD), p.fnw, p.out, (float*)(ws + WS_RS), (unsigned*)(ws + WS_BAR + 16384)};
        pg8::gemm_phase(lds, g, S, E);
    }
}

extern "C" void kernel_launch(void* const* d_in, const int* in_sizes, int n_in, void* d_out, int out_size, void* d_ws, size_t ws_size, hipStream_t stream) {
    static int grid_blocks = 0;
    if (!grid_blocks) {
        int dev = 0, cus = 0, per_cu = 0;
        hipGetDevice(&dev);
        hipDeviceGetAttribute(&cus, hipDeviceAttributeMultiprocessorCount, dev);
        hipFuncSetAttribute((const void*)fwd_megakernel, hipFuncAttributeMaxDynamicSharedMemorySize, LDS_BYTES);
        hipOccupancyMaxActiveBlocksPerMultiprocessor(&per_cu, (const void*)fwd_megakernel, 512, LDS_BYTES);
        if (per_cu < 1) per_cu = 1;
        grid_blocks = cus;
        if (ws_size < WS_END) fprintf(stderr, "kernel_launch: workspace too small (%zu < %zu)\n", ws_size, (size_t)WS_END);
        (void)hipGetLastError();
    }
    Params p{};
    p.x = (const float*)d_in[0]; p.c = (const float*)d_in[1]; p.norm_w = (const float*)d_in[2]; p.ada_w = (const float*)d_in[3]; p.ada_b = (const float*)d_in[4];
    p.w_in = (const float*)d_in[5]; p.conv_w = (const float*)d_in[6]; p.a_log = (const float*)d_in[7]; p.dt_bias = (const float*)d_in[8]; p.dn_norm_w = (const float*)d_in[9];
    p.w_pa = (const float*)d_in[10]; p.w_pb = (const float*)d_in[11]; p.w_out = (const float*)d_in[12]; p.fnw = (const float*)d_in[13];
    p.out = (float*)d_out; p.ws = (unsigned char*)d_ws;
    (void)hipMemsetAsync((unsigned char*)d_ws + WS_BAR, 0, 65536, stream);
    void* args[] = {&p};
    hipError_t e = hipLaunchCooperativeKernel((const void*)fwd_megakernel, dim3(grid_blocks), dim3(512), args, LDS_BYTES, stream);
    if (e != hipSuccess) fprintf(stderr, "cooperative launch failed: %s (grid %d)\n", hipGetErrorString(e), grid_blocks);
}
```

```cpp
#include <hip/hip_runtime.h>
#include <hip/hip_cooperative_groups.h>
#include <cstdio>
namespace cg = cooperative_groups;

#define LAS __attribute__((address_space(3)))
typedef unsigned short bf16_t;
typedef short bf16x8 __attribute__((ext_vector_type(8)));
typedef float f32x4 __attribute__((ext_vector_type(4)));
typedef float f32x2 __attribute__((ext_vector_type(2)));
typedef unsigned u32x4 __attribute__((ext_vector_type(4)));
typedef unsigned u32x2 __attribute__((ext_vector_type(2)));
typedef __bf16 bf2_t __attribute__((ext_vector_type(2)));
#define DI __device__ __forceinline__

constexpr int D = 1024, NB = 8, SEQ = 2048, MTOK = NB * SEQ;
constexpr int N_IN = 9232;
constexpr float EPS = 1e-6f;
constexpr size_t MiB = 1048576;
constexpr size_t WS_WT_IN = 0;
constexpr size_t WS_WT_PA = 18 * MiB;
constexpr size_t WS_WT_PB = 20 * MiB;
constexpr size_t WS_WT_O  = 21 * MiB + 512 * 1024;
constexpr size_t WS_MOD   = 23 * MiB + 512 * 1024;
constexpr size_t WS_BETA  = WS_MOD + 128 * 1024;
constexpr size_t WS_G     = WS_BETA + 512 * 1024;
constexpr size_t WS_GL    = WS_G + 512 * 1024;
constexpr size_t WS_BAR   = WS_GL + 64 * 1024;
constexpr size_t WS_LSE   = 24 * MiB + 768 * 1024;
static_assert(WS_BAR + 4096 <= WS_LSE && WS_LSE + 768 * 1024 <= 26 * MiB, "ws map");
constexpr size_t WS_H     = 26 * MiB;
constexpr size_t WS_R1    = 58 * MiB;
constexpr size_t WS_OB    = WS_R1 + 72 * MiB;
constexpr size_t WS_R2    = 154 * MiB;
constexpr size_t WS_QD    = WS_R2;
constexpr size_t WS_KDT   = WS_R2 + 32 * MiB;
constexpr size_t WS_AG    = WS_R2 + 64 * MiB;
constexpr size_t WS_MODP  = 234 * MiB;
constexpr size_t WS_RS    = 25 * MiB + 512 * 1024;
constexpr size_t WS_ZB    = 218 * MiB;
constexpr size_t WS_YA    = WS_R1;
constexpr size_t WS_END   = 235 * MiB;
constexpr int LDS_BYTES = 138240 + 16;

struct Params {
    const float *x, *c, *norm_w, *ada_w, *ada_b, *w_in, *conv_w, *a_log, *dt_bias, *dn_norm_w, *w_pa, *w_pb, *w_out, *fnw;
    float* out; unsigned char* ws;
};

DI unsigned pk_bf16(float lo, float hi) { f32x2 v = {lo, hi}; bf2_t b = __builtin_convertvector(v, bf2_t); return __builtin_bit_cast(unsigned, b); }
DI bf16_t f2bf(float x) { return (bf16_t)(pk_bf16(x, 0.f) & 0xffffu); }
DI float bf2f(bf16_t b) { return __uint_as_float(((unsigned)b) << 16); }
DI float bflo(unsigned u) { return __uint_as_float(u << 16); }
DI float bfhi(unsigned u) { return __uint_as_float(u & 0xffff0000u); }
DI float sigmoidf_(float v) { return __builtin_amdgcn_rcpf(1.f + __builtin_amdgcn_exp2f(v * -1.4426950408889634f)); }
DI float siluf_(float v) { return v * __builtin_amdgcn_rcpf(1.f + __builtin_amdgcn_exp2f(v * -1.4426950408889634f)); }
template <int CTRL> DI float dpp_f(float v) { return __builtin_bit_cast(float, __builtin_amdgcn_update_dpp(0, __builtin_bit_cast(int, v), CTRL, 0xf, 0xf, false)); }
DI float wave_sum(float v) {
    v += dpp_f<0x128>(v); v += dpp_f<0x124>(v); v += dpp_f<0x122>(v); v += dpp_f<0x121>(v);
    const int iv = __builtin_bit_cast(int, v);
    return __builtin_bit_cast(float, __builtin_amdgcn_readlane(iv, 0)) + __builtin_bit_cast(float, __builtin_amdgcn_readlane(iv, 16))
         + __builtin_bit_cast(float, __builtin_amdgcn_readlane(iv, 32)) + __builtin_bit_cast(float, __builtin_amdgcn_readlane(iv, 48));
}
DI void reduce8(const float (&p)[8], float (&tot)[8], int lane) {
    const bool b5 = (lane & 32) != 0, b4 = (lane & 16) != 0, b3 = (lane & 8) != 0;
    float q[4], r2[2];
#pragma unroll
    for (int e = 0; e < 4; ++e) { const float send = b5 ? p[e] : p[e + 4], keep = b5 ? p[e + 4] : p[e]; q[e] = keep + __shfl_xor(send, 32); }
#pragma unroll
    for (int e = 0; e < 2; ++e) { const float send = b4 ? q[e] : q[e + 2], keep = b4 ? q[e + 2] : q[e]; r2[e] = keep + __shfl_xor(send, 16); }
    const float send = b3 ? r2[0] : r2[1], keep = b3 ? r2[1] : r2[0];
    float s = keep + dpp_f<0x128>(send);
    s += dpp_f<0xB1>(s);
    s += dpp_f<0x4E>(s);
    s += dpp_f<0x141>(s);
    const int iv = __builtin_bit_cast(int, s);
#pragma unroll
    for (int e = 0; e < 8; ++e) tot[e] = __builtin_bit_cast(float, __builtin_amdgcn_readlane(iv, 8 * e));
}
DI bf16x8 pack8(const f32x4& a, const f32x4& b) {
    u32x4 p; p[0] = pk_bf16(a[0], a[1]); p[1] = pk_bf16(a[2], a[3]); p[2] = pk_bf16(b[0], b[1]); p[3] = pk_bf16(b[2], b[3]);
    return __builtin_bit_cast(bf16x8, p);
}

#define XB_TMO      128
#define XB_XCNT(j)  (256  + 64 * (j))
#define XB_XSUB(j)  (1280 + 64 * (j))
#define XB_XGEN(j)  (2304 + 64 * (j))
#define XB_TOP      3328
#define XB_TOPGEN   3392
#define XCD_BAR_WORDS 3456
#define XB_SPIN_CAP (1u << 18)
DI unsigned xb_ld(unsigned* p)              { return __hip_atomic_load(p, __ATOMIC_RELAXED, __HIP_MEMORY_SCOPE_AGENT); }
DI unsigned xb_add(unsigned* p, unsigned v) { return __hip_atomic_fetch_add(p, v, __ATOMIC_RELAXED, __HIP_MEMORY_SCOPE_AGENT); }
DI unsigned xb_xcc_id() { return (unsigned)__builtin_amdgcn_s_getreg((3 << 11) | 20) & 0xFu; }
#define XB_SPIN(cond, bar) do { unsigned _sp = 0; while (cond) { __builtin_amdgcn_s_sleep(1); \
    if ((++_sp & 255u) == 0u) { if (xb_ld(&(bar)[XB_TMO])) break; if (_sp > XB_SPIN_CAP) { atomicAdd(&(bar)[XB_TMO], 1u); break; } } } } while (0)
struct XcdBarrier { unsigned* bar; unsigned x; volatile LAS unsigned* st; unsigned total; };
DI XcdBarrier xcd_barrier_post(unsigned* bar, volatile LAS unsigned* st, unsigned total) {
    XcdBarrier b; b.bar = bar; b.x = xb_xcc_id(); b.st = st; b.total = total;
    if (threadIdx.x == 0) (void)xb_add(&bar[XB_XCNT(b.x)], 1u);
    return b;
}
DI void xcd_barrier_complete(unsigned* bar, unsigned x, unsigned G, unsigned& nloc, unsigned& nx) {
    unsigned sum, cnt, mine, sp = 0u;
    for (;;) {
        sum = 0u; cnt = 0u; mine = 0u;
#pragma unroll
        for (unsigned j = 0; j < 16; ++j) { const unsigned c = xb_ld(&bar[XB_XCNT(j)]); sum += c; cnt += (c > 0u) ? 1u : 0u; mine = (j == x) ? c : mine; }
        if (sum == G) break;
        __builtin_amdgcn_s_sleep(1);
        if ((++sp & 255u) == 0u) { if (xb_ld(&bar[XB_TMO])) break; if (sp > XB_SPIN_CAP) { atomicAdd(&bar[XB_TMO], 1u); break; } }
    }
    nloc = mine > 0u ? mine : 1u; nx = cnt > 0u ? cnt : 1u;
}
DI void xcd_barrier(const XcdBarrier& b) {
    asm volatile("s_waitcnt vmcnt(0)" ::: "memory");
    __syncthreads();
    if (threadIdx.x == 0) {
        unsigned* bar = b.bar;
        __builtin_amdgcn_s_waitcnt(0);
        unsigned nloc = b.st[0], nx = b.st[1];
        if (nloc == 0u) { xcd_barrier_complete(bar, b.x, b.total, nloc, nx); b.st[0] = nloc; b.st[1] = nx; }
        const unsigned old = xb_add(&bar[XB_XSUB(b.x)], 1u);
        const unsigned gen = old / nloc;
        if (old + 1u == (gen + 1u) * nloc) {
            __builtin_amdgcn_fence(__ATOMIC_RELEASE, "agent");
            asm volatile("s_waitcnt vmcnt(0)" ::: "memory");
            const unsigned og = xb_add(&bar[XB_TOP], 1u);
            const unsigned tg = og / nx;
            if (og + 1u == (tg + 1u) * nx) xb_add(&bar[XB_TOPGEN], 1u);
            else XB_SPIN(xb_ld(&bar[XB_TOPGEN]) == tg, bar);
            __builtin_amdgcn_fence(__ATOMIC_ACQUIRE, "agent");
            xb_add(&bar[XB_XGEN(b.x)], 1u);
            asm volatile("s_waitcnt vmcnt(0)" ::: "memory");
        } else {
            XB_SPIN(xb_ld(&bar[XB_XGEN(b.x)]) == gen, bar);
            __builtin_amdgcn_fence(__ATOMIC_ACQUIRE, "agent");
            asm volatile("s_waitcnt vmcnt(0)" ::: "memory");
        }
    }
    __syncthreads();
}
DI void subset_barrier(unsigned* ctr, unsigned nblk) {
    asm volatile("s_waitcnt vmcnt(0)" ::: "memory");
    __syncthreads();
    if (threadIdx.x == 0) {
        __builtin_amdgcn_fence(__ATOMIC_RELEASE, "agent");
        asm volatile("s_waitcnt vmcnt(0)" ::: "memory");
        __hip_atomic_fetch_add(ctr, 1u, __ATOMIC_RELAXED, __HIP_MEMORY_SCOPE_AGENT);
        unsigned sp = 0;
        while (__hip_atomic_load(ctr, __ATOMIC_RELAXED, __HIP_MEMORY_SCOPE_AGENT) < nblk) { __builtin_amdgcn_s_sleep(2); if (++sp > (1u << 24)) break; }
        __builtin_amdgcn_fence(__ATOMIC_ACQUIRE, "agent");
        asm volatile("s_waitcnt vmcnt(0)" ::: "memory");
    }
    __syncthreads();
}
DI void panel_post_xcc(unsigned* w) {
    if (threadIdx.x == 0) { __hip_atomic_fetch_add(w, 1u << (3u * (xb_xcc_id() & 7u)), __ATOMIC_RELAXED, __HIP_MEMORY_SCOPE_AGENT); __hip_atomic_fetch_add(w + 16, 1u, __ATOMIC_RELAXED, __HIP_MEMORY_SCOPE_AGENT); }
}
DI void panel_handoff(unsigned* w) {
    asm volatile("s_waitcnt vmcnt(0)" ::: "memory");
    __syncthreads();
    if (threadIdx.x == 0) {
        unsigned sp = 0;
        while (__hip_atomic_load(w + 16, __ATOMIC_RELAXED, __HIP_MEMORY_SCOPE_AGENT) < 4u) { __builtin_amdgcn_s_sleep(1); if (++sp > (1u << 24)) break; }
        const bool same = __hip_atomic_load(w, __ATOMIC_RELAXED, __HIP_MEMORY_SCOPE_AGENT) == (4u << (3u * (xb_xcc_id() & 7u)));
        if (!same) { __builtin_amdgcn_fence(__ATOMIC_RELEASE, "agent"); asm volatile("s_waitcnt vmcnt(0)" ::: "memory"); }
        __hip_atomic_fetch_add(w + 32, 1u, __ATOMIC_RELAXED, __HIP_MEMORY_SCOPE_AGENT);
        sp = 0;
        while (__hip_atomic_load(w + 32, __ATOMIC_RELAXED, __HIP_MEMORY_SCOPE_AGENT) < 4u) { __builtin_amdgcn_s_sleep(1); if (++sp > (1u << 24)) break; }
        if (!same) { __builtin_amdgcn_fence(__ATOMIC_ACQUIRE, "agent"); asm volatile("s_waitcnt vmcnt(0)" ::: "memory"); }
    }
    __syncthreads();
}
#define MFMA16(a, b, c) __builtin_amdgcn_mfma_f32_16x16x32_bf16((a), (b), (c), 0, 0, 0)

namespace pg8 {
constexpr int BM = 256, BK = 64, HALF = 128, HTB = HALF * BK * 2, STAGE_BYTES = 8 * HTB, NXCD = 8, WGM = 8;
DI int lds_byte(int r, int c) { const int st = (r >> 4) * 2 + (c >> 5), rr = r & 15, cc = c & 31, ob = rr * 64 + cc * 2; return st * 1024 + (ob ^ (((ob >> 9) & 1) << 5)); }
DI void stage_rc(int b, int& R, int& C) { const int st = b / 1024, sb = b % 1024, swz = sb ^ (((sb >> 9) & 1) << 5); R = (st >> 1) * 16 + swz / 64; C = (st & 1) * 32 + (swz % 64) / 2; }
DI int perm32(int rho) { const int n = rho >> 4, i = rho & 15; return 8 * (i >> 2) + 4 * n + (i & 3); }
struct Unit { int pm, pn; };
struct Gemm { const bf16_t* A; const bf16_t* Bt; int M, N, K; };
struct StaticOrder {
    int nM, nN, nwg, G, c;
    DI void init(int M, int N, int G_, int c_) { nM = M / BM; nN = N / BM; nwg = nM * nN; G = G_; c = c_; }
    DI bool next(int i, Unit& u) const {
        const long L = (long)i * G + c; if (L >= nwg) return false;
        int wgid = (int)L; { const int q = nwg / NXCD, r = nwg % NXCD, xcd = wgid % NXCD, off = wgid / NXCD; wgid = (xcd < r ? xcd * (q + 1) : r * (q + 1) + (xcd - r) * q) + off; }
        const int nig = WGM * nN, gid = wgid / nig, fm = gid * WGM, gsz = (nM - fm) < WGM ? (nM - fm) : WGM;
        u.pm = fm + ((wgid % nig) % gsz); u.pn = (wgid % nig) / gsz; return true;
    }
};

template <class Epi, bool ALIGN_EPI = false>
DI void gemm_phase(LAS unsigned char* lds, const Gemm g, const StaticOrder& S, const Epi& E) {
    int tid = threadIdx.x; asm volatile("" : "+v"(tid));
    const int wid = __builtin_amdgcn_readfirstlane(tid >> 6), lane = tid & 63, wr = wid >> 2, wc = wid & 3, fr = lane & 15, fq = lane >> 4;
    const int K = g.K, nt = K / BK;
    unsigned voffA[2], voffB[2];
#pragma unroll
    for (int i = 0; i < 2; ++i) { int R, C; stage_rc(tid * 16 + i * 8192, R, C); const int Rb = Epi::PERM ? ((R & ~31) + perm32(R & 31)) : R;
        voffA[i] = (unsigned)(R * K + C) * 2u; voffB[i] = (unsigned)(Rb * K + C) * 2u; }
    const size_t kstep = (size_t)(BK * 2);
    const size_t hstep = (size_t)HALF * K * 2;
    const size_t tstep = 2 * hstep;
    const unsigned ldsw = (unsigned)wid * 1024u;
    const int aoff = lds_byte(wr * 64 + fr, fq * 8), boff = lds_byte(wc * 32 + fr, fq * 8);
#define PG8_SA(b, h) (((b) * 2 + (h)) * HTB)
#define PG8_SB(b, h) ((4 + (b) * 2 + (h)) * HTB)
#define PG8_STAGE(bufoff, gbase, voff) do { _Pragma("unroll") for (int _i = 0; _i < 2; ++_i) \
        __builtin_amdgcn_global_load_lds((const unsigned*)((const char*)(gbase) + (voff)[_i]), (LAS unsigned*)(lds + (bufoff) + ldsw + _i * 8192), 16, 0, 0); } while (0)
#define PG8_LDA(dst, b, h) do { _Pragma("unroll") for (int m = 0; m < 4; ++m) _Pragma("unroll") for (int k = 0; k < 2; ++k) dst[m][k] = *(const LAS bf16x8*)(lds + PG8_SA(b, h) + aoff + m * 2048 + k * 1024); } while (0)
#define PG8_LDB(dst, b, h) do { _Pragma("unroll") for (int n = 0; n < 2; ++n) _Pragma("unroll") for (int k = 0; k < 2; ++k) dst[n][k] = *(const LAS bf16x8*)(lds + PG8_SB(b, h) + boff + n * 2048 + k * 1024); } while (0)
#define PG8_MMA(ai, bj, At, Bt) do { __builtin_amdgcn_s_setprio(1); _Pragma("unroll") for (int m = 0; m < 4; ++m) _Pragma("unroll") for (int n = 0; n < 2; ++n) _Pragma("unroll") for (int k = 0; k < 2; ++k) \
        acc[ai][bj][m][n] = __builtin_amdgcn_mfma_f32_16x16x32_bf16(Bt[n][k], At[m][k], acc[ai][bj][m][n], 0, 0, 0); __builtin_amdgcn_s_setprio(0); } while (0)
#define PG8_WAIT_V(n) asm volatile("s_waitcnt vmcnt(" #n ")" ::: "memory")
#define PG8_WAIT_L(n) asm volatile("s_waitcnt lgkmcnt(" #n ")" ::: "memory")
#define PG8_BAR __builtin_amdgcn_s_barrier()
#define PG8_SCHED __builtin_amdgcn_sched_barrier(0)
    Unit cur, nxt; int ui = 0;
    if (!S.next(0, cur)) return;
    f32x4 acc[2][2][4][2];
#pragma unroll
    for (int a = 0; a < 2; ++a)
#pragma unroll
        for (int b = 0; b < 2; ++b)
#pragma unroll
            for (int m = 0; m < 4; ++m)
#pragma unroll
                for (int n = 0; n < 2; ++n) acc[a][b][m][n] = (f32x4){0.f, 0.f, 0.f, 0.f};
    bf16x8 At[4][2], B0[2][2], B1[2][2];
    const char* cA = (const char*)g.A + (size_t)cur.pm * tstep; const char* cB = (const char*)g.Bt + (size_t)cur.pn * tstep;
    PG8_STAGE(PG8_SB(0, 0), cB, voffB); PG8_STAGE(PG8_SB(0, 1), cB + hstep, voffB); PG8_STAGE(PG8_SA(0, 0), cA, voffA); PG8_STAGE(PG8_SA(0, 1), cA + hstep, voffA);
    if (wr == 1) PG8_BAR;
    PG8_WAIT_V(2); PG8_BAR;
    PG8_STAGE(PG8_SB(1, 0), cB + kstep, voffB); PG8_STAGE(PG8_SA(1, 0), cA + kstep, voffA); PG8_STAGE(PG8_SB(1, 1), cB + hstep + kstep, voffB);
    PG8_WAIT_V(6); PG8_BAR;
    for (;;) {
        const bool has_next = S.next(ui + 1, nxt);
        const char* nA = has_next ? (const char*)g.A + (size_t)nxt.pm * tstep : cA; const char* nB = has_next ? (const char*)g.Bt + (size_t)nxt.pn * tstep : cB;
        for (int t = 0; t < nt; t += 2) {
            const bool last = (t == nt - 2);
            const char* a1 = cA + (size_t)(t + 1) * kstep;
            const char* a2 = last ? nA : cA + (size_t)(t + 2) * kstep; const char* b2 = last ? nB : cB + (size_t)(t + 2) * kstep;
            const char* a3 = a2 + kstep; const char* b3 = b2 + kstep;
            PG8_LDB(B0, 0, 0); PG8_LDB(B1, 0, 1); PG8_SCHED; PG8_LDA(At, 0, 0); PG8_STAGE(PG8_SA(1, 1), a1 + hstep, voffA);
            PG8_WAIT_V(8); PG8_WAIT_L(0); PG8_BAR; PG8_MMA(0, 0, At, B0); PG8_MMA(0, 1, At, B1); PG8_BAR; PG8_SCHED;
            PG8_LDA(At, 0, 1); PG8_STAGE(PG8_SB(0, 0), b2, voffB); PG8_STAGE(PG8_SB(0, 1), b2 + hstep, voffB); PG8_STAGE(PG8_SA(0, 0), a2, voffA);
            PG8_WAIT_V(8); PG8_WAIT_L(0); PG8_BAR; PG8_MMA(1, 0, At, B0); PG8_MMA(1, 1, At, B1); PG8_BAR; PG8_SCHED;
            PG8_LDB(B0, 1, 0); PG8_LDB(B1, 1, 1); PG8_SCHED; PG8_LDA(At, 1, 0); PG8_STAGE(PG8_SA(0, 1), a2 + hstep, voffA);
            PG8_WAIT_V(8); PG8_WAIT_L(0); PG8_BAR; PG8_MMA(0, 0, At, B0); PG8_MMA(0, 1, At, B1); PG8_BAR; PG8_SCHED;
            PG8_LDA(At, 1, 1); PG8_STAGE(PG8_SB(1, 0), b3, voffB); PG8_STAGE(PG8_SB(1, 1), b3 + hstep, voffB); PG8_STAGE(PG8_SA(1, 0), a3, voffA);
            PG8_WAIT_V(8); PG8_WAIT_L(0); PG8_BAR; PG8_MMA(1, 0, At, B0); PG8_MMA(1, 1, At, B1); PG8_BAR; PG8_SCHED;
        }
        if constexpr (ALIGN_EPI) { if (wr == 0) PG8_BAR; }
        if constexpr (!Epi::AFTER_DRAIN) E(acc, cur, wr, wc, fr, fq);
        if (!has_next) break;
#pragma unroll
        for (int a = 0; a < 2; ++a)
#pragma unroll
            for (int b = 0; b < 2; ++b)
#pragma unroll
                for (int m = 0; m < 4; ++m)
#pragma unroll
                    for (int n = 0; n < 2; ++n) acc[a][b][m][n] = (f32x4){0.f, 0.f, 0.f, 0.f};
        cur = nxt; cA = nA; cB = nB; ++ui;
        if constexpr (ALIGN_EPI) { if (wr == 1) PG8_BAR; }
    }
    PG8_WAIT_V(0);
    if constexpr (!ALIGN_EPI) { if (wr == 0) PG8_BAR; }
    PG8_BAR;
    if constexpr (Epi::AFTER_DRAIN) E.fused(acc, cur, wr, wc, fr, fq, lds);
#undef PG8_SA
#undef PG8_SB
#undef PG8_STAGE
#undef PG8_LDA
#undef PG8_LDB
#undef PG8_MMA
#undef PG8_WAIT_V
#undef PG8_WAIT_L
#undef PG8_BAR
#undef PG8_SCHED
}

template <class Epi>
DI void gemm_phase2(LAS unsigned char* lds, const Gemm g0, const Gemm g1, const StaticOrder& S, const Epi& E) {
    int tid = threadIdx.x; asm volatile("" : "+v"(tid));
    const int wid = __builtin_amdgcn_readfirstlane(tid >> 6), lane = tid & 63, wr = wid >> 2, wc = wid & 3, fr = lane & 15, fq = lane >> 4;
    unsigned rA[2], rB[2], c2[2];
#pragma unroll
    for (int i = 0; i < 2; ++i) { int R, C; stage_rc(tid * 16 + i * 8192, R, C); const int Rb = Epi::PERM ? ((R & ~31) + perm32(R & 31)) : R;
        rA[i] = (unsigned)R; rB[i] = (unsigned)Rb; c2[i] = (unsigned)C * 2u; }
    const unsigned k20 = (unsigned)g0.K * 2u, k21 = (unsigned)g1.K * 2u;
    const size_t kstep = (size_t)(BK * 2);
    const size_t hs0 = (size_t)HALF * g0.K * 2, hs1 = (size_t)HALF * g1.K * 2;
    const unsigned ldsw = (unsigned)wid * 1024u;
    const int aoff = lds_byte(wr * 64 + fr, fq * 8), boff = lds_byte(wc * 32 + fr, fq * 8);
#define PG8_SA(b, h) (((b) * 2 + (h)) * HTB)
#define PG8_SB(b, h) ((4 + (b) * 2 + (h)) * HTB)
#define PG8_STAGE(bufoff, gbase, rowv, k2) do { _Pragma("unroll") for (int _i = 0; _i < 2; ++_i) \
        __builtin_amdgcn_global_load_lds((const unsigned*)((const char*)(gbase) + ((rowv)[_i] * (k2) + c2[_i])), (LAS unsigned*)(lds + (bufoff) + ldsw + _i * 8192), 16, 0, 0); } while (0)
#define PG8_LDA(dst, b, h) do { _Pragma("unroll") for (int m = 0; m < 4; ++m) _Pragma("unroll") for (int k = 0; k < 2; ++k) dst[m][k] = *(const LAS bf16x8*)(lds + PG8_SA(b, h) + aoff + m * 2048 + k * 1024); } while (0)
#define PG8_LDB(dst, b, h) do { _Pragma("unroll") for (int n = 0; n < 2; ++n) _Pragma("unroll") for (int k = 0; k < 2; ++k) dst[n][k] = *(const LAS bf16x8*)(lds + PG8_SB(b, h) + boff + n * 2048 + k * 1024); } while (0)
#define PG8_MMA(ai, bj, At, Bt) do { __builtin_amdgcn_s_setprio(1); _Pragma("unroll") for (int m = 0; m < 4; ++m) _Pragma("unroll") for (int n = 0; n < 2; ++n) _Pragma("unroll") for (int k = 0; k < 2; ++k) \
        acc[ai][bj][m][n] = __builtin_amdgcn_mfma_f32_16x16x32_bf16(Bt[n][k], At[m][k], acc[ai][bj][m][n], 0, 0, 0); __builtin_amdgcn_s_setprio(0); } while (0)
#define PG8_WAIT_V(n) asm volatile("s_waitcnt vmcnt(" #n ")" ::: "memory")
#define PG8_WAIT_L(n) asm volatile("s_waitcnt lgkmcnt(" #n ")" ::: "memory")
#define PG8_BAR __builtin_amdgcn_s_barrier()
#define PG8_SCHED __builtin_amdgcn_sched_barrier(0)
    Unit cur;
    if (!S.next(0, cur)) return;
    f32x4 acc[2][2][4][2];
#pragma unroll
    for (int a = 0; a < 2; ++a)
#pragma unroll
        for (int b = 0; b < 2; ++b)
#pragma unroll
            for (int m = 0; m < 4; ++m)
#pragma unroll
                for (int n = 0; n < 2; ++n) acc[a][b][m][n] = (f32x4){0.f, 0.f, 0.f, 0.f};
    bf16x8 At[4][2], B0[2][2], B1[2][2];
    const char* cA = (const char*)g0.A + (size_t)cur.pm * 2 * hs0; const char* cB = (const char*)g0.Bt + (size_t)cur.pn * 2 * hs0;
    {   PG8_STAGE(PG8_SB(0, 0), cB, rB, k20); PG8_STAGE(PG8_SB(0, 1), cB + hs0, rB, k20); PG8_STAGE(PG8_SA(0, 0), cA, rA, k20); PG8_STAGE(PG8_SA(0, 1), cA + hs0, rA, k20);
        if (wr == 1) PG8_BAR;
        PG8_WAIT_V(2); PG8_BAR;
        PG8_STAGE(PG8_SB(1, 0), cB + kstep, rB, k20); PG8_STAGE(PG8_SA(1, 0), cA + kstep, rA, k20); PG8_STAGE(PG8_SB(1, 1), cB + hs0 + kstep, rB, k20);
        PG8_WAIT_V(6); PG8_BAR; }
#define PG8_KLOOP(ntc, hsc, k2c, nA, nB, hsn, k2n) \
        for (int t = 0; t < (ntc); t += 2) { \
            const bool last = (t == (ntc) - 2); \
            const char* a1 = cA + (size_t)(t + 1) * kstep; \
            const char* a2 = last ? (nA) : cA + (size_t)(t + 2) * kstep; const char* b2 = last ? (nB) : cB + (size_t)(t + 2) * kstep; \
            const char* a3 = a2 + kstep; const char* b3 = b2 + kstep; \
            const size_t hs2 = last ? (hsn) : (hsc); const unsigned k22 = last ? (k2n) : (k2c); \
            PG8_LDB(B0, 0, 0); PG8_LDB(B1, 0, 1); PG8_SCHED; PG8_LDA(At, 0, 0); PG8_STAGE(PG8_SA(1, 1), a1 + (hsc), rA, (k2c)); \
            PG8_WAIT_V(8); PG8_WAIT_L(0); PG8_BAR; PG8_MMA(0, 0, At, B0); PG8_MMA(0, 1, At, B1); PG8_BAR; PG8_SCHED; \
            PG8_LDA(At, 0, 1); PG8_STAGE(PG8_SB(0, 0), b2, rB, k22); PG8_STAGE(PG8_SB(0, 1), b2 + hs2, rB, k22); PG8_STAGE(PG8_SA(0, 0), a2, rA, k22); \
            PG8_WAIT_V(8); PG8_WAIT_L(0); PG8_BAR; PG8_MMA(1, 0, At, B0); PG8_MMA(1, 1, At, B1); PG8_BAR; PG8_SCHED; \
            PG8_LDB(B0, 1, 0); PG8_LDB(B1, 1, 1); PG8_SCHED; PG8_LDA(At, 1, 0); PG8_STAGE(PG8_SA(0, 1), a2 + hs2, rA, k22); \
            PG8_WAIT_V(8); PG8_WAIT_L(0); PG8_BAR; PG8_MMA(0, 0, At, B0); PG8_MMA(0, 1, At, B1); PG8_BAR; PG8_SCHED; \
            PG8_LDA(At, 1, 1); PG8_STAGE(PG8_SB(1, 0), b3, rB, k22); PG8_STAGE(PG8_SB(1, 1), b3 + hs2, rB, k22); PG8_STAGE(PG8_SA(1, 0), a3, rA, k22); \
            PG8_WAIT_V(8); PG8_WAIT_L(0); PG8_BAR; PG8_MMA(1, 0, At, B0); PG8_MMA(1, 1, At, B1); PG8_BAR; PG8_SCHED; \
        }
    const int nt0 = g0.K / BK, nt1 = g1.K / BK;
    {
        const char* pA1 = (const char*)g1.A + (size_t)cur.pm * 2 * hs1; const char* pB1 = (const char*)g1.Bt + (size_t)cur.pn * 2 * hs1;
        PG8_KLOOP(nt0, hs0, k20, pA1, pB1, hs1, k21)
        E.mid(acc, cur, wr, wc, fr, fq);
        cA = pA1; cB = pB1;
        PG8_KLOOP(nt1, hs1, k21, cA, cB, hs1, k21)
        E(acc, cur, wr, wc, fr, fq);
    }
#undef PG8_KLOOP
    PG8_WAIT_V(0);
    if (wr == 0) PG8_BAR;
    PG8_BAR;
#undef PG8_SA
#undef PG8_SB
#undef PG8_STAGE
#undef PG8_LDA
#undef PG8_LDB
#undef PG8_MMA
#undef PG8_WAIT_V
#undef PG8_WAIT_L
#undef PG8_BAR
#undef PG8_SCHED
}

template <int ACT> DI void epi_store8(bf16_t* dstp, f32x4 v0, f32x4 v1) {
    if (ACT == 1) {
#pragma unroll
        for (int e = 0; e < 4; ++e) { v0[e] = siluf_(v0[e]); v1[e] = siluf_(v1[e]); }
    } else if (ACT == 2) {
#pragma unroll
        for (int e = 0; e < 4; ++e) { v0[e] = sigmoidf_(v0[e]); v1[e] = sigmoidf_(v1[e]); }
    }
    u32x4 o; o[0] = pk_bf16(v0[0], v0[1]); o[1] = pk_bf16(v0[2], v0[3]); o[2] = pk_bf16(v1[0], v1[1]); o[3] = pk_bf16(v1[2], v1[3]);
    *(u32x4*)dstp = o;
}
template <int LD> struct EpiProj1 {
    static constexpr bool PERM = true, AFTER_DRAIN = false;
    bf16_t* dst;
    DI void operator()(const f32x4 (&acc)[2][2][4][2], const Unit& u, int wr, int wc, int fr, int fq) const {
        const int row0 = u.pm * BM + wr * 64 + fr, col0 = u.pn * BM + wc * 32 + 8 * fq;
#pragma unroll
        for (int ai = 0; ai < 2; ++ai)
#pragma unroll
            for (int m = 0; m < 4; ++m) { bf16_t* rowp = dst + (size_t)(row0 + ai * HALF + m * 16) * LD + col0;
#pragma unroll
                for (int bj = 0; bj < 2; ++bj) epi_store8<0>(rowp + bj * HALF, acc[ai][bj][m][0], acc[ai][bj][m][1]); }
    }
};
struct EpiProjC {
    static constexpr bool PERM = true, AFTER_DRAIN = false;
    unsigned char* ws; float* out;
    DI void operator()(const f32x4 (&acc)[2][2][4][2], const Unit& u, int wr, int wc, int fr, int fq) const {
        const int row0 = u.pm * BM + wr * 64 + fr, cw = wc * 32 + 8 * fq;
        if (u.pn < 4) { bf16_t* base = (bf16_t*)out + (size_t)MTOK * D + u.pn * BM + cw;
#pragma unroll
            for (int ai = 0; ai < 2; ++ai)
#pragma unroll
                for (int m = 0; m < 4; ++m)
#pragma unroll
                    for (int bj = 0; bj < 2; ++bj) epi_store8<1>(base + (size_t)(row0 + ai * HALF + m * 16) * 1024 + bj * HALF, acc[ai][bj][m][0], acc[ai][bj][m][1]);
        } else if (u.pn < 7) { bf16_t* base = (bf16_t*)(ws + WS_ZB) + (u.pn - 4) * BM + cw;
#pragma unroll
            for (int ai = 0; ai < 2; ++ai)
#pragma unroll
                for (int m = 0; m < 4; ++m)
#pragma unroll
                    for (int bj = 0; bj < 2; ++bj) epi_store8<1>(base + (size_t)(row0 + ai * HALF + m * 16) * 768 + bj * HALF, acc[ai][bj][m][0], acc[ai][bj][m][1]);
        } else { bf16_t* base = (bf16_t*)(ws + WS_R2) + (u.pn - 7) * BM + cw;
#pragma unroll
            for (int ai = 0; ai < 2; ++ai)
#pragma unroll
                for (int m = 0; m < 4; ++m)
#pragma unroll
                    for (int bj = 0; bj < 2; ++bj) epi_store8<2>(base + (size_t)(row0 + ai * HALF + m * 16) * 2048 + bj * HALF, acc[ai][bj][m][0], acc[ai][bj][m][1]);
        }
    }
};
struct EpiGate {
    static constexpr bool PERM = true, AFTER_DRAIN = false;
    bf16_t* T; const bf16_t* sg; int ldsg; int mode;
    DI void operator()(const f32x4 (&acc)[2][2][4][2], const Unit& u, int wr, int wc, int fr, int fq) const {
        const int row0 = u.pm * BM + wr * 64 + fr, col0 = u.pn * BM + wc * 32 + 8 * fq;
#pragma unroll
        for (int ai = 0; ai < 2; ++ai)
#pragma unroll
            for (int m = 0; m < 4; ++m) { const size_t row = (size_t)(row0 + ai * HALF + m * 16);
#pragma unroll
                for (int bj = 0; bj < 2; ++bj) { const f32x4 v0 = acc[ai][bj][m][0], v1 = acc[ai][bj][m][1];
                    const u32x4 s = *(const u32x4*)(sg + row * ldsg + col0 + bj * HALF);
                    float r[8] = { bflo(s[0]) * v0[0], bfhi(s[0]) * v0[1], bflo(s[1]) * v0[2], bfhi(s[1]) * v0[3], bflo(s[2]) * v1[0], bfhi(s[2]) * v1[1], bflo(s[3]) * v1[2], bfhi(s[3]) * v1[3] };
                    bf16_t* tp = T + row * D + col0 + bj * HALF;
                    if (mode == 1) { const u32x4 t = *(const u32x4*)tp;
                        r[0] += bflo(t[0]); r[1] += bfhi(t[0]); r[2] += bflo(t[1]); r[3] += bfhi(t[1]); r[4] += bflo(t[2]); r[5] += bfhi(t[2]); r[6] += bflo(t[3]); r[7] += bfhi(t[3]); }
                    u32x4 o; o[0] = pk_bf16(r[0], r[1]); o[1] = pk_bf16(r[2], r[3]); o[2] = pk_bf16(r[4], r[5]); o[3] = pk_bf16(r[6], r[7]);
                    *(u32x4*)tp = o; } }
    }
};
struct EpiMerge2 {
    static constexpr bool PERM = true, AFTER_DRAIN = false;
    bf16_t* out; const bf16_t* gt;
    DI void mid(f32x4 (&acc)[2][2][4][2], const Unit& u, int wr, int wc, int fr, int fq) const {
        int row0 = u.pm * BM + wr * 64 + fr, col0 = u.pn * BM + wc * 32 + 8 * fq;
        asm volatile("" : "+v"(row0), "+v"(col0));
#pragma unroll
        for (int ai = 0; ai < 2; ++ai)
#pragma unroll
            for (int m = 0; m < 4; ++m) { const bf16_t* gp = gt + (size_t)(row0 + ai * HALF + m * 16) * 2048 + col0;
#pragma unroll
                for (int bj = 0; bj < 2; ++bj) { const u32x4 sa = *(const u32x4*)(gp + bj * HALF), sb = *(const u32x4*)(gp + 1024 + bj * HALF);
#pragma unroll
                    for (int e = 0; e < 2; ++e) {
                        acc[ai][bj][m][0][2 * e]     *= bflo(sa[e]) * __builtin_amdgcn_rcpf(fmaxf(bflo(sb[e]), 1e-20f));
                        acc[ai][bj][m][0][2 * e + 1] *= bfhi(sa[e]) * __builtin_amdgcn_rcpf(fmaxf(bfhi(sb[e]), 1e-20f));
                        acc[ai][bj][m][1][2 * e]     *= bflo(sa[2 + e]) * __builtin_amdgcn_rcpf(fmaxf(bflo(sb[2 + e]), 1e-20f));
                        acc[ai][bj][m][1][2 * e + 1] *= bfhi(sa[2 + e]) * __builtin_amdgcn_rcpf(fmaxf(bfhi(sb[2 + e]), 1e-20f)); } }
                if (m & 1) __builtin_amdgcn_sched_barrier(0); }
    }
    DI void operator()(const f32x4 (&acc)[2][2][4][2], const Unit& u, int wr, int wc, int fr, int fq) const {
        int row0 = u.pm * BM + wr * 64 + fr, col0 = u.pn * BM + wc * 32 + 8 * fq;
        asm volatile("" : "+v"(row0), "+v"(col0));
#pragma unroll
        for (int ai = 0; ai < 2; ++ai)
#pragma unroll
            for (int m = 0; m < 4; ++m) { const size_t row = (size_t)(row0 + ai * HALF + m * 16);
#pragma unroll
                for (int bj = 0; bj < 2; ++bj) { const f32x4 v0 = acc[ai][bj][m][0], v1 = acc[ai][bj][m][1];
                    const u32x4 sb = *(const u32x4*)(gt + row * 2048 + 1024 + col0 + bj * HALF);
                    u32x4 o;
                    o[0] = pk_bf16(v0[0] * fmaxf(bflo(sb[0]), 1e-20f), v0[1] * fmaxf(bfhi(sb[0]), 1e-20f)); o[1] = pk_bf16(v0[2] * fmaxf(bflo(sb[1]), 1e-20f), v0[3] * fmaxf(bfhi(sb[1]), 1e-20f));
                    o[2] = pk_bf16(v1[0] * fmaxf(bflo(sb[2]), 1e-20f), v1[1] * fmaxf(bfhi(sb[2]), 1e-20f)); o[3] = pk_bf16(v1[2] * fmaxf(bflo(sb[3]), 1e-20f), v1[3] * fmaxf(bfhi(sb[3]), 1e-20f));
                    *(u32x4*)(out + row * D + col0 + bj * HALF) = o; } }
    }
};
struct EpiOutNorm {
    static constexpr bool PERM = false, AFTER_DRAIN = true;
    const float* x; const float* mod; const float* fnw; float* out; float* rs; unsigned* cnt;
    DI void operator()(const f32x4 (&)[2][2][4][2], const Unit&, int, int, int, int) const {}
    DI void fused(f32x4 (&acc)[2][2][4][2], const Unit& u, int wr, int wc, int fr, int fq, LAS unsigned char* lds) const {
        const int tid = threadIdx.x;
        const int row0 = u.pm * BM + wr * 64 + fr, col0 = u.pn * BM + wc * 32 + 4 * fq;
        const int b = (u.pm * BM) / SEQ;
        LAS float* part = (LAS float*)lds;
        LAS float* rstd_l = (LAS float*)(lds + 4096);
        f32x4 gv[2][2];
#pragma unroll
        for (int bj = 0; bj < 2; ++bj)
#pragma unroll
            for (int n = 0; n < 2; ++n) gv[bj][n] = *(const f32x4*)(mod + b * 3072 + 2048 + col0 + bj * HALF + n * 16);
#pragma unroll
        for (int ai = 0; ai < 2; ++ai)
#pragma unroll
            for (int m = 0; m < 4; ++m) { const size_t ro = (size_t)(row0 + ai * HALF + m * 16) * D + col0;
                float ss = 0.f;
#pragma unroll
                for (int bj = 0; bj < 2; ++bj)
#pragma unroll
                    for (int n = 0; n < 2; ++n) { const f32x4 xv = __builtin_nontemporal_load((const f32x4*)(x + ro + bj * HALF + n * 16));
                        const f32x4 v = xv + gv[bj][n] * acc[ai][bj][m][n]; acc[ai][bj][m][n] = v;
                        ss += v[0] * v[0] + v[1] * v[1] + v[2] * v[2] + v[3] * v[3]; }
                ss += __shfl_xor(ss, 16); ss += __shfl_xor(ss, 32);
                if (fq == 0) part[wc * 256 + ai * HALF + wr * 64 + m * 16 + fr] = ss; }
        __syncthreads();
        if (tid < 256) __hip_atomic_store(rs + (size_t)(u.pm * 4 + u.pn) * 256 + tid, part[tid] + part[256 + tid] + part[512 + tid] + part[768 + tid], __ATOMIC_RELAXED, __HIP_MEMORY_SCOPE_AGENT);
        asm volatile("s_waitcnt vmcnt(0)" ::: "memory");
        __syncthreads();
        if (tid == 0) {
            unsigned* c = cnt + u.pm * 16;
            __hip_atomic_fetch_add(c, 1u, __ATOMIC_RELAXED, __HIP_MEMORY_SCOPE_AGENT);
            unsigned sp = 0;
            while (__hip_atomic_load(c, __ATOMIC_RELAXED, __HIP_MEMORY_SCOPE_AGENT) < 4u) { __builtin_amdgcn_s_sleep(1); if (++sp > (1u << 24)) break; }
        }
        __syncthreads();
        if (tid < 256) { float* rp = rs + (size_t)(u.pm * 4) * 256 + tid;
            const float tot = __hip_atomic_load(rp, __ATOMIC_RELAXED, __HIP_MEMORY_SCOPE_AGENT) + __hip_atomic_load(rp + 256, __ATOMIC_RELAXED, __HIP_MEMORY_SCOPE_AGENT)
                            + __hip_atomic_load(rp + 512, __ATOMIC_RELAXED, __HIP_MEMORY_SCOPE_AGENT) + __hip_atomic_load(rp + 768, __ATOMIC_RELAXED, __HIP_MEMORY_SCOPE_AGENT);
            rstd_l[tid] = rsqrtf(tot * (1.f / 1024.f) + EPS); }
        __syncthreads();
        f32x4 wv[2][2];
#pragma unroll
        for (int bj = 0; bj < 2; ++bj)
#pragma unroll
            for (int n = 0; n < 2; ++n) wv[bj][n] = *(const f32x4*)(fnw + col0 + bj * HALF + n * 16);
#pragma unroll
        for (int ai = 0; ai < 2; ++ai)
#pragma unroll
            for (int m = 0; m < 4; ++m) { const size_t ro = (size_t)(row0 + ai * HALF + m * 16) * D + col0;
                const float r = rstd_l[ai * HALF + wr * 64 + m * 16 + fr];
#pragma unroll
                for (int bj = 0; bj < 2; ++bj)
#pragma unroll
                    for (int n = 0; n < 2; ++n) *(f32x4*)(out + ro + bj * HALF + n * 16) = acc[ai][bj][m][n] * r * wv[bj][n]; }
    }
};
}

DI int map_n_in(int np) {
    if (np < 3072) return np;
    if (np < 5376) return 4112 + (np - 3072);
    if (np < 6400) return 3072 + (np - 5376);
    if (np < 7168) return 6416 + (np - 6400);
    return 7184 + (np - 7168);
}
struct TileDesc { const float* src; bf16_t* dst; int ld, col0, K, n0, k0; };
DI TileDesc tile_desc(const Params& p, int t) {
    TileDesc d; unsigned char* ws = p.ws;
    if (t < 2304) { const int tn = t >> 4, tk = t & 15; d.src = p.w_in; d.ld = N_IN; d.col0 = map_n_in(tn * 64); d.dst = (bf16_t*)(ws + WS_WT_IN); d.K = 1024; d.n0 = tn * 64; d.k0 = tk * 64; }
    else if (t < 2560) { const int u = t - 2304, tn = u >> 4, tk = u & 15; d.src = p.w_pa; d.ld = 1024; d.col0 = tn * 64; d.dst = (bf16_t*)(ws + WS_WT_PA); d.K = 1024; d.n0 = tn * 64; d.k0 = tk * 64; }
    else if (t < 2752) { const int u = t - 2560, tn = u / 12, tk = u % 12; d.src = p.w_pb; d.ld = 1024; d.col0 = tn * 64; d.dst = (bf16_t*)(ws + WS_WT_PB); d.K = 768; d.n0 = tn * 64; d.k0 = tk * 64; }
    else { const int u = t - 2752, tn = u >> 4, tk = u & 15; d.src = p.w_out; d.ld = 1024; d.col0 = tn * 64; d.dst = (bf16_t*)(ws + WS_WT_O); d.K = 1024; d.n0 = tn * 64; d.k0 = tk * 64; }
    return d;
}
DI void tile_load(float (&v)[8], const TileDesc& d, int tid) {
#pragma unroll
    for (int i = 0; i < 8; ++i) { const int r = (tid >> 6) + 8 * i, c = tid & 63; v[i] = d.src[(size_t)(d.k0 + r) * d.ld + d.col0 + c]; }
}
DI void phase0(const Params& p, LAS unsigned char* lds) {
    int tid = threadIdx.x; asm volatile("" : "+v"(tid));
    const int nb = gridDim.x;
    unsigned char* ws = p.ws;
    {
        const int task = nb - 1 - (int)blockIdx.x;
        if (task < 192) {
            LAS float* sc = (LAS float*)lds;
            LAS float* red = (LAS float*)(lds + 8192);
            const int cg = task % 48, ks = task / 48, k0 = ks * 256;
            for (int i = tid; i < 2048; i += 512) sc[i] = siluf_(p.c[(i >> 8) * 1024 + k0 + (i & 255)]);
            __syncthreads();
            const int col = cg * 64 + (tid & 63), kq = tid >> 6;
            float a[8] = {0.f, 0.f, 0.f, 0.f, 0.f, 0.f, 0.f, 0.f};
            const float* wp = p.ada_w + (size_t)(k0 + kq * 32) * 3072 + col;
#pragma unroll
            for (int kk = 0; kk < 32; kk += 8) {
                float w[8];
#pragma unroll
                for (int u = 0; u < 8; ++u) w[u] = wp[(size_t)(kk + u) * 3072];
#pragma unroll
                for (int u = 0; u < 8; ++u)
#pragma unroll
                    for (int b = 0; b < 8; ++b) a[b] += sc[b * 256 + kq * 32 + kk + u] * w[u];
            }
#pragma unroll
            for (int b = 0; b < 8; ++b) red[(kq * 8 + b) * 64 + (tid & 63)] = a[b];
            __syncthreads();
            { const int b = tid >> 6, cl = tid & 63; float s = 0.f;
#pragma unroll
                for (int q = 0; q < 8; ++q) s += red[(q * 8 + b) * 64 + cl];
                __hip_atomic_store((float*)(ws + WS_MODP) + (size_t)(ks * 8 + b) * 3072 + cg * 64 + cl, s, __ATOMIC_RELAXED, __HIP_MEMORY_SCOPE_AGENT); }
            asm volatile("s_waitcnt vmcnt(0)" ::: "memory");
            __syncthreads();
            if (tid == 0)
                __hip_atomic_fetch_add((unsigned*)(ws + WS_BAR + 28672), 1u, __ATOMIC_RELAXED, __HIP_MEMORY_SCOPE_AGENT);
        }
    }
    LAS float* tile = (LAS float*)lds;
    int t = blockIdx.x;
    if (t < 3008) {
        TileDesc d = tile_desc(p, t);
        float v[8];
        tile_load(v, d, tid);
        for (;;) {
#pragma unroll
            for (int i = 0; i < 8; ++i) { const int r = (tid >> 6) + 8 * i, c = tid & 63; tile[r * 65 + c] = v[i]; }
            __syncthreads();
            const int tn = t + nb;
            TileDesc dn = d;
            if (tn < 3008) { dn = tile_desc(p, tn); tile_load(v, dn, tid); }
#pragma unroll
            for (int i = 0; i < 4; ++i) { const int rr = (tid >> 5) + 16 * i, cc = (tid & 31) * 2;
                *(unsigned*)(d.dst + (size_t)(d.n0 + rr) * d.K + d.k0 + cc) = pk_bf16(tile[cc * 65 + rr], tile[(cc + 1) * 65 + rr]); }
            __syncthreads();
            if (tn >= 3008) break;
            t = tn; d = dn;
        }
    }
}

DI void phase1(const Params& p, LAS unsigned char* lds) {
    LAS float* wT = (LAS float*)lds;
    LAS float* lmod = (LAS float*)(lds + 65536);
    int tid = threadIdx.x; asm volatile("" : "+v"(tid));
    const int lane = tid & 63, wave = tid >> 6;
    for (int i = tid; i < 16384; i += 512) { const int k = i >> 4, j = i & 15; wT[j * 1024 + k] = p.w_in[(size_t)k * N_IN + 4096 + j]; }
    float* mod = (float*)(p.ws + WS_MOD);
    const float* modp = (const float*)(p.ws + WS_MODP);
    bf16_t* H = (bf16_t*)(p.ws + WS_H);
    float* BETA = (float*)(p.ws + WS_BETA); float* GG = (float*)(p.ws + WS_G);
    if (tid == 0) {
        unsigned* c = (unsigned*)(p.ws + WS_BAR + 28672); unsigned sp = 0;
        while (__hip_atomic_load(c, __ATOMIC_RELAXED, __HIP_MEMORY_SCOPE_AGENT) < 192u) { __builtin_amdgcn_s_sleep(2); if (++sp > (1u << 24)) break; }
    }
    for (int rb = blockIdx.x; rb < MTOK / 64; rb += gridDim.x) {
        const int b = rb >> 5;
        __syncthreads();
        for (int i = tid; i < 3072; i += 512) {
            float v = p.ada_b[i];
#pragma unroll
            for (int ks = 0; ks < 4; ++ks) v += __hip_atomic_load((float*)modp + (size_t)(ks * 8 + b) * 3072 + i, __ATOMIC_RELAXED, __HIP_MEMORY_SCOPE_AGENT);
            if (i < 2048) lmod[i] = v;
            if ((rb & 31) == 0) mod[b * 3072 + i] = v;
        }
        __syncthreads();
        const float ea = expf(p.a_log[lane & 7]), dtb = p.dt_bias[lane & 7];
        for (int j = 0; j < 8; j += 4) {
            const int row = rb * 64 + wave * 8 + j;
            f32x4 xv[4][4]; float ss[4] = {0.f, 0.f, 0.f, 0.f};
#pragma unroll
            for (int r = 0; r < 4; ++r)
#pragma unroll
                for (int i = 0; i < 4; ++i) { xv[r][i] = __builtin_nontemporal_load((const f32x4*)(p.x + (size_t)(row + r) * D + i * 256 + lane * 4));
                    ss[r] += xv[r][i][0] * xv[r][i][0] + xv[r][i][1] * xv[r][i][1] + xv[r][i][2] * xv[r][i][2] + xv[r][i][3] * xv[r][i][3]; }
#pragma unroll
            for (int r = 0; r < 4; ++r) {
                const float rstd = rsqrtf(wave_sum(ss[r]) * (1.f / 1024.f) + EPS);
#pragma unroll
                for (int i = 0; i < 4; ++i) { const int k = i * 256 + lane * 4;
                    const f32x4 nw = *(const f32x4*)(p.norm_w + k), sh = *(const LAS f32x4*)(lmod + k), scl = *(const LAS f32x4*)(lmod + 1024 + k);
#pragma unroll
                    for (int e = 0; e < 4; ++e) xv[r][i][e] = xv[r][i][e] * rstd * nw[e] * (1.f + scl[e]) + sh[e];
                    u32x2 o; o[0] = pk_bf16(xv[r][i][0], xv[r][i][1]); o[1] = pk_bf16(xv[r][i][2], xv[r][i][3]);
                    *(u32x2*)(H + (size_t)(row + r) * D + k) = o; }
            }
            float myv[4] = {0.f, 0.f, 0.f, 0.f};
#pragma unroll 2
            for (int jj = 0; jj < 16; ++jj) { float a[4] = {0.f, 0.f, 0.f, 0.f};
#pragma unroll
                for (int i = 0; i < 4; ++i) { const f32x4 w = *(const LAS f32x4*)(wT + jj * 1024 + i * 256 + lane * 4);
#pragma unroll
                    for (int r = 0; r < 4; ++r) a[r] += xv[r][i][0] * w[0] + xv[r][i][1] * w[1] + xv[r][i][2] * w[2] + xv[r][i][3] * w[3]; }
#pragma unroll
                for (int r = 0; r < 4; ++r) { const float s = wave_sum(a[r]); if (lane == jj) myv[r] = s; } }
#pragma unroll
            for (int r = 0; r < 4; ++r) {
                if (lane < 8) BETA[(size_t)(row + r) * 8 + lane] = sigmoidf_(myv[r]);
                else if (lane < 16) { const float z = myv[r] + dtb; const float sp = z > 20.f ? z : log1pf(expf(z));
                    GG[(size_t)(row + r) * 8 + (lane - 8)] = -ea * sp; } }
        }
    }
}

constexpr int CP_SLOT_B = 8448;
constexpr int CP_BUF0 = 8 * CP_SLOT_B;
constexpr int CP_BUF_B = 17408 * 2 + 512;
constexpr int CP_LDS_TOTAL = CP_BUF0 + 2 * CP_BUF_B;
DI int permpos4(int t) { return 32 * (t >> 1) + 4 * (t & 1); }
DI int lrow_off(int a, int bq) { return bq == 0 ? (8 * a * a + 4 * a) : (8 * a * a + 8 * a + 4 * (bq - 1) * (a + 1)); }
struct CpRaw { unsigned q[11], k[11], v[11]; float g, beta; };
DI void cp_load_raw(CpRaw& R, const Params& p, int item, int wave, int lane) {
    const int bh = item >> 5, n = item & 31, b = bh >> 3, h = bh & 7, tl0 = wave * 8;
    const bf16_t* PA = (const bf16_t*)(p.ws + WS_R1);
#pragma unroll
    for (int r = 0; r < 11; ++r) { const int tb = n * 64 + tl0 - 3 + r;
        if (tb >= 0) { const bf16_t* rp = PA + (size_t)(b * SEQ + tb) * 3072 + h * 128 + 2 * lane;
            R.q[r] = *(const unsigned*)rp; R.k[r] = *(const unsigned*)(rp + 1024); R.v[r] = *(const unsigned*)(rp + 2048); }
        else { R.q[r] = 0u; R.k[r] = 0u; R.v[r] = 0u; } }
    const size_t grow = (size_t)(b * SEQ + n * 64 + lane) * 8 + h;
    R.g = ((const float*)(p.ws + WS_G))[grow]; R.beta = ((const float*)(p.ws + WS_BETA))[grow];
}
DI void cp_conv(const unsigned (&raw)[11], const float* cw, float (&y0)[8], float (&y1)[8]) {
    float w0[4], w1[4];
#pragma unroll
    for (int j = 0; j < 4; ++j) { const f32x2 w = *(const f32x2*)(cw + j * 3072); w0[j] = w[0]; w1[j] = w[1]; }
#pragma unroll
    for (int e = 0; e < 8; ++e) { float a0 = 0.f, a1 = 0.f;
#pragma unroll
        for (int j = 0; j < 4; ++j) { a0 += w0[j] * bflo(raw[e + j]); a1 += w1[j] * bfhi(raw[e + j]); }
        y0[e] = siluf_(a0); y1[e] = siluf_(a1); }
}
DI void cp_stage_a1(const CpRaw& R, const Params& p, LAS unsigned char* lds, int item, int buf, int wave, int lane) {
    const int bh = item >> 5, h = bh & 7, tl0 = wave * 8;
    LAS bf16_t* qs = (LAS bf16_t*)(lds + CP_BUF0 + buf * CP_BUF_B); LAS bf16_t* ks = qs + 64 * 136;
    LAS float* gcs = (LAS float*)(lds + CP_BUF0 + buf * CP_BUF_B + 34816); LAS float* betas = gcs + 64;
    bf16_t* UT = (bf16_t*)p.out + (size_t)item * 8192;
    bf16_t* Wg = (bf16_t*)p.out + (size_t)MTOK * D + (size_t)item * 8192;
    bf16_t* QD = (bf16_t*)(p.ws + WS_QD) + (size_t)item * 8192;
    bf16_t* KDT = (bf16_t*)(p.ws + WS_KDT) + (size_t)item * 8192;
    float v = R.g;
#pragma unroll
    for (int o = 1; o < 64; o <<= 1) { const float u = __shfl_up(v, o); if (lane >= o) v += u; }
    const float gcl = __shfl(v, 63);
    float egc[8], bet[8], ekd[8];
#pragma unroll
    for (int e = 0; e < 8; ++e) { const float gce = __shfl(v, tl0 + e); egc[e] = __expf(gce); ekd[e] = __expf(gcl - gce); bet[e] = __shfl(R.beta, tl0 + e); }
    if (wave == 0) { gcs[lane] = v; betas[lane] = R.beta; if (lane == 63) ((float*)(p.ws + WS_GL))[item] = __expf(v); }
    float y0[8], y1[8];
    {
        cp_conv(R.q, p.conv_w + h * 128 + 2 * lane, y0, y1);
        { float pp[8], tt[8];
#pragma unroll
          for (int e = 0; e < 8; ++e) pp[e] = y0[e] * y0[e] + y1[e] * y1[e];
          reduce8(pp, tt, lane);
#pragma unroll
          for (int e = 0; e < 8; ++e) { const float ri = rsqrtf(tt[e] + EPS); y0[e] *= ri; y1[e] *= ri; } }
        const int dk = 2 * lane, loc = dk & 31, pp = 32 * (dk >> 5) + 8 * ((loc >> 2) & 3) + 4 * (loc >> 4) + (loc & 3);
#pragma unroll
        for (int e = 0; e < 8; ++e) { *(LAS unsigned*)(qs + (tl0 + e) * 136 + 2 * lane) = pk_bf16(y0[e], y1[e]);
            const float s = 0.08838834764831845f * egc[e];
            *(unsigned*)(QD + (tl0 + e) * 128 + pp) = pk_bf16(y0[e] * s, y1[e] * s); }
    }
    {
        cp_conv(R.k, p.conv_w + 1024 + h * 128 + 2 * lane, y0, y1);
        { float pp[8], tt[8];
#pragma unroll
          for (int e = 0; e < 8; ++e) pp[e] = y0[e] * y0[e] + y1[e] * y1[e];
          reduce8(pp, tt, lane);
#pragma unroll
          for (int e = 0; e < 8; ++e) { const float ri = rsqrtf(tt[e] + EPS); y0[e] *= ri; y1[e] *= ri; } }
#pragma unroll
        for (int e = 0; e < 8; ++e) *(LAS unsigned*)(ks + (tl0 + e) * 136 + 2 * lane) = pk_bf16(y0[e], y1[e]);
        float be[8];
#pragma unroll
        for (int e = 0; e < 8; ++e) be[e] = bet[e] * egc[e];
        u32x4 a, c;
        a[0] = pk_bf16(y0[0] * be[0], y0[1] * be[1]); a[1] = pk_bf16(y0[2] * be[2], y0[3] * be[3]); a[2] = pk_bf16(y0[4] * be[4], y0[5] * be[5]); a[3] = pk_bf16(y0[6] * be[6], y0[7] * be[7]);
        c[0] = pk_bf16(y1[0] * be[0], y1[1] * be[1]); c[1] = pk_bf16(y1[2] * be[2], y1[3] * be[3]); c[2] = pk_bf16(y1[4] * be[4], y1[5] * be[5]); c[3] = pk_bf16(y1[6] * be[6], y1[7] * be[7]);
        *(u32x4*)(Wg + (size_t)(wave * 128 + 2 * lane) * 8) = a; *(u32x4*)(Wg + (size_t)(wave * 128 + 2 * lane + 1) * 8) = c;
        u32x4 ka, kc;
        ka[0] = pk_bf16(y0[0] * ekd[0], y0[1] * ekd[1]); ka[1] = pk_bf16(y0[2] * ekd[2], y0[3] * ekd[3]); ka[2] = pk_bf16(y0[4] * ekd[4], y0[5] * ekd[5]); ka[3] = pk_bf16(y0[6] * ekd[6], y0[7] * ekd[7]);
        kc[0] = pk_bf16(y1[0] * ekd[0], y1[1] * ekd[1]); kc[1] = pk_bf16(y1[2] * ekd[2], y1[3] * ekd[3]); kc[2] = pk_bf16(y1[4] * ekd[4], y1[5] * ekd[5]); kc[3] = pk_bf16(y1[6] * ekd[6], y1[7] * ekd[7]);
        *(u32x4*)(KDT + (size_t)(wave * 128 + 2 * lane) * 8) = ka; *(u32x4*)(KDT + (size_t)(wave * 128 + 2 * lane + 1) * 8) = kc;
    }
    {
        cp_conv(R.v, p.conv_w + 2048 + h * 128 + 2 * lane, y0, y1);
        u32x4 a, c;
        a[0] = pk_bf16(y0[0] * bet[0], y0[1] * bet[1]); a[1] = pk_bf16(y0[2] * bet[2], y0[3] * bet[3]); a[2] = pk_bf16(y0[4] * bet[4], y0[5] * bet[5]); a[3] = pk_bf16(y0[6] * bet[6], y0[7] * bet[7]);
        c[0] = pk_bf16(y1[0] * bet[0], y1[1] * bet[1]); c[1] = pk_bf16(y1[2] * bet[2], y1[3] * bet[3]); c[2] = pk_bf16(y1[4] * bet[4], y1[5] * bet[5]); c[3] = pk_bf16(y1[6] * bet[6], y1[7] * bet[7]);
        *(u32x4*)(UT + (size_t)(wave * 128 + 2 * lane) * 8) = a; *(u32x4*)(UT + (size_t)(wave * 128 + 2 * lane + 1) * 8) = c;
    }
}
DI void cp_stage_a2(const Params& p, LAS unsigned char* lds, int item, int buf, int slot, int wave, int lane) {
    const int fr = lane & 15, fq = lane >> 4;
    LAS bf16_t* qs = (LAS bf16_t*)(lds + CP_BUF0 + buf * CP_BUF_B); LAS bf16_t* ks = qs + 64 * 136;
    LAS float* gcs = (LAS float*)(lds + CP_BUF0 + buf * CP_BUF_B + 34816); LAS float* betas = gcs + 64;
    LAS float* Lp = (LAS float*)(lds + slot * CP_SLOT_B);
    bf16_t* AG = (bf16_t*)(p.ws + WS_AG) + (size_t)item * 4096;
    if (wave < 4) {
#pragma unroll
        for (int tn = 0; tn < 4; ++tn) {
            f32x4 acc = {0.f, 0.f, 0.f, 0.f};
#pragma unroll
            for (int s = 0; s < 4; ++s) {
                const bf16x8 a = *(const LAS bf16x8*)(ks + (16 * wave + fr) * 136 + 32 * s + 8 * fq);
                const bf16x8 bb = *(const LAS bf16x8*)(ks + (16 * tn + fr) * 136 + 32 * s + 8 * fq);
                acc = MFMA16(a, bb, acc);
            }
            const int j = 16 * tn + fr; const float gj = gcs[j]; const int arow = 4 * wave + fq;
#pragma unroll
            for (int r = 0; r < 4; ++r) { const int i = 16 * wave + 4 * fq + r;
                if (i > j) Lp[lrow_off(arow, r) + j] = betas[i] * acc[r] * __expf(gcs[i] - gj); }
        }
    } else {
        const int s2 = (wave - 4) >> 1;
#pragma unroll
        for (int ti = 0; ti < 2; ++ti) {
            const int tn = 2 * ((wave - 4) & 1) + ti;
            const int i = 16 * tn + fr; const float gi = gcs[i];
            float v[8];
#pragma unroll
            for (int hh = 0; hh < 2; ++hh) {
                const int tm = 2 * s2 + hh;
                f32x4 acc = {0.f, 0.f, 0.f, 0.f};
#pragma unroll
                for (int s = 0; s < 4; ++s) {
                    const bf16x8 a = *(const LAS bf16x8*)(ks + (16 * tm + fr) * 136 + 32 * s + 8 * fq);
                    const bf16x8 bb = *(const LAS bf16x8*)(qs + (16 * tn + fr) * 136 + 32 * s + 8 * fq);
                    acc = MFMA16(a, bb, acc);
                }
#pragma unroll
                for (int r = 0; r < 4; ++r) { const int j = 16 * tm + 4 * fq + r;
                    v[4 * hh + r] = (i >= j) ? 0.08838834764831845f * acc[r] * __expf(gi - gcs[j]) : 0.f; }
            }
            u32x4 o; o[0] = pk_bf16(v[0], v[1]); o[1] = pk_bf16(v[2], v[3]); o[2] = pk_bf16(v[4], v[5]); o[3] = pk_bf16(v[6], v[7]);
            *(u32x4*)(AG + (size_t)((tn * 2 + s2) * 64 + lane) * 8) = o;
        }
    }
}
DI void cp_solve(LAS unsigned char* lds, int slot, int lane) {
    unsigned zero_v; asm volatile("v_mov_b32 %0, 0" : "=v"(zero_v));
    LAS float* Lp = (LAS float*)(lds + slot * CP_SLOT_B) + zero_v;
    float t[64];
#pragma unroll
    for (int i = 0; i < 64; ++i) t[i] = 0.f;
#pragma unroll
    for (int i = 0; i < 64; ++i) {
        LAS float* lp = Lp;
        if (i >= 2) asm volatile("" : "+v"(lp) : "v"(t[i - 2]));
        const int ro = (i & 3) == 0 ? (8 * (i >> 2) * (i >> 2) + 4 * (i >> 2)) : (8 * (i >> 2) * (i >> 2) + 8 * (i >> 2) + 4 * ((i & 3) - 1) * ((i >> 2) + 1));
        float s0 = (lane == i) ? 1.f : 0.f, s1 = 0.f;
#pragma unroll
        for (int j4 = 0; j4 < (i + 3) / 4; ++j4) {
            const f32x4 l = *(const LAS f32x4*)(lp + ro + j4 * 4);
            if (4 * j4 + 0 < i) s0 -= l[0] * t[4 * j4 + 0];
            if (4 * j4 + 1 < i) s1 -= l[1] * t[4 * j4 + 1];
            if (4 * j4 + 2 < i) s0 -= l[2] * t[4 * j4 + 2];
            if (4 * j4 + 3 < i) s1 -= l[3] * t[4 * j4 + 3];
        }
        t[i] = s0 + s1;
    }
    LAS unsigned char* Tb = lds + slot * CP_SLOT_B + zero_v;
#pragma unroll
    for (int i = 0; i < 64; ++i) *(LAS bf16_t*)(Tb + i * 128 + ((((lane >> 3) ^ ((i >> 1) & 7))) * 16) + (lane & 7) * 2) = f2bf(t[i]);
}
DI void chunk_prep_batch(const Params& p, LAS unsigned char* lds, int first, int stride, int cnt) {
    int tid = threadIdx.x; asm volatile("" : "+v"(tid));
    const int lane = tid & 63, wave = __builtin_amdgcn_readfirstlane(tid >> 6), fr = lane & 15, fq = lane >> 4;
    CpRaw R;
    cp_load_raw(R, p, first, wave, lane);
    for (int k = 0; k < cnt; ++k) {
        const int item = first + k * stride;
        cp_stage_a1(R, p, lds, item, k & 1, wave, lane);
        __syncthreads();
        if (k + 1 < cnt) cp_load_raw(R, p, item + stride, wave, lane);
        cp_stage_a2(p, lds, item, k & 1, k, wave, lane);
    }
    __syncthreads();
    if (wave < cnt) cp_solve(lds, wave, lane);
    __syncthreads();
    const int offK0 = fr * 128 + (((0 + fq) ^ (fr >> 1)) * 16), offK1 = fr * 128 + (((4 + fq) ^ (fr >> 1)) * 16);
    const int ws2 = wave >> 1, wt0 = 2 * (wave & 1);
    for (int half = 0; half < 2; ++half) {
        bf16x8 vbA[4][2], kbA[4][4];
#pragma unroll
        for (int kk = 0; kk < 4; ++kk) {
            const int k = half * 4 + kk;
            if (k < cnt) { const int item = first + k * stride;
                const bf16_t* UT = (const bf16_t*)p.out + (size_t)item * 8192; const bf16_t* Wg = (const bf16_t*)p.out + (size_t)MTOK * D + (size_t)item * 8192;
                vbA[kk][0] = *(const bf16x8*)(UT + (size_t)(fq * 128 + 16 * wave + fr) * 8); vbA[kk][1] = *(const bf16x8*)(UT + (size_t)((4 + fq) * 128 + 16 * wave + fr) * 8);
#pragma unroll
                for (int hh = 0; hh < 2; ++hh) { kbA[kk][2 * hh] = *(const bf16x8*)(Wg + (size_t)(fq * 128 + 16 * (2 * ws2 + hh) + fr) * 8); kbA[kk][2 * hh + 1] = *(const bf16x8*)(Wg + (size_t)((4 + fq) * 128 + 16 * (2 * ws2 + hh) + fr) * 8); } }
            else { vbA[kk][0] = vbA[kk][1] = kbA[kk][0] = kbA[kk][1] = kbA[kk][2] = kbA[kk][3] = (bf16x8){0, 0, 0, 0, 0, 0, 0, 0}; }
        }
        asm volatile("s_waitcnt vmcnt(0)" ::: "memory");
        __syncthreads();
#pragma unroll
        for (int kk = 0; kk < 4; ++kk) {
            const int k = half * 4 + kk;
            if (k >= cnt) break;
            const int item = first + k * stride;
            bf16_t* UT = (bf16_t*)p.out + (size_t)item * 8192; bf16_t* Wg = (bf16_t*)p.out + (size_t)MTOK * D + (size_t)item * 8192;
            LAS unsigned char* Tb = lds + k * CP_SLOT_B;
#pragma unroll
            for (int t4 = 0; t4 < 4; ++t4) {
                const bf16x8 t0 = *(const LAS bf16x8*)(Tb + t4 * 2048 + offK0), t1 = *(const LAS bf16x8*)(Tb + t4 * 2048 + offK1);
                f32x4 acc = {0.f, 0.f, 0.f, 0.f};
                acc = MFMA16(t0, vbA[kk][0], acc); acc = MFMA16(t1, vbA[kk][1], acc);
                u32x2 o; o[0] = pk_bf16(acc[0], acc[1]); o[1] = pk_bf16(acc[2], acc[3]);
                *(u32x2*)(UT + (size_t)((wave * 4 + t4) * 64 + lane) * 4) = o; }
#pragma unroll
            for (int ti = 0; ti < 2; ++ti) {
                const int tn = wt0 + ti;
                const bf16x8 t0 = *(const LAS bf16x8*)(Tb + tn * 2048 + offK0), t1 = *(const LAS bf16x8*)(Tb + tn * 2048 + offK1);
                f32x4 a0 = {0.f, 0.f, 0.f, 0.f}, a1 = {0.f, 0.f, 0.f, 0.f};
                a0 = MFMA16(kbA[kk][0], t0, a0); a0 = MFMA16(kbA[kk][1], t1, a0);
                a1 = MFMA16(kbA[kk][2], t0, a1); a1 = MFMA16(kbA[kk][3], t1, a1);
                u32x4 o; o[0] = pk_bf16(a0[0], a0[1]); o[1] = pk_bf16(a0[2], a0[3]); o[2] = pk_bf16(a1[0], a1[1]); o[3] = pk_bf16(a1[2], a1[3]);
                *(u32x4*)(Wg + (size_t)((tn * 4 + ws2) * 64 + lane) * 8) = o; }
        }
    }
    asm volatile("s_waitcnt vmcnt(0)" ::: "memory");
    __syncthreads();
}

constexpr int SC_W = 0, SC_QD = 16384, SC_KDT = 32768, SC_A = 49152, SC_BUF = 57344;
DI void scan_stage(LAS unsigned char* lds, int buf, const Params& p, int item, int wave, int lane) {
    const unsigned char* Wp = (const unsigned char*)((const bf16_t*)p.out + (size_t)MTOK * D + (size_t)item * 8192);
    const unsigned char* QDp = (const unsigned char*)((const bf16_t*)(p.ws + WS_QD) + (size_t)item * 8192);
    const unsigned char* KDTp = (const unsigned char*)((const bf16_t*)(p.ws + WS_KDT) + (size_t)item * 8192);
    const unsigned char* Ap = (const unsigned char*)((const bf16_t*)(p.ws + WS_AG) + (size_t)item * 4096);
    const int r4 = lane >> 4, c4 = lane & 15, r8 = lane >> 3, c8 = lane & 7;
#pragma unroll
    for (int k = 0; k < 7; ++k) {
        const int i = wave + 8 * k;
        const unsigned char* g; int loff;
        if (i < 16) { g = Wp + i * 1024 + lane * 16; loff = SC_W + i * 1024; }
        else if (i < 32) { const int ii = i & 15, r = 4 * ii + r4, c = c4 ^ (r & 15);
            g = QDp + r * 256 + c * 16; loff = SC_QD + ii * 1024; }
        else if (i < 48) { const int ii = i - 32; g = KDTp + ii * 1024 + lane * 16; loff = SC_KDT + ii * 1024; }
        else { const int ii = i - 48; g = Ap + ii * 1024 + lane * 16; loff = SC_A + ii * 1024; }
        __builtin_amdgcn_global_load_lds((const unsigned*)g, (LAS unsigned*)(lds + buf * SC_BUF + loff), 16, 0, 0);
    }
}
DI void dn_scan(const Params& p, LAS unsigned char* lds, int bh) {
    int tid = threadIdx.x; asm volatile("" : "+v"(tid));
    const int lane = tid & 63, wave = __builtin_amdgcn_readfirstlane(tid >> 6), fr = lane & 15, fq = lane >> 4;
    unsigned char* ws = p.ws;
    f32x4 S[8];
#pragma unroll
    for (int t = 0; t < 8; ++t) S[t] = (f32x4){0.f, 0.f, 0.f, 0.f};
    const float glv = ((const float*)(ws + WS_GL))[bh * 32 + (lane & 31)];
    int offW[4], offK[2];
#pragma unroll
    for (int s = 0; s < 4; ++s) offW[s] = fr * 256 + (((4 * s + fq) ^ fr) * 16);
#pragma unroll
    for (int s = 0; s < 2; ++s) offK[s] = fr * 128 + (((4 * s + fq) ^ (fr >> 1)) * 16);
    bf16_t* UT0 = (bf16_t*)p.out + (size_t)(bh * 32) * 8192 + (size_t)(wave * 4 * 64 + lane) * 4;
    scan_stage(lds, 0, p, bh * 32, wave, lane);
    u32x2 ucur[4];
#pragma unroll
    for (int tm = 0; tm < 4; ++tm) ucur[tm] = *(const u32x2*)(UT0 + 256 * tm);
    for (int n = 0; n < 32; ++n) {
        const int item = bh * 32 + n, buf = n & 1;
        asm volatile("s_waitcnt vmcnt(0)" ::: "memory");
        __syncthreads();
        u32x2 unext[4];
        if (n + 1 < 32) {
            scan_stage(lds, buf ^ 1, p, item + 1, wave, lane);
#pragma unroll
            for (int tm = 0; tm < 4; ++tm) unext[tm] = *(const u32x2*)(UT0 + (size_t)(n + 1) * 8192 + 256 * tm);
        } else {
#pragma unroll
            for (int tm = 0; tm < 4; ++tm) unext[tm] = (u32x2){0u, 0u};
        }
        const float gl = __builtin_bit_cast(float, __builtin_amdgcn_readlane(__builtin_bit_cast(int, glv), n));
        LAS unsigned char* B = lds + buf * SC_BUF;
        bf16_t* UTp = UT0 + (size_t)n * 8192;
        bf16x8 Sf[4];
#pragma unroll
        for (int s = 0; s < 4; ++s) Sf[s] = pack8(S[2 * s], S[2 * s + 1]);
        f32x4 vn[4];
#pragma unroll
        for (int tm = 0; tm < 4; ++tm) {
            f32x4 acc = {0.f, 0.f, 0.f, 0.f};
#pragma unroll
            for (int s = 0; s < 4; ++s) { const bf16x8 a = *(const LAS bf16x8*)(B + SC_W + (tm * 4 + s) * 1024 + lane * 16); acc = MFMA16(a, Sf[s], acc); }
            const u32x2 u = ucur[tm];
            vn[tm][0] = bflo(u[0]) - acc[0]; vn[tm][1] = bfhi(u[0]) - acc[1]; vn[tm][2] = bflo(u[1]) - acc[2]; vn[tm][3] = bfhi(u[1]) - acc[3];
        }
        bf16x8 Vf[2];
        Vf[0] = pack8(vn[0], vn[1]); Vf[1] = pack8(vn[2], vn[3]);
#pragma unroll
        for (int tm = 0; tm < 4; ++tm) {
            f32x4 acc = {0.f, 0.f, 0.f, 0.f};
#pragma unroll
            for (int s = 0; s < 4; ++s) { const bf16x8 a = *(const LAS bf16x8*)(B + SC_QD + tm * 4096 + offW[s]); acc = MFMA16(a, Sf[s], acc); }
#pragma unroll
            for (int s = 0; s < 2; ++s) { const bf16x8 a = *(const LAS bf16x8*)(B + SC_A + (tm * 2 + s) * 1024 + lane * 16); acc = MFMA16(a, Vf[s], acc); }
            u32x2 o; o[0] = pk_bf16(acc[0], acc[1]); o[1] = pk_bf16(acc[2], acc[3]);
            *(u32x2*)(UTp + 256 * tm) = o;
        }
#pragma unroll
        for (int t = 0; t < 8; ++t) {
            f32x4 acc = S[t] * gl;
#pragma unroll
            for (int s = 0; s < 2; ++s) {
                const u32x2 lo = *(const LAS u32x2*)(B + SC_KDT + ((4 * s + (fq >> 1)) * 128 + 16 * t + fr) * 16 + (fq & 1) * 8);
                const u32x2 hi = *(const LAS u32x2*)(B + SC_KDT + ((4 * s + 2 + (fq >> 1)) * 128 + 16 * t + fr) * 16 + (fq & 1) * 8);
                u32x4 av; av[0] = lo[0]; av[1] = lo[1]; av[2] = hi[0]; av[3] = hi[1];
                acc = MFMA16(__builtin_bit_cast(bf16x8, av), Vf[s], acc); }
            S[t] = acc;
        }
#pragma unroll
        for (int tm = 0; tm < 4; ++tm) ucur[tm] = unext[tm];
    }
    asm volatile("s_waitcnt vmcnt(0)" ::: "memory");
    __syncthreads();
}

constexpr int AT_VT = 32768;
struct AtRaw { u32x4 k[4], v[4]; bf16x8 q[2]; };
struct AtItem { int b, head, dil, res, blk; };
DI AtItem at_decode(int item) {
    AtItem I; const int sub = item & 15; I.head = (item >> 4) % 12; I.b = item / 192;
    const int grp = I.head >> 2; I.dil = grp == 0 ? 1 : (grp == 1 ? 4 : 16); const int nbk = 16 / I.dil;
    I.res = sub / nbk; I.blk = sub % nbk; return I;
}
DI void at_load(AtRaw& R, const Params& p, int item, int tid) {
    const AtItem I = at_decode(item);
    const bf16_t* PB = (const bf16_t*)(p.ws + WS_R1);
    const int kk = tid >> 1, half = tid & 1, lk = (I.blk - 1) * 128 + kk;
    if (lk >= 0) { const bf16_t* rp = PB + (size_t)(I.b * SEQ + lk * I.dil + I.res) * 2304 + I.head * 64 + half * 32;
#pragma unroll
        for (int i = 0; i < 4; ++i) { R.k[i] = *(const u32x4*)(rp + 768 + 8 * i); R.v[i] = *(const u32x4*)(rp + 1536 + 8 * i); }
    } else {
#pragma unroll
        for (int i = 0; i < 4; ++i) { R.k[i] = (u32x4){0u, 0u, 0u, 0u}; R.v[i] = (u32x4){0u, 0u, 0u, 0u}; }
    }
    const int lane = tid & 63, wave = tid >> 6, fr = lane & 15, fq = lane >> 4;
    const int tq = (I.blk * 128 + 16 * wave + fr) * I.dil + I.res;
    const bf16_t* qrow = PB + (size_t)(I.b * SEQ + tq) * 2304 + I.head * 64;
    R.q[0] = *(const bf16x8*)(qrow + 8 * fq); R.q[1] = *(const bf16x8*)(qrow + 32 + 8 * fq);
}
DI void at_store_lds(const AtRaw& R, LAS unsigned char* lds, int tid) {
    const int kk = tid >> 1, half = tid & 1;
#pragma unroll
    for (int i = 0; i < 4; ++i) { const int c = half * 4 + i; *(LAS u32x4*)(lds + kk * 128 + ((c ^ ((kk >> 1) & 7)) * 16)) = R.k[i]; }
#pragma unroll
    for (int i = 0; i < 4; ++i)
#pragma unroll
        for (int e = 0; e < 4; ++e) { const int d0 = half * 32 + 8 * i + 2 * e, d1 = d0 + 1;
            *(LAS bf16_t*)(lds + AT_VT + d0 * 512 + (((kk >> 2) ^ ((d0 & 15) << 2)) * 8) + (kk & 3) * 2) = (bf16_t)(R.v[i][e] & 0xffffu);
            *(LAS bf16_t*)(lds + AT_VT + d1 * 512 + (((kk >> 2) ^ ((d1 & 15) << 2)) * 8) + (kk & 3) * 2) = (bf16_t)(R.v[i][e] >> 16); }
}
DI void at_compute(const Params& p, LAS unsigned char* lds, int item, const bf16x8 (&Qf)[2], int tid) {
    const int lane = tid & 63, wave = __builtin_amdgcn_readfirstlane(tid >> 6), fr = lane & 15, fq = lane >> 4;
    const AtItem I = at_decode(item);
    bf16_t* OB = (bf16_t*)(p.ws + WS_OB);
    float* LSE = (float*)(p.ws + WS_LSE);
    const int iq = 16 * wave + fr;
    const int tq = (I.blk * 128 + iq) * I.dil + I.res;
    const int offK0 = fr * 128 + (((0 + fq) ^ (fr >> 1)) * 16), offK1 = fr * 128 + (((4 + fq) ^ (fr >> 1)) * 16);
    const int kb2 = wave >> 1;
    f32x4 sc[10];
    float mx = -3.0e38f;
#pragma unroll
    for (int i = 0; i < 10; ++i) {
        const int kt = 2 * kb2 + i;
        if (kt < wave || kt > wave + 8) { sc[i] = (f32x4){-3.0e38f, -3.0e38f, -3.0e38f, -3.0e38f}; continue; }
        const bf16x8 a0 = *(const LAS bf16x8*)(lds + kt * 2048 + offK0), a1 = *(const LAS bf16x8*)(lds + kt * 2048 + offK1);
        f32x4 acc = {0.f, 0.f, 0.f, 0.f};
        acc = MFMA16(a0, Qf[0], acc); acc = MFMA16(a1, Qf[1], acc);
#pragma unroll
        for (int r = 0; r < 4; ++r) { const int kk = 16 * kt + 4 * fq + r;
            const bool valid = (kk >= iq) && (kk <= iq + 128) && (I.blk > 0 || kk >= 128);
            const float v = valid ? acc[r] * 0.125f : -3.0e38f; acc[r] = v; mx = fmaxf(mx, v); }
        sc[i] = acc;
    }
    mx = fmaxf(mx, __shfl_xor(mx, 16)); mx = fmaxf(mx, __shfl_xor(mx, 32));
    float den = 0.f;
    const float mxl = mx * 1.4426950408889634f;
#pragma unroll
    for (int i = 0; i < 10; ++i)
#pragma unroll
        for (int r = 0; r < 4; ++r) { const float v = sc[i][r]; const float e = (v > -1.0e38f) ? __builtin_amdgcn_exp2f(v * 1.4426950408889634f - mxl) : 0.f; sc[i][r] = e; den += e; }
    den += __shfl_xor(den, 16); den += __shfl_xor(den, 32);
    const float rden = __builtin_amdgcn_rcpf(den);
    bf16_t* orow = OB + (size_t)(I.b * SEQ + tq) * 768 + I.head * 64;
    f32x4 oacc[4];
#pragma unroll
    for (int dt = 0; dt < 4; ++dt) oacc[dt] = (f32x4){0.f, 0.f, 0.f, 0.f};
#pragma unroll
    for (int si = 0; si < 5; ++si) {
        const int s = kb2 + si;
        const bf16x8 Pf = pack8(sc[2 * si], sc[2 * si + 1]);
#pragma unroll
        for (int dt = 0; dt < 4; ++dt) {
            const u32x2 lo = *(const LAS u32x2*)(lds + AT_VT + (16 * dt + fr) * 512 + (((8 * s + fq) ^ (fr << 2)) * 8));
            const u32x2 hi = *(const LAS u32x2*)(lds + AT_VT + (16 * dt + fr) * 512 + (((8 * s + 4 + fq) ^ (fr << 2)) * 8));
            u32x4 av; av[0] = lo[0]; av[1] = lo[1]; av[2] = hi[0]; av[3] = hi[1];
            oacc[dt] = MFMA16(__builtin_bit_cast(bf16x8, av), Pf, oacc[dt]);
        }
    }
#pragma unroll
    for (int dt = 0; dt < 4; ++dt) { u32x2 o; o[0] = pk_bf16(oacc[dt][0] * rden, oacc[dt][1] * rden); o[1] = pk_bf16(oacc[dt][2] * rden, oacc[dt][3] * rden);
        *(u32x2*)(orow + 16 * dt + 4 * fq) = o; }
    if (fq == 0) LSE[(size_t)(I.b * SEQ + tq) * 12 + I.head] = mx + __logf(den);
}
DI void attn_phase(const Params& p, LAS unsigned char* lds, int it, int it_end) {
    int tid = threadIdx.x; asm volatile("" : "+v"(tid));
    if (it >= it_end) return;
    AtRaw R;
    at_load(R, p, it, tid);
    for (; it < it_end; ++it) {
        at_store_lds(R, lds, tid);
        __syncthreads();
        bf16x8 Qf[2]; Qf[0] = R.q[0]; Qf[1] = R.q[1];
        if (it + 1 < it_end) at_load(R, p, it + 1, tid);
        at_compute(p, lds, it, Qf, tid);
        __syncthreads();
    }
}

DI void ya_phase(const Params& p) {
    int tid = threadIdx.x; asm volatile("" : "+v"(tid));
    const int lane = tid & 63, wave = tid >> 6;
    const bf16_t* Z = (const bf16_t*)p.out + (size_t)MTOK * D;
    bf16_t* YA = (bf16_t*)(p.ws + WS_YA);
    const float nw0 = p.dn_norm_w[lane], nw1 = p.dn_norm_w[lane + 64];
    for (int task = blockIdx.x * 8 + wave; task < 2048 * 8; task += gridDim.x * 8) {
        const int item = task >> 3, tg = task & 7;
        const int bh = item >> 5, n = item & 31, b = bh >> 3, h = bh & 7;
        const bf16_t* OA = (const bf16_t*)p.out + (size_t)item * 8192 + (size_t)(((lane >> 4) * 4 + (tg >> 1)) * 64 + 2 * (tg & 1) * 16 + (lane & 15)) * 4;
        const u32x2 p00 = *(const u32x2*)OA, p01 = *(const u32x2*)(OA + 64), p10 = *(const u32x2*)(OA + 4 * 4 * 256), p11 = *(const u32x2*)(OA + 4 * 4 * 256 + 64);
        u32x4 o0, o1; o0[0] = p00[0]; o0[1] = p00[1]; o0[2] = p01[0]; o0[3] = p01[1]; o1[0] = p10[0]; o1[1] = p10[1]; o1[2] = p11[0]; o1[3] = p11[1];
        const size_t row0 = (size_t)(b * SEQ + n * 64 + tg * 8);
        const bf16_t* zp = Z + row0 * 1024 + h * 128 + lane;
        bf16_t z0[8], z1[8];
#pragma unroll
        for (int e = 0; e < 8; ++e) { z0[e] = zp[(size_t)e * 1024]; z1[e] = zp[(size_t)e * 1024 + 64]; }
        float a0[8], a1[8];
#pragma unroll
        for (int e = 0; e < 4; ++e) { a0[2 * e] = bflo(o0[e]); a0[2 * e + 1] = bfhi(o0[e]); a1[2 * e] = bflo(o1[e]); a1[2 * e + 1] = bfhi(o1[e]); }
        bf16_t* yp = YA + row0 * D + h * 128 + lane;
#pragma unroll
        for (int e = 0; e < 8; ++e) {
            const float ss = wave_sum(a0[e] * a0[e] + a1[e] * a1[e]);
            const float rstd = rsqrtf(ss * (1.f / 128.f) + EPS);
            yp[(size_t)e * D] = f2bf(a0[e] * rstd * nw0 * bf2f(z0[e]));
            yp[(size_t)e * D + 64] = f2bf(a1[e] * rstd * nw1 * bf2f(z1[e]));
        }
    }
}
DI void yb_rows(const Params& p) {
    int tid = threadIdx.x; asm volatile("" : "+v"(tid));
    const int lane = tid & 63, wave = tid >> 6;
    bf16_t* OB = (bf16_t*)(p.ws + WS_OB);
    const bf16_t* Z = (const bf16_t*)(p.ws + WS_ZB);
    const float* LSE = (const float*)(p.ws + WS_LSE);
    const int c0 = lane, c1 = lane + 64;
    const int j0 = (c0 >> 3) & 3, j1 = (c1 >> 3) & 3, g0 = c0 >> 5, g1 = c1 >> 5;
    for (int rq = blockIdx.x * 8 + wave; rq < MTOK / 4; rq += gridDim.x * 8) {
        float l0[4][3], l1[4][3]; u32x4 o0[4], o1[4], z0[4], z1[4];
#pragma unroll
        for (int r = 0; r < 4; ++r) { const size_t row = (size_t)rq * 4 + r;
#pragma unroll
            for (int g = 0; g < 3; ++g) { l0[r][g] = LSE[row * 12 + 4 * g + j0]; l1[r][g] = LSE[row * 12 + 4 * g + j1]; }
            o0[r] = *(const u32x4*)(OB + row * 768 + c0 * 8); z0[r] = *(const u32x4*)(Z + row * 768 + c0 * 8);
            if (c1 < 96) { o1[r] = *(const u32x4*)(OB + row * 768 + c1 * 8); z1[r] = *(const u32x4*)(Z + row * 768 + c1 * 8); }
            else { o1[r] = (u32x4){0u, 0u, 0u, 0u}; z1[r] = (u32x4){0u, 0u, 0u, 0u}; } }
#pragma unroll
        for (int r = 0; r < 4; ++r) { const size_t row = (size_t)rq * 4 + r;
            { const float m = fmaxf(l0[r][0], fmaxf(l0[r][1], l0[r][2]));
              const float e0 = __expf(l0[r][0] - m), e1 = __expf(l0[r][1] - m), e2 = __expf(l0[r][2] - m);
              const float w = (g0 == 0 ? e0 : (g0 == 1 ? e1 : e2)) * __builtin_amdgcn_rcpf(e0 + e1 + e2);
              u32x4 rr;
#pragma unroll
              for (int e = 0; e < 4; ++e) rr[e] = pk_bf16(bflo(o0[r][e]) * w * bflo(z0[r][e]), bfhi(o0[r][e]) * w * bfhi(z0[r][e]));
              *(u32x4*)(OB + row * 768 + c0 * 8) = rr; }
            if (c1 < 96) { const float m = fmaxf(l1[r][0], fmaxf(l1[r][1], l1[r][2]));
              const float e0 = __expf(l1[r][0] - m), e1 = __expf(l1[r][1] - m), e2 = __expf(l1[r][2] - m);
              const float w = (g1 == 0 ? e0 : (g1 == 1 ? e1 : e2)) * __builtin_amdgcn_rcpf(e0 + e1 + e2);
              u32x4 rr;
#pragma unroll
              for (int e = 0; e < 4; ++e) rr[e] = pk_bf16(bflo(o1[r][e]) * w * bflo(z1[r][e]), bfhi(o1[r][e]) * w * bfhi(z1[r][e]));
              *(u32x4*)(OB + row * 768 + c1 * 8) = rr; }
        }
    }
}

DI void final_norm(const Params& p) {
    int tid = threadIdx.x; asm volatile("" : "+v"(tid));
    const int lane = tid & 63, wave = tid >> 6;
    f32x4 w[4];
#pragma unroll
    for (int i = 0; i < 4; ++i) w[i] = *(const f32x4*)(p.fnw + i * 256 + lane * 4);
    for (int rq = blockIdx.x * 8 + wave; rq < MTOK / 4; rq += gridDim.x * 8) {
        f32x4 xv[4][4];
#pragma unroll
        for (int r = 0; r < 4; ++r)
#pragma unroll
            for (int i = 0; i < 4; ++i) xv[r][i] = *(const f32x4*)(p.out + ((size_t)rq * 4 + r) * D + i * 256 + lane * 4);
#pragma unroll
        for (int r = 0; r < 4; ++r) { float ss = 0.f;
#pragma unroll
            for (int i = 0; i < 4; ++i) ss += xv[r][i][0] * xv[r][i][0] + xv[r][i][1] * xv[r][i][1] + xv[r][i][2] * xv[r][i][2] + xv[r][i][3] * xv[r][i][3];
            ss = wave_sum(ss);
            const float rstd = rsqrtf(ss * (1.f / 1024.f) + EPS);
#pragma unroll
            for (int i = 0; i < 4; ++i) *(f32x4*)(p.out + ((size_t)rq * 4 + r) * D + i * 256 + lane * 4) = xv[r][i] * rstd * w[i]; }
    }
}

__global__ void __launch_bounds__(512, 2) fwd_megakernel(Params p) {
    extern __shared__ __attribute__((aligned(16))) unsigned char lds_raw[];
    LAS unsigned char* lds = (LAS unsigned char*)lds_raw;
    cg::grid_group grid = cg::this_grid();
    unsigned char* ws = p.ws;
    const int G = gridDim.x, bid = blockIdx.x;

    unsigned* barp = (unsigned*)(ws + WS_BAR);
    if (threadIdx.x < 4) ((LAS unsigned*)(lds + 138240))[threadIdx.x] = 0u;
    __syncthreads();
    XcdBarrier xb = xcd_barrier_post(barp, (volatile LAS unsigned*)(lds + 138240), (unsigned)G);
    if (p.ws == nullptr) grid.sync();
    phase0(p, lds);
    __syncthreads();
    phase1(p, lds);
    xcd_barrier(xb);
    {
        pg8::Gemm g{(const bf16_t*)(ws + WS_H), (const bf16_t*)(ws + WS_WT_IN), MTOK, 3072, 1024};
        pg8::StaticOrder S; S.init(MTOK, 3072, G, bid);
        pg8::EpiProj1<3072> E{(bf16_t*)(ws + WS_R1)};
        pg8::gemm_phase<pg8::EpiProj1<3072>, true>(lds, g, S, E);
    }
    xcd_barrier(xb);
    for (int base = bid; base < 2048; base += 8 * G) { int cnt = (2048 - base + G - 1) / G; if (cnt > 8) cnt = 8; chunk_prep_batch(p, lds, base, G, cnt); }
    xcd_barrier(xb);
    if (bid < 64) dn_scan(p, lds, bid);
    else {
        pg8::Gemm g{(const bf16_t*)(ws + WS_H), (const bf16_t*)(ws + WS_WT_IN) + (size_t)3072 * 1024, MTOK, 2304, 1024};
        pg8::StaticOrder S; S.init(MTOK, 2304, G - 64, bid - 64);
        pg8::EpiProj1<2304> E{(bf16_t*)(ws + WS_R1)};
        pg8::gemm_phase<pg8::EpiProj1<2304>, true>(lds, g, S, E);
        if (G == 256) {
            { XcdBarrier sb = xcd_barrier_post((unsigned*)(ws + WS_BAR + 32768), (volatile LAS unsigned*)(lds + 138248), 192u); xcd_barrier(sb); }
            attn_phase(p, lds, (bid - 64) * 4, (bid - 64) * 4 + 4);
        }
    }
    xcd_barrier(xb);
    {
        int a0, a1;
        if (G == 256) { if (bid < 192) { a0 = 768 + bid * 2; a1 = a0 + 2; } else { a0 = 1152 + (bid - 192) * 6; a1 = a0 + 6; } }
        else { const int per = (1536 + G - 1) / G; a0 = bid * per; a1 = a0 + per; if (a1 > 1536) a1 = 1536; }
        pg8::Gemm g{(const bf16_t*)(ws + WS_H), (const bf16_t*)(ws + WS_WT_IN) + (size_t)5376 * 1024, MTOK, 3840, 1024};
        pg8::StaticOrder S; S.init(MTOK, 3840, G, bid);
        pg8::EpiProjC E{ws, p.out};
        if (bid & 1) attn_phase(p, lds, a0, a1);
        pg8::gemm_phase<pg8::EpiProjC, true>(lds, g, S, E);
        if (!(bid & 1)) attn_phase(p, lds, a0, a1);
    }
    xcd_barrier(xb);
    ya_phase(p);
    yb_rows(p);
    xcd_barrier(xb);
    {
        pg8::StaticOrder S; S.init(MTOK, 1024, G, bid);
        pg8::Gemm g1{(const bf16_t*)(ws + WS_YA), (const bf16_t*)(ws + WS_WT_PA), MTOK, 1024, 1024};
        pg8::Gemm g2{(const bf16_t*)(ws + WS_OB), (const bf16_t*)(ws + WS_WT_PB), MTOK, 1024, 768};
        pg8::EpiMerge2 E{(bf16_t*)(ws + WS_H), (const bf16_t*)(ws + WS_R2)};
        pg8::Unit u; S.next(0, u);
        unsigned* pw = (unsigned*)(ws + WS_BAR + 49152) + u.pm * 64;
        panel_post_xcc(pw);
        pg8::gemm_phase2(lds, g1, g2, S, E);
        panel_handoff(pw);
    }
    {
        pg8::StaticOrder S; S.init(MTOK, 1024, G, bid);
        pg8::Gemm g{(const bf16_t*)(ws + WS_H), (const bf16_t*)(ws + WS_WT_O), MTOK, 1024, 1024};
        pg8::EpiOutNorm E{p.x, (const float*)(ws + WS_MOD), p.fnw, p.out, (float*)(ws + WS_RS), (unsigned*)(ws + WS_BAR + 16384)};
        pg8::gemm_phase(lds, g, S, E);
    }
}

extern "C" void kernel_launch(void* const* d_in, const int* in_sizes, int n_in, void* d_out, int out_size, void* d_ws, size_t ws_size, hipStream_t stream) {
    static int grid_blocks = 0;
    if (!grid_blocks) {
        int dev = 0, cus = 0, per_cu = 0;
        hipGetDevice(&dev);
        hipDeviceGetAttribute(&cus, hipDeviceAttributeMultiprocessorCount, dev);
        hipFuncSetAttribute((const void*)fwd_megakernel, hipFuncAttributeMaxDynamicSharedMemorySize, LDS_BYTES);
        hipOccupancyMaxActiveBlocksPerMultiprocessor(&per_cu, (const void*)fwd_megakernel, 512, LDS_BYTES);
        if (per_cu < 1) per_cu = 1;
        grid_blocks = cus;
        if (ws_size < WS_END) fprintf(stderr, "kernel_launch: workspace too small (%zu < %zu)\n", ws_size, (size_t)WS_END);
        (void)hipGetLastError();
    }
    Params p{};
    p.x = (const float*)d_in[0]; p.c = (const float*)d_in[1]; p.norm_w = (const float*)d_in[2]; p.ada_w = (const float*)d_in[3]; p.ada_b = (const float*)d_in[4];
    p.w_in = (const float*)d_in[5]; p.conv_w = (const float*)d_in[6]; p.a_log = (const float*)d_in[7]; p.dt_bias = (const float*)d_in[8]; p.dn_norm_w = (const float*)d_in[9];
    p.w_pa = (const float*)d_in[10]; p.w_pb = (const float*)d_in[11]; p.w_out = (const float*)d_in[12]; p.fnw = (const float*)d_in[13];
    p.out = (float*)d_out; p.ws = (unsigned char*)d_ws;
    (void)hipMemsetAsync((unsigned char*)d_ws + WS_BAR, 0, 65536, stream);
    void* args[] = {&p};
    hipError_t e = hipLaunchCooperativeKernel((const void*)fwd_megakernel, dim3(grid_blocks), dim3(512), args, LDS_BYTES, stream);
    if (e != hipSuccess) fprintf(stderr, "cooperative launch failed: %s (grid %d)\n", hipGetErrorString(e), grid_blocks);
}
```

```cpp
#include <hip/hip_runtime.h>
#include <hip/hip_cooperative_groups.h>
#include <cstdio>
namespace cg = cooperative_groups;

#define LAS __attribute__((address_space(3)))
typedef unsigned short bf16_t;
typedef short bf16x8 __attribute__((ext_vector_type(8)));
typedef float f32x4 __attribute__((ext_vector_type(4)));
typedef float f32x2 __attribute__((ext_vector_type(2)));
typedef unsigned u32x4 __attribute__((ext_vector_type(4)));
typedef unsigned u32x2 __attribute__((ext_vector_type(2)));
typedef __bf16 bf2_t __attribute__((ext_vector_type(2)));
#define DI __device__ __forceinline__

constexpr int D = 1024, NB = 8, SEQ = 2048, MTOK = NB * SEQ;
constexpr int N_IN = 9232;
constexpr float EPS = 1e-6f;
constexpr size_t MiB = 1048576;
constexpr size_t WS_WT_IN = 0;
constexpr size_t WS_WT_PA = 18 * MiB;
constexpr size_t WS_WT_PB = 20 * MiB;
constexpr size_t WS_WT_O  = 21 * MiB + 512 * 1024;
constexpr size_t WS_MOD   = 23 * MiB + 512 * 1024;
constexpr size_t WS_BETA  = WS_MOD + 128 * 1024;
constexpr size_t WS_G     = WS_BETA + 512 * 1024;
constexpr size_t WS_GL    = WS_G + 512 * 1024;
constexpr size_t WS_BAR   = WS_GL + 64 * 1024;
constexpr size_t WS_LSE   = 24 * MiB + 768 * 1024;
static_assert(WS_BAR + 4096 <= WS_LSE && WS_LSE + 768 * 1024 <= 26 * MiB, "ws map");
constexpr size_t WS_H     = 26 * MiB;
constexpr size_t WS_R1    = 58 * MiB;
constexpr size_t WS_OB    = WS_R1 + 72 * MiB;
constexpr size_t WS_R2    = 154 * MiB;
constexpr size_t WS_QD    = WS_R2;
constexpr size_t WS_KDT   = WS_R2 + 32 * MiB;
constexpr size_t WS_AG    = WS_R2 + 64 * MiB;
constexpr size_t WS_MODP  = 234 * MiB;
constexpr size_t WS_RS    = 25 * MiB + 512 * 1024;
constexpr size_t WS_ZB    = 218 * MiB;
constexpr size_t WS_YA    = WS_R1;
constexpr size_t WS_END   = 235 * MiB;
constexpr int LDS_BYTES = 138240 + 16;

struct Params {
    const float *x, *c, *norm_w, *ada_w, *ada_b, *w_in, *conv_w, *a_log, *dt_bias, *dn_norm_w, *w_pa, *w_pb, *w_out, *fnw;
    float* out; unsigned char* ws;
};

DI unsigned pk_bf16(float lo, float hi) { f32x2 v = {lo, hi}; bf2_t b = __builtin_convertvector(v, bf2_t); return __builtin_bit_cast(unsigned, b); }
DI bf16_t f2bf(float x) { return (bf16_t)(pk_bf16(x, 0.f) & 0xffffu); }
DI float bf2f(bf16_t b) { return __uint_as_float(((unsigned)b) << 16); }
DI float bflo(unsigned u) { return __uint_as_float(u << 16); }
DI float bfhi(unsigned u) { return __uint_as_float(u & 0xffff0000u); }
DI float sigmoidf_(float v) { return __builtin_amdgcn_rcpf(1.f + __builtin_amdgcn_exp2f(v * -1.4426950408889634f)); }
DI float siluf_(float v) { return v * __builtin_amdgcn_rcpf(1.f + __builtin_amdgcn_exp2f(v * -1.4426950408889634f)); }
template <int CTRL> DI float dpp_f(float v) { return __builtin_bit_cast(float, __builtin_amdgcn_update_dpp(0, __builtin_bit_cast(int, v), CTRL, 0xf, 0xf, false)); }
DI float wave_sum(float v) {
    v += dpp_f<0x128>(v); v += dpp_f<0x124>(v); v += dpp_f<0x122>(v); v += dpp_f<0x121>(v);
    const int iv = __builtin_bit_cast(int, v);
    return __builtin_bit_cast(float, __builtin_amdgcn_readlane(iv, 0)) + __builtin_bit_cast(float, __builtin_amdgcn_readlane(iv, 16))
         + __builtin_bit_cast(float, __builtin_amdgcn_readlane(iv, 32)) + __builtin_bit_cast(float, __builtin_amdgcn_readlane(iv, 48));
}
DI void reduce8(const float (&p)[8], float (&tot)[8], int lane) {
    const bool b5 = (lane & 32) != 0, b4 = (lane & 16) != 0, b3 = (lane & 8) != 0;
    float q[4], r2[2];
#pragma unroll
    for (int e = 0; e < 4; ++e) { const float send = b5 ? p[e] : p[e + 4], keep = b5 ? p[e + 4] : p[e]; q[e] = keep + __shfl_xor(send, 32); }
#pragma unroll
    for (int e = 0; e < 2; ++e) { const float send = b4 ? q[e] : q[e + 2], keep = b4 ? q[e + 2] : q[e]; r2[e] = keep + __shfl_xor(send, 16); }
    const float send = b3 ? r2[0] : r2[1], keep = b3 ? r2[1] : r2[0];
    float s = keep + dpp_f<0x128>(send);
    s += dpp_f<0xB1>(s);
    s += dpp_f<0x4E>(s);
    s += dpp_f<0x141>(s);
    const int iv = __builtin_bit_cast(int, s);
#pragma unroll
    for (int e = 0; e < 8; ++e) tot[e] = __builtin_bit_cast(float, __builtin_amdgcn_readlane(iv, 8 * e));
}
DI bf16x8 pack8(const f32x4& a, const f32x4& b) {
    u32x4 p; p[0] = pk_bf16(a[0], a[1]); p[1] = pk_bf16(a[2], a[3]); p[2] = pk_bf16(b[0], b[1]); p[3] = pk_bf16(b[2], b[3]);
    return __builtin_bit_cast(bf16x8, p);
}

#define XB_TMO      128
#define XB_XCNT(j)  (256  + 64 * (j))
#define XB_XSUB(j)  (1280 + 64 * (j))
#define XB_XGEN(j)  (2304 + 64 * (j))
#define XB_TOP      3328
#define XB_TOPGEN   3392
#define XCD_BAR_WORDS 3456
#define XB_SPIN_CAP (1u << 18)
DI unsigned xb_ld(unsigned* p)              { return __hip_atomic_load(p, __ATOMIC_RELAXED, __HIP_MEMORY_SCOPE_AGENT); }
DI unsigned xb_add(unsigned* p, unsigned v) { return __hip_atomic_fetch_add(p, v, __ATOMIC_RELAXED, __HIP_MEMORY_SCOPE_AGENT); }
DI unsigned xb_xcc_id() { return (unsigned)__builtin_amdgcn_s_getreg((3 << 11) | 20) & 0xFu; }
#define XB_SPIN(cond, bar) do { unsigned _sp = 0; while (cond) { __builtin_amdgcn_s_sleep(1); \
    if ((++_sp & 255u) == 0u) { if (xb_ld(&(bar)[XB_TMO])) break; if (_sp > XB_SPIN_CAP) { atomicAdd(&(bar)[XB_TMO], 1u); break; } } } } while (0)
struct XcdBarrier { unsigned* bar; unsigned x; volatile LAS unsigned* st; unsigned total; };
DI XcdBarrier xcd_barrier_post(unsigned* bar, volatile LAS unsigned* st, unsigned total) {
    XcdBarrier b; b.bar = bar; b.x = xb_xcc_id(); b.st = st; b.total = total;
    if (threadIdx.x == 0) (void)xb_add(&bar[XB_XCNT(b.x)], 1u);
    return b;
}
DI void xcd_barrier_complete(unsigned* bar, unsigned x, unsigned G, unsigned& nloc, unsigned& nx) {
    unsigned sum, cnt, mine, sp = 0u;
    for (;;) {
        sum = 0u; cnt = 0u; mine = 0u;
#pragma unroll
        for (unsigned j = 0; j < 16; ++j) { const unsigned c = xb_ld(&bar[XB_XCNT(j)]); sum += c; cnt += (c > 0u) ? 1u : 0u; mine = (j == x) ? c : mine; }
        if (sum == G) break;
        __builtin_amdgcn_s_sleep(1);
        if ((++sp & 255u) == 0u) { if (xb_ld(&bar[XB_TMO])) break; if (sp > XB_SPIN_CAP) { atomicAdd(&bar[XB_TMO], 1u); break; } }
    }
    nloc = mine > 0u ? mine : 1u; nx = cnt > 0u ? cnt : 1u;
}
DI void xcd_barrier(const XcdBarrier& b) {
    asm volatile("s_waitcnt vmcnt(0)" ::: "memory");
    __syncthreads();
    if (threadIdx.x == 0) {
        unsigned* bar = b.bar;
        __builtin_amdgcn_s_waitcnt(0);
        unsigned nloc = b.st[0], nx = b.st[1];
        if (nloc == 0u) { xcd_barrier_complete(bar, b.x, b.total, nloc, nx); b.st[0] = nloc; b.st[1] = nx; }
        const unsigned old = xb_add(&bar[XB_XSUB(b.x)], 1u);
        const unsigned gen = old / nloc;
        if (old + 1u == (gen + 1u) * nloc) {
            __builtin_amdgcn_fence(__ATOMIC_RELEASE, "agent");
            asm volatile("s_waitcnt vmcnt(0)" ::: "memory");
            const unsigned og = xb_add(&bar[XB_TOP], 1u);
            const unsigned tg = og / nx;
            if (og + 1u == (tg + 1u) * nx) xb_add(&bar[XB_TOPGEN], 1u);
            else XB_SPIN(xb_ld(&bar[XB_TOPGEN]) == tg, bar);
            __builtin_amdgcn_fence(__ATOMIC_ACQUIRE, "agent");
            xb_add(&bar[XB_XGEN(b.x)], 1u);
            asm volatile("s_waitcnt vmcnt(0)" ::: "memory");
        } else {
            XB_SPIN(xb_ld(&bar[XB_XGEN(b.x)]) == gen, bar);
            __builtin_amdgcn_fence(__ATOMIC_ACQUIRE, "agent");
            asm volatile("s_waitcnt vmcnt(0)" ::: "memory");
        }
    }
    __syncthreads();
}
DI void subset_barrier(unsigned* ctr, unsigned nblk) {
    asm volatile("s_waitcnt vmcnt(0)" ::: "memory");
    __syncthreads();
    if (threadIdx.x == 0) {
        __builtin_amdgcn_fence(__ATOMIC_RELEASE, "agent");
        asm volatile("s_waitcnt vmcnt(0)" ::: "memory");
        __hip_atomic_fetch_add(ctr, 1u, __ATOMIC_RELAXED, __HIP_MEMORY_SCOPE_AGENT);
        unsigned sp = 0;
        while (__hip_atomic_load(ctr, __ATOMIC_RELAXED, __HIP_MEMORY_SCOPE_AGENT) < nblk) { __builtin_amdgcn_s_sleep(2); if (++sp > (1u << 24)) break; }
        __builtin_amdgcn_fence(__ATOMIC_ACQUIRE, "agent");
        asm volatile("s_waitcnt vmcnt(0)" ::: "memory");
    }
    __syncthreads();
}
DI void panel_post_xcc(unsigned* w) {
    if (threadIdx.x == 0) { __hip_atomic_fetch_add(w, 1u << (3u * (xb_xcc_id() & 7u)), __ATOMIC_RELAXED, __HIP_MEMORY_SCOPE_AGENT); __hip_atomic_fetch_add(w + 16, 1u, __ATOMIC_RELAXED, __HIP_MEMORY_SCOPE_AGENT); }
}
DI void panel_handoff(unsigned* w) {
    asm volatile("s_waitcnt vmcnt(0)" ::: "memory");
    __syncthreads();
    if (threadIdx.x == 0) {
        unsigned sp = 0;
        while (__hip_atomic_load(w + 16, __ATOMIC_RELAXED, __HIP_MEMORY_SCOPE_AGENT) < 4u) { __builtin_amdgcn_s_sleep(1); if (++sp > (1u << 24)) break; }
        const bool same = __hip_atomic_load(w, __ATOMIC_RELAXED, __HIP_MEMORY_SCOPE_AGENT) == (4u << (3u * (xb_xcc_id() & 7u)));
        if (!same) { __builtin_amdgcn_fence(__ATOMIC_RELEASE, "agent"); asm volatile("s_waitcnt vmcnt(0)" ::: "memory"); }
        __hip_atomic_fetch_add(w + 32, 1u, __ATOMIC_RELAXED, __HIP_MEMORY_SCOPE_AGENT);
        sp = 0;
        while (__hip_atomic_load(w + 32, __ATOMIC_RELAXED, __HIP_MEMORY_SCOPE_AGENT) < 4u) { __builtin_amdgcn_s_sleep(1); if (++sp > (1u << 24)) break; }
        if (!same) { __builtin_amdgcn_fence(__ATOMIC_ACQUIRE, "agent"); asm volatile("s_waitcnt vmcnt(0)" ::: "memory"); }
    }
    __syncthreads();
}
#define MFMA16(a, b, c) __builtin_amdgcn_mfma_f32_16x16x32_bf16((a), (b), (c), 0, 0, 0)

namespace pg8 {
constexpr int BM = 256, BK = 64, HALF = 128, HTB = HALF * BK * 2, STAGE_BYTES = 8 * HTB, NXCD = 8, WGM = 8;
DI int lds_byte(int r, int c) { const int st = (r >> 4) * 2 + (c >> 5), rr = r & 15, cc = c & 31, ob = rr * 64 + cc * 2; return st * 1024 + (ob ^ (((ob >> 9) & 1) << 5)); }
DI void stage_rc(int b, int& R, int& C) { const int st = b / 1024, sb = b % 1024, swz = sb ^ (((sb >> 9) & 1) << 5); R = (st >> 1) * 16 + swz / 64; C = (st & 1) * 32 + (swz % 64) / 2; }
DI int perm32(int rho) { const int n = rho >> 4, i = rho & 15; return 8 * (i >> 2) + 4 * n + (i & 3); }
struct Unit { int pm, pn; };
struct Gemm { const bf16_t* A; const bf16_t* Bt; int M, N, K; };
struct StaticOrder {
    int nM, nN, nwg, G, c;
    DI void init(int M, int N, int G_, int c_) { nM = M / BM; nN = N / BM; nwg = nM * nN; G = G_; c = c_; }
    DI bool next(int i, Unit& u) const {
        const long L = (long)i * G + c; if (L >= nwg) return false;
        int wgid = (int)L; { const int q = nwg / NXCD, r = nwg % NXCD, xcd = wgid % NXCD, off = wgid / NXCD; wgid = (xcd < r ? xcd * (q + 1) : r * (q + 1) + (xcd - r) * q) + off; }
        const int nig = WGM * nN, gid = wgid / nig, fm = gid * WGM, gsz = (nM - fm) < WGM ? (nM - fm) : WGM;
        u.pm = fm + ((wgid % nig) % gsz); u.pn = (wgid % nig) / gsz; return true;
    }
};

template <class Epi, bool ALIGN_EPI = false>
DI void gemm_phase(LAS unsigned char* lds, const Gemm g, const StaticOrder& S, const Epi& E) {
    int tid = threadIdx.x; asm volatile("" : "+v"(tid));
    const int wid = __builtin_amdgcn_readfirstlane(tid >> 6), lane = tid & 63, wr = wid >> 2, wc = wid & 3, fr = lane & 15, fq = lane >> 4;
    const int K = g.K, nt = K / BK;
    unsigned voffA[2], voffB[2];
#pragma unroll
    for (int i = 0; i < 2; ++i) { int R, C; stage_rc(tid * 16 + i * 8192, R, C); const int Rb = Epi::PERM ? ((R & ~31) + perm32(R & 31)) : R;
        voffA[i] = (unsigned)(R * K + C) * 2u; voffB[i] = (unsigned)(Rb * K + C) * 2u; }
    const size_t kstep = (size_t)(BK * 2);
    const size_t hstep = (size_t)HALF * K * 2;
    const size_t tstep = 2 * hstep;
    const unsigned ldsw = (unsigned)wid * 1024u;
    const int aoff = lds_byte(wr * 64 + fr, fq * 8), boff = lds_byte(wc * 32 + fr, fq * 8);
#define PG8_SA(b, h) (((b) * 2 + (h)) * HTB)
#define PG8_SB(b, h) ((4 + (b) * 2 + (h)) * HTB)
#define PG8_STAGE(bufoff, gbase, voff) do { _Pragma("unroll") for (int _i = 0; _i < 2; ++_i) \
        __builtin_amdgcn_global_load_lds((const unsigned*)((const char*)(gbase) + (voff)[_i]), (LAS unsigned*)(lds + (bufoff) + ldsw + _i * 8192), 16, 0, 0); } while (0)
#define PG8_LDA(dst, b, h) do { _Pragma("unroll") for (int m = 0; m < 4; ++m) _Pragma("unroll") for (int k = 0; k < 2; ++k) dst[m][k] = *(const LAS bf16x8*)(lds + PG8_SA(b, h) + aoff + m * 2048 + k * 1024); } while (0)
#define PG8_LDB(dst, b, h) do { _Pragma("unroll") for (int n = 0; n < 2; ++n) _Pragma("unroll") for (int k = 0; k < 2; ++k) dst[n][k] = *(const LAS bf16x8*)(lds + PG8_SB(b, h) + boff + n * 2048 + k * 1024); } while (0)
#define PG8_MMA(ai, bj, At, Bt) do { __builtin_amdgcn_s_setprio(1); _Pragma("unroll") for (int m = 0; m < 4; ++m) _Pragma("unroll") for (int n = 0; n < 2; ++n) _Pragma("unroll") for (int k = 0; k < 2; ++k) \
        acc[ai][bj][m][n] = __builtin_amdgcn_mfma_f32_16x16x32_bf16(Bt[n][k], At[m][k], acc[ai][bj][m][n], 0, 0, 0); __builtin_amdgcn_s_setprio(0); } while (0)
#define PG8_WAIT_V(n) asm volatile("s_waitcnt vmcnt(" #n ")" ::: "memory")
#define PG8_WAIT_L(n) asm volatile("s_waitcnt lgkmcnt(" #n ")" ::: "memory")
#define PG8_BAR __builtin_amdgcn_s_barrier()
#define PG8_SCHED __builtin_amdgcn_sched_barrier(0)
    Unit cur, nxt; int ui = 0;
    if (!S.next(0, cur)) return;
    f32x4 acc[2][2][4][2];
#pragma unroll
    for (int a = 0; a < 2; ++a)
#pragma unroll
        for (int b = 0; b < 2; ++b)
#pragma unroll
            for (int m = 0; m < 4; ++m)
#pragma unroll
                for (int n = 0; n < 2; ++n) acc[a][b][m][n] = (f32x4){0.f, 0.f, 0.f, 0.f};
    bf16x8 At[4][2], B0[2][2], B1[2][2];
    const char* cA = (const char*)g.A + (size_t)cur.pm * tstep; const char* cB = (const char*)g.Bt + (size_t)cur.pn * tstep;
    PG8_STAGE(PG8_SB(0, 0), cB, voffB); PG8_STAGE(PG8_SB(0, 1), cB + hstep, voffB); PG8_STAGE(PG8_SA(0, 0), cA, voffA); PG8_STAGE(PG8_SA(0, 1), cA + hstep, voffA);
    if (wr == 1) PG8_BAR;
    PG8_WAIT_V(2); PG8_BAR;
    PG8_STAGE(PG8_SB(1, 0), cB + kstep, voffB); PG8_STAGE(PG8_SA(1, 0), cA + kstep, voffA); PG8_STAGE(PG8_SB(1, 1), cB + hstep + kstep, voffB);
    PG8_WAIT_V(6); PG8_BAR;
    for (;;) {
        const bool has_next = S.next(ui + 1, nxt);
        const char* nA = has_next ? (const char*)g.A + (size_t)nxt.pm * tstep : cA; const char* nB = has_next ? (const char*)g.Bt + (size_t)nxt.pn * tstep : cB;
        for (int t = 0; t < nt; t += 2) {
            const bool last = (t == nt - 2);
            const char* a1 = cA + (size_t)(t + 1) * kstep;
            const char* a2 = last ? nA : cA + (size_t)(t + 2) * kstep; const char* b2 = last ? nB : cB + (size_t)(t + 2) * kstep;
            const char* a3 = a2 + kstep; const char* b3 = b2 + kstep;
            PG8_LDB(B0, 0, 0); PG8_LDB(B1, 0, 1); PG8_SCHED; PG8_LDA(At, 0, 0); PG8_STAGE(PG8_SA(1, 1), a1 + hstep, voffA);
            PG8_WAIT_V(8); PG8_WAIT_L(0); PG8_BAR; PG8_MMA(0, 0, At, B0); PG8_MMA(0, 1, At, B1); PG8_BAR; PG8_SCHED;
            PG8_LDA(At, 0, 1); PG8_STAGE(PG8_SB(0, 0), b2, voffB); PG8_STAGE(PG8_SB(0, 1), b2 + hstep, voffB); PG8_STAGE(PG8_SA(0, 0), a2, voffA);
            PG8_WAIT_V(8); PG8_WAIT_L(0); PG8_BAR; PG8_MMA(1, 0, At, B0); PG8_MMA(1, 1, At, B1); PG8_BAR; PG8_SCHED;
            PG8_LDB(B0, 1, 0); PG8_LDB(B1, 1, 1); PG8_SCHED; PG8_LDA(At, 1, 0); PG8_STAGE(PG8_SA(0, 1), a2 + hstep, voffA);
            PG8_WAIT_V(8); PG8_WAIT_L(0); PG8_BAR; PG8_MMA(0, 0, At, B0); PG8_MMA(0, 1, At, B1); PG8_BAR; PG8_SCHED;
            PG8_LDA(At, 1, 1); PG8_STAGE(PG8_SB(1, 0), b3, voffB); PG8_STAGE(PG8_SB(1, 1), b3 + hstep, voffB); PG8_STAGE(PG8_SA(1, 0), a3, voffA);
            PG8_WAIT_V(8); PG8_WAIT_L(0); PG8_BAR; PG8_MMA(1, 0, At, B0); PG8_MMA(1, 1, At, B1); PG8_BAR; PG8_SCHED;
        }
        if constexpr (ALIGN_EPI) { if (wr == 0) PG8_BAR; }
        if constexpr (!Epi::AFTER_DRAIN) E(acc, cur, wr, wc, fr, fq);
        if (!has_next) break;
#pragma unroll
        for (int a = 0; a < 2; ++a)
#pragma unroll
            for (int b = 0; b < 2; ++b)
#pragma unroll
                for (int m = 0; m < 4; ++m)
#pragma unroll
                    for (int n = 0; n < 2; ++n) acc[a][b][m][n] = (f32x4){0.f, 0.f, 0.f, 0.f};
        cur = nxt; cA = nA; cB = nB; ++ui;
        if constexpr (ALIGN_EPI) { if (wr == 1) PG8_BAR; }
    }
    PG8_WAIT_V(0);
    if constexpr (!ALIGN_EPI) { if (wr == 0) PG8_BAR; }
    PG8_BAR;
    if constexpr (Epi::AFTER_DRAIN) E.fused(acc, cur, wr, wc, fr, fq, lds);
#undef PG8_SA
#undef PG8_SB
#undef PG8_STAGE
#undef PG8_LDA
#undef PG8_LDB
#undef PG8_MMA
#undef PG8_WAIT_V
#undef PG8_WAIT_L
#undef PG8_BAR
#undef PG8_SCHED
}

template <class Epi>
DI void gemm_phase2(LAS unsigned char* lds, const Gemm g0, const Gemm g1, const StaticOrder& S, const Epi& E) {
    int tid = threadIdx.x; asm volatile("" : "+v"(tid));
    const int wid = __builtin_amdgcn_readfirstlane(tid >> 6), lane = tid & 63, wr = wid >> 2, wc = wid & 3, fr = lane & 15, fq = lane >> 4;
    unsigned rA[2], rB[2], c2[2];
#pragma unroll
    for (int i = 0; i < 2; ++i) { int R, C; stage_rc(tid * 16 + i * 8192, R, C); const int Rb = Epi::PERM ? ((R & ~31) + perm32(R & 31)) : R;
        rA[i] = (unsigned)R; rB[i] = (unsigned)Rb; c2[i] = (unsigned)C * 2u; }
    const unsigned k20 = (unsigned)g0.K * 2u, k21 = (unsigned)g1.K * 2u;
    const size_t kstep = (size_t)(BK * 2);
    const size_t hs0 = (size_t)HALF * g0.K * 2, hs1 = (size_t)HALF * g1.K * 2;
    const unsigned ldsw = (unsigned)wid * 1024u;
    const int aoff = lds_byte(wr * 64 + fr, fq * 8), boff = lds_byte(wc * 32 + fr, fq * 8);
#define PG8_SA(b, h) (((b) * 2 + (h)) * HTB)
#define PG8_SB(b, h) ((4 + (b) * 2 + (h)) * HTB)
#define PG8_STAGE(bufoff, gbase, rowv, k2) do { _Pragma("unroll") for (int _i = 0; _i < 2; ++_i) \
        __builtin_amdgcn_global_load_lds((const unsigned*)((const char*)(gbase) + ((rowv)[_i] * (k2) + c2[_i])), (LAS unsigned*)(lds + (bufoff) + ldsw + _i * 8192), 16, 0, 0); } while (0)
#define PG8_LDA(dst, b, h) do { _Pragma("unroll") for (int m = 0; m < 4; ++m) _Pragma("unroll") for (int k = 0; k < 2; ++k) dst[m][k] = *(const LAS bf16x8*)(lds + PG8_SA(b, h) + aoff + m * 2048 + k * 1024); } while (0)
#define PG8_LDB(dst, b, h) do { _Pragma("unroll") for (int n = 0; n < 2; ++n) _Pragma("unroll") for (int k = 0; k < 2; ++k) dst[n][k] = *(const LAS bf16x8*)(lds + PG8_SB(b, h) + boff + n * 2048 + k * 1024); } while (0)
#define PG8_MMA(ai, bj, At, Bt) do { __builtin_amdgcn_s_setprio(1); _Pragma("unroll") for (int m = 0; m < 4; ++m) _Pragma("unroll") for (int n = 0; n < 2; ++n) _Pragma("unroll") for (int k = 0; k < 2; ++k) \
        acc[ai][bj][m][n] = __builtin_amdgcn_mfma_f32_16x16x32_bf16(Bt[n][k], At[m][k], acc[ai][bj][m][n], 0, 0, 0); __builtin_amdgcn_s_setprio(0); } while (0)
#define PG8_WAIT_V(n) asm volatile("s_waitcnt vmcnt(" #n ")" ::: "memory")
#define PG8_WAIT_L(n) asm volatile("s_waitcnt lgkmcnt(" #n ")" ::: "memory")
#define PG8_BAR __builtin_amdgcn_s_barrier()
#define PG8_SCHED __builtin_amdgcn_sched_barrier(0)
    Unit cur;
    if (!S.next(0, cur)) return;
    f32x4 acc[2][2][4][2];
#pragma unroll
    for (int a = 0; a < 2; ++a)
#pragma unroll
        for (int b = 0; b < 2; ++b)
#pragma unroll
            for (int m = 0; m < 4; ++m)
#pragma unroll
                for (int n = 0; n < 2; ++n) acc[a][b][m][n] = (f32x4){0.f, 0.f, 0.f, 0.f};
    bf16x8 At[4][2], B0[2][2], B1[2][2];
    const char* cA = (const char*)g0.A + (size_t)cur.pm * 2 * hs0; const char* cB = (const char*)g0.Bt + (size_t)cur.pn * 2 * hs0;
    {   PG8_STAGE(PG8_SB(0, 0), cB, rB, k20); PG8_STAGE(PG8_SB(0, 1), cB + hs0, rB, k20); PG8_STAGE(PG8_SA(0, 0), cA, rA, k20); PG8_STAGE(PG8_SA(0, 1), cA + hs0, rA, k20);
        if (wr == 1) PG8_BAR;
        PG8_WAIT_V(2); PG8_BAR;
        PG8_STAGE(PG8_SB(1, 0), cB + kstep, rB, k20); PG8_STAGE(PG8_SA(1, 0), cA + kstep, rA, k20); PG8_STAGE(PG8_SB(1, 1), cB + hs0 + kstep, rB, k20);
        PG8_WAIT_V(6); PG8_BAR; }
#define PG8_KLOOP(ntc, hsc, k2c, nA, nB, hsn, k2n) \
        for (int t = 0; t < (ntc); t += 2) { \
            const bool last = (t == (ntc) - 2); \
            const char* a1 = cA + (size_t)(t + 1) * kstep; \
            const char* a2 = last ? (nA) : cA + (size_t)(t + 2) * kstep; const char* b2 = last ? (nB) : cB + (size_t)(t + 2) * kstep; \
            const char* a3 = a2 + kstep; const char* b3 = b2 + kstep; \
            const size_t hs2 = last ? (hsn) : (hsc); const unsigned k22 = last ? (k2n) : (k2c); \
            PG8_LDB(B0, 0, 0); PG8_LDB(B1, 0, 1); PG8_SCHED; PG8_LDA(At, 0, 0); PG8_STAGE(PG8_SA(1, 1), a1 + (hsc), rA, (k2c)); \
            PG8_WAIT_V(8); PG8_WAIT_L(0); PG8_BAR; PG8_MMA(0, 0, At, B0); PG8_MMA(0, 1, At, B1); PG8_BAR; PG8_SCHED; \
            PG8_LDA(At, 0, 1); PG8_STAGE(PG8_SB(0, 0), b2, rB, k22); PG8_STAGE(PG8_SB(0, 1), b2 + hs2, rB, k22); PG8_STAGE(PG8_SA(0, 0), a2, rA, k22); \
            PG8_WAIT_V(8); PG8_WAIT_L(0); PG8_BAR; PG8_MMA(1, 0, At, B0); PG8_MMA(1, 1, At, B1); PG8_BAR; PG8_SCHED; \
            PG8_LDB(B0, 1, 0); PG8_LDB(B1, 1, 1); PG8_SCHED; PG8_LDA(At, 1, 0); PG8_STAGE(PG8_SA(0, 1), a2 + hs2, rA, k22); \
            PG8_WAIT_V(8); PG8_WAIT_L(0); PG8_BAR; PG8_MMA(0, 0, At, B0); PG8_MMA(0, 1, At, B1); PG8_BAR; PG8_SCHED; \
            PG8_LDA(At, 1, 1); PG8_STAGE(PG8_SB(1, 0), b3, rB, k22); PG8_STAGE(PG8_SB(1, 1), b3 + hs2, rB, k22); PG8_STAGE(PG8_SA(1, 0), a3, rA, k22); \
            PG8_WAIT_V(8); PG8_WAIT_L(0); PG8_BAR; PG8_MMA(1, 0, At, B0); PG8_MMA(1, 1, At, B1); PG8_BAR; PG8_SCHED; \
        }
    const int nt0 = g0.K / BK, nt1 = g1.K / BK;
    {
        const char* pA1 = (const char*)g1.A + (size_t)cur.pm * 2 * hs1; const char* pB1 = (const char*)g1.Bt + (size_t)cur.pn * 2 * hs1;
        PG8_KLOOP(nt0, hs0, k20, pA1, pB1, hs1, k21)
        E.mid(acc, cur, wr, wc, fr, fq);
        cA = pA1; cB = pB1;
        PG8_KLOOP(nt1, hs1, k21, cA, cB, hs1, k21)
        E(acc, cur, wr, wc, fr, fq);
    }
#undef PG8_KLOOP
    PG8_WAIT_V(0);
    if (wr == 0) PG8_BAR;
    PG8_BAR;
#undef PG8_SA
#undef PG8_SB
#undef PG8_STAGE
#undef PG8_LDA
#undef PG8_LDB
#undef PG8_MMA
#undef PG8_WAIT_V
#undef PG8_WAIT_L
#undef PG8_BAR
#undef PG8_SCHED
}

template <int ACT> DI void epi_store8(bf16_t* dstp, f32x4 v0, f32x4 v1) {
    if (ACT == 1) {
#pragma unroll
        for (int e = 0; e < 4; ++e) { v0[e] = siluf_(v0[e]); v1[e] = siluf_(v1[e]); }
    } else if (ACT == 2) {
#pragma unroll
        for (int e = 0; e < 4; ++e) { v0[e] = sigmoidf_(v0[e]); v1[e] = sigmoidf_(v1[e]); }
    }
    u32x4 o; o[0] = pk_bf16(v0[0], v0[1]); o[1] = pk_bf16(v0[2], v0[3]); o[2] = pk_bf16(v1[0], v1[1]); o[3] = pk_bf16(v1[2], v1[3]);
    *(u32x4*)dstp = o;
}
template <int LD> struct EpiProj1 {
    static constexpr bool PERM = true, AFTER_DRAIN = false;
    bf16_t* dst;
    DI void operator()(const f32x4 (&acc)[2][2][4][2], const Unit& u, int wr, int wc, int fr, int fq) const {
        const int row0 = u.pm * BM + wr * 64 + fr, col0 = u.pn * BM + wc * 32 + 8 * fq;
#pragma unroll
        for (int ai = 0; ai < 2; ++ai)
#pragma unroll
            for (int m = 0; m < 4; ++m) { bf16_t* rowp = dst + (size_t)(row0 + ai * HALF + m * 16) * LD + col0;
#pragma unroll
                for (int bj = 0; bj < 2; ++bj) epi_store8<0>(rowp + bj * HALF, acc[ai][bj][m][0], acc[ai][bj][m][1]); }
    }
};
struct EpiProjC {
    static constexpr bool PERM = true, AFTER_DRAIN = false;
    unsigned char* ws; float* out;
    DI void operator()(const f32x4 (&acc)[2][2][4][2], const Unit& u, int wr, int wc, int fr, int fq) const {
        const int row0 = u.pm * BM + wr * 64 + fr, cw = wc * 32 + 8 * fq;
        if (u.pn < 4) { bf16_t* base = (bf16_t*)out + (size_t)MTOK * D + u.pn * BM + cw;
#pragma unroll
            for (int ai = 0; ai < 2; ++ai)
#pragma unroll
                for (int m = 0; m < 4; ++m)
#pragma unroll
                    for (int bj = 0; bj < 2; ++bj) epi_store8<1>(base + (size_t)(row0 + ai * HALF + m * 16) * 1024 + bj * HALF, acc[ai][bj][m][0], acc[ai][bj][m][1]);
        } else if (u.pn < 7) { bf16_t* base = (bf16_t*)(ws + WS_ZB) + (u.pn - 4) * BM + cw;
#pragma unroll
            for (int ai = 0; ai < 2; ++ai)
#pragma unroll
                for (int m = 0; m < 4; ++m)
#pragma unroll
                    for (int bj = 0; bj < 2; ++bj) epi_store8<1>(base + (size_t)(row0 + ai * HALF + m * 16) * 768 + bj * HALF, acc[ai][bj][m][0], acc[ai][bj][m][1]);
        } else { bf16_t* base = (bf16_t*)(ws + WS_R2) + (u.pn - 7) * BM + cw;
#pragma unroll
            for (int ai = 0; ai < 2; ++ai)
#pragma unroll
                for (int m = 0; m < 4; ++m)
#pragma unroll
                    for (int bj = 0; bj < 2; ++bj) epi_store8<2>(base + (size_t)(row0 + ai * HALF + m * 16) * 2048 + bj * HALF, acc[ai][bj][m][0], acc[ai][bj][m][1]);
        }
    }
};
struct EpiGate {
    static constexpr bool PERM = true, AFTER_DRAIN = false;
    bf16_t* T; const bf16_t* sg; int ldsg; int mode;
    DI void operator()(const f32x4 (&acc)[2][2][4][2], const Unit& u, int wr, int wc, int fr, int fq) const {
        const int row0 = u.pm * BM + wr * 64 + fr, col0 = u.pn * BM + wc * 32 + 8 * fq;
#pragma unroll
        for (int ai = 0; ai < 2; ++ai)
#pragma unroll
            for (int m = 0; m < 4; ++m) { const size_t row = (size_t)(row0 + ai * HALF + m * 16);
#pragma unroll
                for (int bj = 0; bj < 2; ++bj) { const f32x4 v0 = acc[ai][bj][m][0], v1 = acc[ai][bj][m][1];
                    const u32x4 s = *(const u32x4*)(sg + row * ldsg + col0 + bj * HALF);
                    float r[8] = { bflo(s[0]) * v0[0], bfhi(s[0]) * v0[1], bflo(s[1]) * v0[2], bfhi(s[1]) * v0[3], bflo(s[2]) * v1[0], bfhi(s[2]) * v1[1], bflo(s[3]) * v1[2], bfhi(s[3]) * v1[3] };
                    bf16_t* tp = T + row * D + col0 + bj * HALF;
                    if (mode == 1) { const u32x4 t = *(const u32x4*)tp;
                        r[0] += bflo(t[0]); r[1] += bfhi(t[0]); r[2] += bflo(t[1]); r[3] += bfhi(t[1]); r[4] += bflo(t[2]); r[5] += bfhi(t[2]); r[6] += bflo(t[3]); r[7] += bfhi(t[3]); }
                    u32x4 o; o[0] = pk_bf16(r[0], r[1]); o[1] = pk_bf16(r[2], r[3]); o[2] = pk_bf16(r[4], r[5]); o[3] = pk_bf16(r[6], r[7]);
                    *(u32x4*)tp = o; } }
    }
};
struct EpiMerge2 {
    static constexpr bool PERM = true, AFTER_DRAIN = false;
    bf16_t* out; const bf16_t* gt;
    DI void mid(f32x4 (&acc)[2][2][4][2], const Unit& u, int wr, int wc, int fr, int fq) const {
        int row0 = u.pm * BM + wr * 64 + fr, col0 = u.pn * BM + wc * 32 + 8 * fq;
        asm volatile("" : "+v"(row0), "+v"(col0));
#pragma unroll
        for (int ai = 0; ai < 2; ++ai)
#pragma unroll
            for (int m = 0; m < 4; ++m) { const bf16_t* gp = gt + (size_t)(row0 + ai * HALF + m * 16) * 2048 + col0;
#pragma unroll
                for (int bj = 0; bj < 2; ++bj) { const u32x4 sa = *(const u32x4*)(gp + bj * HALF), sb = *(const u32x4*)(gp + 1024 + bj * HALF);
#pragma unroll
                    for (int e = 0; e < 2; ++e) {
                        acc[ai][bj][m][0][2 * e]     *= bflo(sa[e]) * __builtin_amdgcn_rcpf(fmaxf(bflo(sb[e]), 1e-20f));
                        acc[ai][bj][m][0][2 * e + 1] *= bfhi(sa[e]) * __builtin_amdgcn_rcpf(fmaxf(bfhi(sb[e]), 1e-20f));
                        acc[ai][bj][m][1][2 * e]     *= bflo(sa[2 + e]) * __builtin_amdgcn_rcpf(fmaxf(bflo(sb[2 + e]), 1e-20f));
                        acc[ai][bj][m][1][2 * e + 1] *= bfhi(sa[2 + e]) * __builtin_amdgcn_rcpf(fmaxf(bfhi(sb[2 + e]), 1e-20f)); } }
                if (m & 1) __builtin_amdgcn_sched_barrier(0); }
    }
    DI void operator()(const f32x4 (&acc)[2][2][4][2], const Unit& u, int wr, int wc, int fr, int fq) const {
        int row0 = u.pm * BM + wr * 64 + fr, col0 = u.pn * BM + wc * 32 + 8 * fq;
        asm volatile("" : "+v"(row0), "+v"(col0));
#pragma unroll
        for (int ai = 0; ai < 2; ++ai)
#pragma unroll
            for (int m = 0; m < 4; ++m) { const size_t row = (size_t)(row0 + ai * HALF + m * 16);
#pragma unroll
                for (int bj = 0; bj < 2; ++bj) { const f32x4 v0 = acc[ai][bj][m][0], v1 = acc[ai][bj][m][1];
                    const u32x4 sb = *(const u32x4*)(gt + row * 2048 + 1024 + col0 + bj * HALF);
                    u32x4 o;
                    o[0] = pk_bf16(v0[0] * fmaxf(bflo(sb[0]), 1e-20f), v0[1] * fmaxf(bfhi(sb[0]), 1e-20f)); o[1] = pk_bf16(v0[2] * fmaxf(bflo(sb[1]), 1e-20f), v0[3] * fmaxf(bfhi(sb[1]), 1e-20f));
                    o[2] = pk_bf16(v1[0] * fmaxf(bflo(sb[2]), 1e-20f), v1[1] * fmaxf(bfhi(sb[2]), 1e-20f)); o[3] = pk_bf16(v1[2] * fmaxf(bflo(sb[3]), 1e-20f), v1[3] * fmaxf(bfhi(sb[3]), 1e-20f));
                    *(u32x4*)(out + row * D + col0 + bj * HALF) = o; } }
    }
};
struct EpiOutNorm {
    static constexpr bool PERM = false, AFTER_DRAIN = true;
    const float* x; const float* mod; const float* fnw; float* out; float* rs; unsigned* cnt;
    DI void operator()(const f32x4 (&)[2][2][4][2], const Unit&, int, int, int, int) const {}
    DI void fused(f32x4 (&acc)[2][2][4][2], const Unit& u, int wr, int wc, int fr, int fq, LAS unsigned char* lds) const {
        const int tid = threadIdx.x;
        const int row0 = u.pm * BM + wr * 64 + fr, col0 = u.pn * BM + wc * 32 + 4 * fq;
        const int b = (u.pm * BM) / SEQ;
        LAS float* part = (LAS float*)lds;
        LAS float* rstd_l = (LAS float*)(lds + 4096);
        f32x4 gv[2][2];
#pragma unroll
        for (int bj = 0; bj < 2; ++bj)
#pragma unroll
            for (int n = 0; n < 2; ++n) gv[bj][n] = *(const f32x4*)(mod + b * 3072 + 2048 + col0 + bj * HALF + n * 16);
#pragma unroll
        for (int ai = 0; ai < 2; ++ai)
#pragma unroll
            for (int m = 0; m < 4; ++m) { const size_t ro = (size_t)(row0 + ai * HALF + m * 16) * D + col0;
                float ss = 0.f;
#pragma unroll
                for (int bj = 0; bj < 2; ++bj)
#pragma unroll
                    for (int n = 0; n < 2; ++n) { const f32x4 xv = __builtin_nontemporal_load((const f32x4*)(x + ro + bj * HALF + n * 16));
                        const f32x4 v = xv + gv[bj][n] * acc[ai][bj][m][n]; acc[ai][bj][m][n] = v;
                        ss += v[0] * v[0] + v[1] * v[1] + v[2] * v[2] + v[3] * v[3]; }
                ss += __shfl_xor(ss, 16); ss += __shfl_xor(ss, 32);
                if (fq == 0) part[wc * 256 + ai * HALF + wr * 64 + m * 16 + fr] = ss; }
        __syncthreads();
        if (tid < 256) __hip_atomic_store(rs + (size_t)(u.pm * 4 + u.pn) * 256 + tid, part[tid] + part[256 + tid] + part[512 + tid] + part[768 + tid], __ATOMIC_RELAXED, __HIP_MEMORY_SCOPE_AGENT);
        asm volatile("s_waitcnt vmcnt(0)" ::: "memory");
        __syncthreads();
        if (tid == 0) {
            unsigned* c = cnt + u.pm * 16;
            __hip_atomic_fetch_add(c, 1u, __ATOMIC_RELAXED, __HIP_MEMORY_SCOPE_AGENT);
            unsigned sp = 0;
            while (__hip_atomic_load(c, __ATOMIC_RELAXED, __HIP_MEMORY_SCOPE_AGENT) < 4u) { __builtin_amdgcn_s_sleep(1); if (++sp > (1u << 24)) break; }
        }
        __syncthreads();
        if (tid < 256) { float* rp = rs + (size_t)(u.pm * 4) * 256 + tid;
            const float tot = __hip_atomic_load(rp, __ATOMIC_RELAXED, __HIP_MEMORY_SCOPE_AGENT) + __hip_atomic_load(rp + 256, __ATOMIC_RELAXED, __HIP_MEMORY_SCOPE_AGENT)
                            + __hip_atomic_load(rp + 512, __ATOMIC_RELAXED, __HIP_MEMORY_SCOPE_AGENT) + __hip_atomic_load(rp + 768, __ATOMIC_RELAXED, __HIP_MEMORY_SCOPE_AGENT);
            rstd_l[tid] = rsqrtf(tot * (1.f / 1024.f) + EPS); }
        __syncthreads();
        f32x4 wv[2][2];
#pragma unroll
        for (int bj = 0; bj < 2; ++bj)
#pragma unroll
            for (int n = 0; n < 2; ++n) wv[bj][n] = *(const f32x4*)(fnw + col0 + bj * HALF + n * 16);
#pragma unroll
        for (int ai = 0; ai < 2; ++ai)
#pragma unroll
            for (int m = 0; m < 4; ++m) { const size_t ro = (size_t)(row0 + ai * HALF + m * 16) * D + col0;
                const float r = rstd_l[ai * HALF + wr * 64 + m * 16 + fr];
#pragma unroll
                for (int bj = 0; bj < 2; ++bj)
#pragma unroll
                    for (int n = 0; n < 2; ++n) *(f32x4*)(out + ro + bj * HALF + n * 16) = acc[ai][bj][m][n] * r * wv[bj][n]; }
    }
};
}

DI int map_n_in(int np) {
    if (np < 3072) return np;
    if (np < 5376) return 4112 + (np - 3072);
    if (np < 6400) return 3072 + (np - 5376);
    if (np < 7168) return 6416 + (np - 6400);
    return 7184 + (np - 7168);
}
struct TileDesc { const float* src; bf16_t* dst; int ld, col0, K, n0, k0; };
DI TileDesc tile_desc(const Params& p, int t) {
    TileDesc d; unsigned char* ws = p.ws;
    if (t < 2304) { const int tn = t >> 4, tk = t & 15; d.src = p.w_in; d.ld = N_IN; d.col0 = map_n_in(tn * 64); d.dst = (bf16_t*)(ws + WS_WT_IN); d.K = 1024; d.n0 = tn * 64; d.k0 = tk * 64; }
    else if (t < 2560) { const int u = t - 2304, tn = u >> 4, tk = u & 15; d.src = p.w_pa; d.ld = 1024; d.col0 = tn * 64; d.dst = (bf16_t*)(ws + WS_WT_PA); d.K = 1024; d.n0 = tn * 64; d.k0 = tk * 64; }
    else if (t < 2752) { const int u = t - 2560, tn = u / 12, tk = u % 12; d.src = p.w_pb; d.ld = 1024; d.col0 = tn * 64; d.dst = (bf16_t*)(ws + WS_WT_PB); d.K = 768; d.n0 = tn * 64; d.k0 = tk * 64; }
    else { const int u = t - 2752, tn = u >> 4, tk = u & 15; d.src = p.w_out; d.ld = 1024; d.col0 = tn * 64; d.dst = (bf16_t*)(ws + WS_WT_O); d.K = 1024; d.n0 = tn * 64; d.k0 = tk * 64; }
    return d;
}
DI void tile_load(float (&v)[8], const TileDesc& d, int tid) {
#pragma unroll
    for (int i = 0; i < 8; ++i) { const int r = (tid >> 6) + 8 * i, c = tid & 63; v[i] = __builtin_nontemporal_load(d.src + (size_t)(d.k0 + r) * d.ld + d.col0 + c); }
}
DI void phase0(const Params& p, LAS unsigned char* lds) {
    int tid = threadIdx.x; asm volatile("" : "+v"(tid));
    const int nb = gridDim.x;
    unsigned char* ws = p.ws;
    {
        const int task = nb - 1 - (int)blockIdx.x;
        if (task < 192) {
            LAS float* sc = (LAS float*)lds;
            LAS float* red = (LAS float*)(lds + 8192);
            const int cg = task % 48, ks = task / 48, k0 = ks * 256;
            for (int i = tid; i < 2048; i += 512) sc[i] = siluf_(p.c[(i >> 8) * 1024 + k0 + (i & 255)]);
            __syncthreads();
            const int col = cg * 64 + (tid & 63), kq = tid >> 6;
            float a[8] = {0.f, 0.f, 0.f, 0.f, 0.f, 0.f, 0.f, 0.f};
            const float* wp = p.ada_w + (size_t)(k0 + kq * 32) * 3072 + col;
#pragma unroll
            for (int kk = 0; kk < 32; kk += 8) {
                float w[8];
#pragma unroll
                for (int u = 0; u < 8; ++u) w[u] = __builtin_nontemporal_load(wp + (size_t)(kk + u) * 3072);
#pragma unroll
                for (int u = 0; u < 8; ++u)
#pragma unroll
                    for (int b = 0; b < 8; ++b) a[b] += sc[b * 256 + kq * 32 + kk + u] * w[u];
            }
#pragma unroll
            for (int b = 0; b < 8; ++b) red[(kq * 8 + b) * 64 + (tid & 63)] = a[b];
            __syncthreads();
            { const int b = tid >> 6, cl = tid & 63; float s = 0.f;
#pragma unroll
                for (int q = 0; q < 8; ++q) s += red[(q * 8 + b) * 64 + cl];
                __hip_atomic_store((float*)(ws + WS_MODP) + (size_t)(ks * 8 + b) * 3072 + cg * 64 + cl, s, __ATOMIC_RELAXED, __HIP_MEMORY_SCOPE_AGENT); }
            asm volatile("s_waitcnt vmcnt(0)" ::: "memory");
            __syncthreads();
            if (tid == 0)
                __hip_atomic_fetch_add((unsigned*)(ws + WS_BAR + 28672), 1u, __ATOMIC_RELAXED, __HIP_MEMORY_SCOPE_AGENT);
        }
    }
    LAS float* tile = (LAS float*)lds;
    int t = blockIdx.x;
    if (t < 3008) {
        TileDesc d = tile_desc(p, t);
        float v[8];
        tile_load(v, d, tid);
        for (;;) {
#pragma unroll
            for (int i = 0; i < 8; ++i) { const int r = (tid >> 6) + 8 * i, c = tid & 63; tile[r * 65 + c] = v[i]; }
            __syncthreads();
            const int tn = t + nb;
            TileDesc dn = d;
            if (tn < 3008) { dn = tile_desc(p, tn); tile_load(v, dn, tid); }
#pragma unroll
            for (int i = 0; i < 4; ++i) { const int rr = (tid >> 5) + 16 * i, cc = (tid & 31) * 2;
                *(unsigned*)(d.dst + (size_t)(d.n0 + rr) * d.K + d.k0 + cc) = pk_bf16(tile[cc * 65 + rr], tile[(cc + 1) * 65 + rr]); }
            __syncthreads();
            if (tn >= 3008) break;
            t = tn; d = dn;
        }
    }
}

DI void phase1(const Params& p, LAS unsigned char* lds) {
    LAS float* wT = (LAS float*)lds;
    LAS float* lmod = (LAS float*)(lds + 65536);
    int tid = threadIdx.x; asm volatile("" : "+v"(tid));
    const int lane = tid & 63, wave = tid >> 6;
    for (int i = tid; i < 16384; i += 512) { const int k = i >> 4, j = i & 15; wT[j * 1024 + k] = p.w_in[(size_t)k * N_IN + 4096 + j]; }
    float* mod = (float*)(p.ws + WS_MOD);
    const float* modp = (const float*)(p.ws + WS_MODP);
    bf16_t* H = (bf16_t*)(p.ws + WS_H);
    float* BETA = (float*)(p.ws + WS_BETA); float* GG = (float*)(p.ws + WS_G);
    if (tid == 0) {
        unsigned* c = (unsigned*)(p.ws + WS_BAR + 28672); unsigned sp = 0;
        while (__hip_atomic_load(c, __ATOMIC_RELAXED, __HIP_MEMORY_SCOPE_AGENT) < 192u) { __builtin_amdgcn_s_sleep(2); if (++sp > (1u << 24)) break; }
    }
    for (int rb = blockIdx.x; rb < MTOK / 64; rb += gridDim.x) {
        const int b = rb >> 5;
        __syncthreads();
        for (int i = tid; i < 3072; i += 512) {
            float v = p.ada_b[i];
#pragma unroll
            for (int ks = 0; ks < 4; ++ks) v += __hip_atomic_load((float*)modp + (size_t)(ks * 8 + b) * 3072 + i, __ATOMIC_RELAXED, __HIP_MEMORY_SCOPE_AGENT);
            if (i < 2048) lmod[i] = v;
            if ((rb & 31) == 0) mod[b * 3072 + i] = v;
        }
        __syncthreads();
        const float ea = expf(p.a_log[lane & 7]), dtb = p.dt_bias[lane & 7];
        for (int j = 0; j < 8; j += 4) {
            const int row = rb * 64 + wave * 8 + j;
            f32x4 xv[4][4]; float ss[4] = {0.f, 0.f, 0.f, 0.f};
#pragma unroll
            for (int r = 0; r < 4; ++r)
#pragma unroll
                for (int i = 0; i < 4; ++i) { xv[r][i] = __builtin_nontemporal_load((const f32x4*)(p.x + (size_t)(row + r) * D + i * 256 + lane * 4));
                    ss[r] += xv[r][i][0] * xv[r][i][0] + xv[r][i][1] * xv[r][i][1] + xv[r][i][2] * xv[r][i][2] + xv[r][i][3] * xv[r][i][3]; }
#pragma unroll
            for (int r = 0; r < 4; ++r) {
                const float rstd = rsqrtf(wave_sum(ss[r]) * (1.f / 1024.f) + EPS);
#pragma unroll
                for (int i = 0; i < 4; ++i) { const int k = i * 256 + lane * 4;
                    const f32x4 nw = *(const f32x4*)(p.norm_w + k), sh = *(const LAS f32x4*)(lmod + k), scl = *(const LAS f32x4*)(lmod + 1024 + k);
#pragma unroll
                    for (int e = 0; e < 4; ++e) xv[r][i][e] = xv[r][i][e] * rstd * nw[e] * (1.f + scl[e]) + sh[e];
                    u32x2 o; o[0] = pk_bf16(xv[r][i][0], xv[r][i][1]); o[1] = pk_bf16(xv[r][i][2], xv[r][i][3]);
                    *(u32x2*)(H + (size_t)(row + r) * D + k) = o; }
            }
            float myv[4] = {0.f, 0.f, 0.f, 0.f};
#pragma unroll 2
            for (int jj = 0; jj < 16; ++jj) { float a[4] = {0.f, 0.f, 0.f, 0.f};
#pragma unroll
                for (int i = 0; i < 4; ++i) { const f32x4 w = *(const LAS f32x4*)(wT + jj * 1024 + i * 256 + lane * 4);
#pragma unroll
                    for (int r = 0; r < 4; ++r) a[r] += xv[r][i][0] * w[0] + xv[r][i][1] * w[1] + xv[r][i][2] * w[2] + xv[r][i][3] * w[3]; }
#pragma unroll
                for (int r = 0; r < 4; ++r) { const float s = wave_sum(a[r]); if (lane == jj) myv[r] = s; } }
#pragma unroll
            for (int r = 0; r < 4; ++r) {
                if (lane < 8) BETA[(size_t)(row + r) * 8 + lane] = sigmoidf_(myv[r]);
                else if (lane < 16) { const float z = myv[r] + dtb; const float sp = z > 20.f ? z : log1pf(expf(z));
                    GG[(size_t)(row + r) * 8 + (lane - 8)] = -ea * sp; } }
        }
    }
}

constexpr int CP_SLOT_B = 8448;
constexpr int CP_BUF0 = 8 * CP_SLOT_B;
constexpr int CP_BUF_B = 17408 * 2 + 512;
constexpr int CP_LDS_TOTAL = CP_BUF0 + 2 * CP_BUF_B;
DI int permpos4(int t) { return 32 * (t >> 1) + 4 * (t & 1); }
DI int lrow_off(int a, int bq) { return bq == 0 ? (8 * a * a + 4 * a) : (8 * a * a + 8 * a + 4 * (bq - 1) * (a + 1)); }
struct CpRaw { unsigned q[11], k[11], v[11]; float g, beta; };
DI void cp_load_raw(CpRaw& R, const Params& p, int item, int wave, int lane) {
    const int bh = item >> 5, n = item & 31, b = bh >> 3, h = bh & 7, tl0 = wave * 8;
    const bf16_t* PA = (const bf16_t*)(p.ws + WS_R1);
#pragma unroll
    for (int r = 0; r < 11; ++r) { const int tb = n * 64 + tl0 - 3 + r;
        if (tb >= 0) { const bf16_t* rp = PA + (size_t)(b * SEQ + tb) * 3072 + h * 128 + 2 * lane;
            R.q[r] = __builtin_nontemporal_load((const unsigned*)rp); R.k[r] = __builtin_nontemporal_load((const unsigned*)(rp + 1024)); R.v[r] = __builtin_nontemporal_load((const unsigned*)(rp + 2048)); }
        else { R.q[r] = 0u; R.k[r] = 0u; R.v[r] = 0u; } }
    const size_t grow = (size_t)(b * SEQ + n * 64 + lane) * 8 + h;
    R.g = ((const float*)(p.ws + WS_G))[grow]; R.beta = ((const float*)(p.ws + WS_BETA))[grow];
}
DI void cp_conv(const unsigned (&raw)[11], const float* cw, float (&y0)[8], float (&y1)[8]) {
    float w0[4], w1[4];
#pragma unroll
    for (int j = 0; j < 4; ++j) { const f32x2 w = *(const f32x2*)(cw + j * 3072); w0[j] = w[0]; w1[j] = w[1]; }
#pragma unroll
    for (int e = 0; e < 8; ++e) { float a0 = 0.f, a1 = 0.f;
#pragma unroll
        for (int j = 0; j < 4; ++j) { a0 += w0[j] * bflo(raw[e + j]); a1 += w1[j] * bfhi(raw[e + j]); }
        y0[e] = siluf_(a0); y1[e] = siluf_(a1); }
}
DI void cp_stage_a1(const CpRaw& R, const Params& p, LAS unsigned char* lds, int item, int buf, int wave, int lane) {
    const int bh = item >> 5, h = bh & 7, tl0 = wave * 8;
    LAS bf16_t* qs = (LAS bf16_t*)(lds + CP_BUF0 + buf * CP_BUF_B); LAS bf16_t* ks = qs + 64 * 136;
    LAS float* gcs = (LAS float*)(lds + CP_BUF0 + buf * CP_BUF_B + 34816); LAS float* betas = gcs + 64;
    bf16_t* UT = (bf16_t*)p.out + (size_t)item * 8192;
    bf16_t* Wg = (bf16_t*)p.out + (size_t)MTOK * D + (size_t)item * 8192;
    bf16_t* QD = (bf16_t*)(p.ws + WS_QD) + (size_t)item * 8192;
    bf16_t* KDT = (bf16_t*)(p.ws + WS_KDT) + (size_t)item * 8192;
    float v = R.g;
#pragma unroll
    for (int o = 1; o < 64; o <<= 1) { const float u = __shfl_up(v, o); if (lane >= o) v += u; }
    const float gcl = __shfl(v, 63);
    float egc[8], bet[8], ekd[8];
#pragma unroll
    for (int e = 0; e < 8; ++e) { const float gce = __shfl(v, tl0 + e); egc[e] = __expf(gce); ekd[e] = __expf(gcl - gce); bet[e] = __shfl(R.beta, tl0 + e); }
    if (wave == 0) { gcs[lane] = v; betas[lane] = R.beta; if (lane == 63) ((float*)(p.ws + WS_GL))[item] = __expf(v); }
    float y0[8], y1[8];
    {
        cp_conv(R.q, p.conv_w + h * 128 + 2 * lane, y0, y1);
        { float pp[8], tt[8];
#pragma unroll
          for (int e = 0; e < 8; ++e) pp[e] = y0[e] * y0[e] + y1[e] * y1[e];
          reduce8(pp, tt, lane);
#pragma unroll
          for (int e = 0; e < 8; ++e) { const float ri = rsqrtf(tt[e] + EPS); y0[e] *= ri; y1[e] *= ri; } }
        const int dk = 2 * lane, loc = dk & 31, pp = 32 * (dk >> 5) + 8 * ((loc >> 2) & 3) + 4 * (loc >> 4) + (loc & 3);
#pragma unroll
        for (int e = 0; e < 8; ++e) { *(LAS unsigned*)(qs + (tl0 + e) * 136 + 2 * lane) = pk_bf16(y0[e], y1[e]);
            const float s = 0.08838834764831845f * egc[e];
            *(unsigned*)(QD + (tl0 + e) * 128 + pp) = pk_bf16(y0[e] * s, y1[e] * s); }
    }
    {
        cp_conv(R.k, p.conv_w + 1024 + h * 128 + 2 * lane, y0, y1);
        { float pp[8], tt[8];
#pragma unroll
          for (int e = 0; e < 8; ++e) pp[e] = y0[e] * y0[e] + y1[e] * y1[e];
          reduce8(pp, tt, lane);
#pragma unroll
          for (int e = 0; e < 8; ++e) { const float ri = rsqrtf(tt[e] + EPS); y0[e] *= ri; y1[e] *= ri; } }
#pragma unroll
        for (int e = 0; e < 8; ++e) *(LAS unsigned*)(ks + (tl0 + e) * 136 + 2 * lane) = pk_bf16(y0[e], y1[e]);
        float be[8];
#pragma unroll
        for (int e = 0; e < 8; ++e) be[e] = bet[e] * egc[e];
        u32x4 a, c;
        a[0] = pk_bf16(y0[0] * be[0], y0[1] * be[1]); a[1] = pk_bf16(y0[2] * be[2], y0[3] * be[3]); a[2] = pk_bf16(y0[4] * be[4], y0[5] * be[5]); a[3] = pk_bf16(y0[6] * be[6], y0[7] * be[7]);
        c[0] = pk_bf16(y1[0] * be[0], y1[1] * be[1]); c[1] = pk_bf16(y1[2] * be[2], y1[3] * be[3]); c[2] = pk_bf16(y1[4] * be[4], y1[5] * be[5]); c[3] = pk_bf16(y1[6] * be[6], y1[7] * be[7]);
        *(u32x4*)(Wg + (size_t)(wave * 128 + 2 * lane) * 8) = a; *(u32x4*)(Wg + (size_t)(wave * 128 + 2 * lane + 1) * 8) = c;
        u32x4 ka, kc;
        ka[0] = pk_bf16(y0[0] * ekd[0], y0[1] * ekd[1]); ka[1] = pk_bf16(y0[2] * ekd[2], y0[3] * ekd[3]); ka[2] = pk_bf16(y0[4] * ekd[4], y0[5] * ekd[5]); ka[3] = pk_bf16(y0[6] * ekd[6], y0[7] * ekd[7]);
        kc[0] = pk_bf16(y1[0] * ekd[0], y1[1] * ekd[1]); kc[1] = pk_bf16(y1[2] * ekd[2], y1[3] * ekd[3]); kc[2] = pk_bf16(y1[4] * ekd[4], y1[5] * ekd[5]); kc[3] = pk_bf16(y1[6] * ekd[6], y1[7] * ekd[7]);
        *(u32x4*)(KDT + (size_t)(wave * 128 + 2 * lane) * 8) = ka; *(u32x4*)(KDT + (size_t)(wave * 128 + 2 * lane + 1) * 8) = kc;
    }
    {
        cp_conv(R.v, p.conv_w + 2048 + h * 128 + 2 * lane, y0, y1);
        u32x4 a, c;
        a[0] = pk_bf16(y0[0] * bet[0], y0[1] * bet[1]); a[1] = pk_bf16(y0[2] * bet[2], y0[3] * bet[3]); a[2] = pk_bf16(y0[4] * bet[4], y0[5] * bet[5]); a[3] = pk_bf16(y0[6] * bet[6], y0[7] * bet[7]);
        c[0] = pk_bf16(y1[0] * bet[0], y1[1] * bet[1]); c[1] = pk_bf16(y1[2] * bet[2], y1[3] * bet[3]); c[2] = pk_bf16(y1[4] * bet[4], y1[5] * bet[5]); c[3] = pk_bf16(y1[6] * bet[6], y1[7] * bet[7]);
        *(u32x4*)(UT + (size_t)(wave * 128 + 2 * lane) * 8) = a; *(u32x4*)(UT + (size_t)(wave * 128 + 2 * lane + 1) * 8) = c;
    }
}
DI void cp_stage_a2(const Params& p, LAS unsigned char* lds, int item, int buf, int slot, int wave, int lane) {
    const int fr = lane & 15, fq = lane >> 4;
    LAS bf16_t* qs = (LAS bf16_t*)(lds + CP_BUF0 + buf * CP_BUF_B); LAS bf16_t* ks = qs + 64 * 136;
    LAS float* gcs = (LAS float*)(lds + CP_BUF0 + buf * CP_BUF_B + 34816); LAS float* betas = gcs + 64;
    LAS float* Lp = (LAS float*)(lds + slot * CP_SLOT_B);
    bf16_t* AG = (bf16_t*)(p.ws + WS_AG) + (size_t)item * 4096;
    if (wave < 4) {
#pragma unroll
        for (int tn = 0; tn < 4; ++tn) {
            f32x4 acc = {0.f, 0.f, 0.f, 0.f};
#pragma unroll
            for (int s = 0; s < 4; ++s) {
                const bf16x8 a = *(const LAS bf16x8*)(ks + (16 * wave + fr) * 136 + 32 * s + 8 * fq);
                const bf16x8 bb = *(const LAS bf16x8*)(ks + (16 * tn + fr) * 136 + 32 * s + 8 * fq);
                acc = MFMA16(a, bb, acc);
            }
            const int j = 16 * tn + fr; const float gj = gcs[j]; const int arow = 4 * wave + fq;
#pragma unroll
            for (int r = 0; r < 4; ++r) { const int i = 16 * wave + 4 * fq + r;
                if (i > j) Lp[lrow_off(arow, r) + j] = betas[i] * acc[r] * __expf(gcs[i] - gj); }
        }
    } else {
        const int s2 = (wave - 4) >> 1;
#pragma unroll
        for (int ti = 0; ti < 2; ++ti) {
            const int tn = 2 * ((wave - 4) & 1) + ti;
            const int i = 16 * tn + fr; const float gi = gcs[i];
            float v[8];
#pragma unroll
            for (int hh = 0; hh < 2; ++hh) {
                const int tm = 2 * s2 + hh;
                f32x4 acc = {0.f, 0.f, 0.f, 0.f};
#pragma unroll
                for (int s = 0; s < 4; ++s) {
                    const bf16x8 a = *(const LAS bf16x8*)(ks + (16 * tm + fr) * 136 + 32 * s + 8 * fq);
                    const bf16x8 bb = *(const LAS bf16x8*)(qs + (16 * tn + fr) * 136 + 32 * s + 8 * fq);
                    acc = MFMA16(a, bb, acc);
                }
#pragma unroll
                for (int r = 0; r < 4; ++r) { const int j = 16 * tm + 4 * fq + r;
                    v[4 * hh + r] = (i >= j) ? 0.08838834764831845f * acc[r] * __expf(gi - gcs[j]) : 0.f; }
            }
            u32x4 o; o[0] = pk_bf16(v[0], v[1]); o[1] = pk_bf16(v[2], v[3]); o[2] = pk_bf16(v[4], v[5]); o[3] = pk_bf16(v[6], v[7]);
            *(u32x4*)(AG + (size_t)((tn * 2 + s2) * 64 + lane) * 8) = o;
        }
    }
}
DI void cp_solve(LAS unsigned char* lds, int slot, int lane) {
    unsigned zero_v; asm volatile("v_mov_b32 %0, 0" : "=v"(zero_v));
    LAS float* Lp = (LAS float*)(lds + slot * CP_SLOT_B) + zero_v;
    float t[64];
#pragma unroll
    for (int i = 0; i < 64; ++i) t[i] = 0.f;
#pragma unroll
    for (int i = 0; i < 64; ++i) {
        LAS float* lp = Lp;
        if (i >= 2) asm volatile("" : "+v"(lp) : "v"(t[i - 2]));
        const int ro = (i & 3) == 0 ? (8 * (i >> 2) * (i >> 2) + 4 * (i >> 2)) : (8 * (i >> 2) * (i >> 2) + 8 * (i >> 2) + 4 * ((i & 3) - 1) * ((i >> 2) + 1));
        float s0 = (lane == i) ? 1.f : 0.f, s1 = 0.f;
#pragma unroll
        for (int j4 = 0; j4 < (i + 3) / 4; ++j4) {
            const f32x4 l = *(const LAS f32x4*)(lp + ro + j4 * 4);
            if (4 * j4 + 0 < i) s0 -= l[0] * t[4 * j4 + 0];
            if (4 * j4 + 1 < i) s1 -= l[1] * t[4 * j4 + 1];
            if (4 * j4 + 2 < i) s0 -= l[2] * t[4 * j4 + 2];
            if (4 * j4 + 3 < i) s1 -= l[3] * t[4 * j4 + 3];
        }
        t[i] = s0 + s1;
    }
    LAS unsigned char* Tb = lds + slot * CP_SLOT_B + zero_v;
#pragma unroll
    for (int i = 0; i < 64; ++i) *(LAS bf16_t*)(Tb + i * 128 + ((((lane >> 3) ^ ((i >> 1) & 7))) * 16) + (lane & 7) * 2) = f2bf(t[i]);
}
DI void chunk_prep_batch(const Params& p, LAS unsigned char* lds, int first, int stride, int cnt) {
    int tid = threadIdx.x; asm volatile("" : "+v"(tid));
    const int lane = tid & 63, wave = __builtin_amdgcn_readfirstlane(tid >> 6), fr = lane & 15, fq = lane >> 4;
    CpRaw R;
    cp_load_raw(R, p, first, wave, lane);
    for (int k = 0; k < cnt; ++k) {
        const int item = first + k * stride;
        cp_stage_a1(R, p, lds, item, k & 1, wave, lane);
        __syncthreads();
        if (k + 1 < cnt) cp_load_raw(R, p, item + stride, wave, lane);
        cp_stage_a2(p, lds, item, k & 1, k, wave, lane);
    }
    __syncthreads();
    if (wave < cnt) cp_solve(lds, wave, lane);
    __syncthreads();
    const int offK0 = fr * 128 + (((0 + fq) ^ (fr >> 1)) * 16), offK1 = fr * 128 + (((4 + fq) ^ (fr >> 1)) * 16);
    const int ws2 = wave >> 1, wt0 = 2 * (wave & 1);
    for (int half = 0; half < 2; ++half) {
        bf16x8 vbA[4][2], kbA[4][4];
#pragma unroll
        for (int kk = 0; kk < 4; ++kk) {
            const int k = half * 4 + kk;
            if (k < cnt) { const int item = first + k * stride;
                const bf16_t* UT = (const bf16_t*)p.out + (size_t)item * 8192; const bf16_t* Wg = (const bf16_t*)p.out + (size_t)MTOK * D + (size_t)item * 8192;
                vbA[kk][0] = *(const bf16x8*)(UT + (size_t)(fq * 128 + 16 * wave + fr) * 8); vbA[kk][1] = *(const bf16x8*)(UT + (size_t)((4 + fq) * 128 + 16 * wave + fr) * 8);
#pragma unroll
                for (int hh = 0; hh < 2; ++hh) { kbA[kk][2 * hh] = *(const bf16x8*)(Wg + (size_t)(fq * 128 + 16 * (2 * ws2 + hh) + fr) * 8); kbA[kk][2 * hh + 1] = *(const bf16x8*)(Wg + (size_t)((4 + fq) * 128 + 16 * (2 * ws2 + hh) + fr) * 8); } }
            else { vbA[kk][0] = vbA[kk][1] = kbA[kk][0] = kbA[kk][1] = kbA[kk][2] = kbA[kk][3] = (bf16x8){0, 0, 0, 0, 0, 0, 0, 0}; }
        }
        asm volatile("s_waitcnt vmcnt(0)" ::: "memory");
        __syncthreads();
#pragma unroll
        for (int kk = 0; kk < 4; ++kk) {
            const int k = half * 4 + kk;
            if (k >= cnt) break;
            const int item = first + k * stride;
            bf16_t* UT = (bf16_t*)p.out + (size_t)item * 8192; bf16_t* Wg = (bf16_t*)p.out + (size_t)MTOK * D + (size_t)item * 8192;
            LAS unsigned char* Tb = lds + k * CP_SLOT_B;
#pragma unroll
            for (int t4 = 0; t4 < 4; ++t4) {
                const bf16x8 t0 = *(const LAS bf16x8*)(Tb + t4 * 2048 + offK0), t1 = *(const LAS bf16x8*)(Tb + t4 * 2048 + offK1);
                f32x4 acc = {0.f, 0.f, 0.f, 0.f};
                acc = MFMA16(t0, vbA[kk][0], acc); acc = MFMA16(t1, vbA[kk][1], acc);
                u32x2 o; o[0] = pk_bf16(acc[0], acc[1]); o[1] = pk_bf16(acc[2], acc[3]);
                *(u32x2*)(UT + (size_t)((wave * 4 + t4) * 64 + lane) * 4) = o; }
#pragma unroll
            for (int ti = 0; ti < 2; ++ti) {
                const int tn = wt0 + ti;
                const bf16x8 t0 = *(const LAS bf16x8*)(Tb + tn * 2048 + offK0), t1 = *(const LAS bf16x8*)(Tb + tn * 2048 + offK1);
                f32x4 a0 = {0.f, 0.f, 0.f, 0.f}, a1 = {0.f, 0.f, 0.f, 0.f};
                a0 = MFMA16(kbA[kk][0], t0, a0); a0 = MFMA16(kbA[kk][1], t1, a0);
                a1 = MFMA16(kbA[kk][2], t0, a1); a1 = MFMA16(kbA[kk][3], t1, a1);
                u32x4 o; o[0] = pk_bf16(a0[0], a0[1]); o[1] = pk_bf16(a0[2], a0[3]); o[2] = pk_bf16(a1[0], a1[1]); o[3] = pk_bf16(a1[2], a1[3]);
                *(u32x4*)(Wg + (size_t)((tn * 4 + ws2) * 64 + lane) * 8) = o; }
        }
    }
    asm volatile("s_waitcnt vmcnt(0)" ::: "memory");
    __syncthreads();
}

constexpr int SC_W = 0, SC_QD = 16384, SC_KDT = 32768, SC_A = 49152, SC_BUF = 57344;
DI void scan_stage(LAS unsigned char* lds, int buf, const Params& p, int item, int wave, int lane) {
    const unsigned char* Wp = (const unsigned char*)((const bf16_t*)p.out + (size_t)MTOK * D + (size_t)item * 8192);
    const unsigned char* QDp = (const unsigned char*)((const bf16_t*)(p.ws + WS_QD) + (size_t)item * 8192);
    const unsigned char* KDTp = (const unsigned char*)((const bf16_t*)(p.ws + WS_KDT) + (size_t)item * 8192);
    const unsigned char* Ap = (const unsigned char*)((const bf16_t*)(p.ws + WS_AG) + (size_t)item * 4096);
    const int r4 = lane >> 4, c4 = lane & 15, r8 = lane >> 3, c8 = lane & 7;
#pragma unroll
    for (int k = 0; k < 7; ++k) {
        const int i = wave + 8 * k;
        const unsigned char* g; int loff;
        if (i < 16) { g = Wp + i * 1024 + lane * 16; loff = SC_W + i * 1024; }
        else if (i < 32) { const int ii = i & 15, r = 4 * ii + r4, c = c4 ^ (r & 15);
            g = QDp + r * 256 + c * 16; loff = SC_QD + ii * 1024; }
        else if (i < 48) { const int ii = i - 32; g = KDTp + ii * 1024 + lane * 16; loff = SC_KDT + ii * 1024; }
        else { const int ii = i - 48; g = Ap + ii * 1024 + lane * 16; loff = SC_A + ii * 1024; }
        __builtin_amdgcn_global_load_lds((const unsigned*)g, (LAS unsigned*)(lds + buf * SC_BUF + loff), 16, 0, 0);
    }
}
DI void dn_scan(const Params& p, LAS unsigned char* lds, int bh) {
    int tid = threadIdx.x; asm volatile("" : "+v"(tid));
    const int lane = tid & 63, wave = __builtin_amdgcn_readfirstlane(tid >> 6), fr = lane & 15, fq = lane >> 4;
    unsigned char* ws = p.ws;
    f32x4 S[8];
#pragma unroll
    for (int t = 0; t < 8; ++t) S[t] = (f32x4){0.f, 0.f, 0.f, 0.f};
    const float glv = ((const float*)(ws + WS_GL))[bh * 32 + (lane & 31)];
    int offW[4], offK[2];
#pragma unroll
    for (int s = 0; s < 4; ++s) offW[s] = fr * 256 + (((4 * s + fq) ^ fr) * 16);
#pragma unroll
    for (int s = 0; s < 2; ++s) offK[s] = fr * 128 + (((4 * s + fq) ^ (fr >> 1)) * 16);
    bf16_t* UT0 = (bf16_t*)p.out + (size_t)(bh * 32) * 8192 + (size_t)(wave * 4 * 64 + lane) * 4;
    scan_stage(lds, 0, p, bh * 32, wave, lane);
    u32x2 ucur[4];
#pragma unroll
    for (int tm = 0; tm < 4; ++tm) ucur[tm] = *(const u32x2*)(UT0 + 256 * tm);
    for (int n = 0; n < 32; ++n) {
        const int item = bh * 32 + n, buf = n & 1;
        asm volatile("s_waitcnt vmcnt(0)" ::: "memory");
        __syncthreads();
        u32x2 unext[4];
        if (n + 1 < 32) {
            scan_stage(lds, buf ^ 1, p, item + 1, wave, lane);
#pragma unroll
            for (int tm = 0; tm < 4; ++tm) unext[tm] = *(const u32x2*)(UT0 + (size_t)(n + 1) * 8192 + 256 * tm);
        } else {
#pragma unroll
            for (int tm = 0; tm < 4; ++tm) unext[tm] = (u32x2){0u, 0u};
        }
        const float gl = __builtin_bit_cast(float, __builtin_amdgcn_readlane(__builtin_bit_cast(int, glv), n));
        LAS unsigned char* B = lds + buf * SC_BUF;
        bf16_t* UTp = UT0 + (size_t)n * 8192;
        bf16x8 Sf[4];
#pragma unroll
        for (int s = 0; s < 4; ++s) Sf[s] = pack8(S[2 * s], S[2 * s + 1]);
        f32x4 vn[4];
#pragma unroll
        for (int tm = 0; tm < 4; ++tm) {
            f32x4 acc = {0.f, 0.f, 0.f, 0.f};
#pragma unroll
            for (int s = 0; s < 4; ++s) { const bf16x8 a = *(const LAS bf16x8*)(B + SC_W + (tm * 4 + s) * 1024 + lane * 16); acc = MFMA16(a, Sf[s], acc); }
            const u32x2 u = ucur[tm];
            vn[tm][0] = bflo(u[0]) - acc[0]; vn[tm][1] = bfhi(u[0]) - acc[1]; vn[tm][2] = bflo(u[1]) - acc[2]; vn[tm][3] = bfhi(u[1]) - acc[3];
        }
        bf16x8 Vf[2];
        Vf[0] = pack8(vn[0], vn[1]); Vf[1] = pack8(vn[2], vn[3]);
#pragma unroll
        for (int tm = 0; tm < 4; ++tm) {
            f32x4 acc = {0.f, 0.f, 0.f, 0.f};
#pragma unroll
            for (int s = 0; s < 4; ++s) { const bf16x8 a = *(const LAS bf16x8*)(B + SC_QD + tm * 4096 + offW[s]); acc = MFMA16(a, Sf[s], acc); }
#pragma unroll
            for (int s = 0; s < 2; ++s) { const bf16x8 a = *(const LAS bf16x8*)(B + SC_A + (tm * 2 + s) * 1024 + lane * 16); acc = MFMA16(a, Vf[s], acc); }
            u32x2 o; o[0] = pk_bf16(acc[0], acc[1]); o[1] = pk_bf16(acc[2], acc[3]);
            *(u32x2*)(UTp + 256 * tm) = o;
        }
#pragma unroll
        for (int t = 0; t < 8; ++t) {
            f32x4 acc = S[t] * gl;
#pragma unroll
            for (int s = 0; s < 2; ++s) {
                const u32x2 lo = *(const LAS u32x2*)(B + SC_KDT + ((4 * s + (fq >> 1)) * 128 + 16 * t + fr) * 16 + (fq & 1) * 8);
                const u32x2 hi = *(const LAS u32x2*)(B + SC_KDT + ((4 * s + 2 + (fq >> 1)) * 128 + 16 * t + fr) * 16 + (fq & 1) * 8);
                u32x4 av; av[0] = lo[0]; av[1] = lo[1]; av[2] = hi[0]; av[3] = hi[1];
                acc = MFMA16(__builtin_bit_cast(bf16x8, av), Vf[s], acc); }
            S[t] = acc;
        }
#pragma unroll
        for (int tm = 0; tm < 4; ++tm) ucur[tm] = unext[tm];
    }
    asm volatile("s_waitcnt vmcnt(0)" ::: "memory");
    __syncthreads();
}

constexpr int AT_VT = 32768;
struct AtRaw { u32x4 k[4], v[4]; bf16x8 q[2]; };
struct AtItem { int b, head, dil, res, blk; };
DI AtItem at_decode(int item) {
    AtItem I; const int sub = item & 15; I.head = (item >> 4) % 12; I.b = item / 192;
    const int grp = I.head >> 2; I.dil = grp == 0 ? 1 : (grp == 1 ? 4 : 16); const int nbk = 16 / I.dil;
    I.res = sub / nbk; I.blk = sub % nbk; return I;
}
DI void at_load(AtRaw& R, const Params& p, int item, int tid) {
    const AtItem I = at_decode(item);
    const bf16_t* PB = (const bf16_t*)(p.ws + WS_R1);
    const int kk = tid >> 1, half = tid & 1, lk = (I.blk - 1) * 128 + kk;
    if (lk >= 0) { const bf16_t* rp = PB + (size_t)(I.b * SEQ + lk * I.dil + I.res) * 2304 + I.head * 64 + half * 32;
#pragma unroll
        for (int i = 0; i < 4; ++i) { R.k[i] = *(const u32x4*)(rp + 768 + 8 * i); R.v[i] = *(const u32x4*)(rp + 1536 + 8 * i); }
    } else {
#pragma unroll
        for (int i = 0; i < 4; ++i) { R.k[i] = (u32x4){0u, 0u, 0u, 0u}; R.v[i] = (u32x4){0u, 0u, 0u, 0u}; }
    }
    const int lane = tid & 63, wave = tid >> 6, fr = lane & 15, fq = lane >> 4;
    const int tq = (I.blk * 128 + 16 * wave + fr) * I.dil + I.res;
    const bf16_t* qrow = PB + (size_t)(I.b * SEQ + tq) * 2304 + I.head * 64;
    R.q[0] = *(const bf16x8*)(qrow + 8 * fq); R.q[1] = *(const bf16x8*)(qrow + 32 + 8 * fq);
}
DI void at_store_lds(const AtRaw& R, LAS unsigned char* lds, int tid) {
    const int kk = tid >> 1, half = tid & 1;
#pragma unroll
    for (int i = 0; i < 4; ++i) { const int c = half * 4 + i; *(LAS u32x4*)(lds + kk * 128 + ((c ^ ((kk >> 1) & 7)) * 16)) = R.k[i]; }
#pragma unroll
    for (int i = 0; i < 4; ++i)
#pragma unroll
        for (int e = 0; e < 4; ++e) { const int d0 = half * 32 + 8 * i + 2 * e, d1 = d0 + 1;
            *(LAS bf16_t*)(lds + AT_VT + d0 * 512 + (((kk >> 2) ^ ((d0 & 15) << 2)) * 8) + (kk & 3) * 2) = (bf16_t)(R.v[i][e] & 0xffffu);
            *(LAS bf16_t*)(lds + AT_VT + d1 * 512 + (((kk >> 2) ^ ((d1 & 15) << 2)) * 8) + (kk & 3) * 2) = (bf16_t)(R.v[i][e] >> 16); }
}
DI void at_compute(const Params& p, LAS unsigned char* lds, int item, const bf16x8 (&Qf)[2], int tid) {
    const int lane = tid & 63, wave = __builtin_amdgcn_readfirstlane(tid >> 6), fr = lane & 15, fq = lane >> 4;
    const AtItem I = at_decode(item);
    bf16_t* OB = (bf16_t*)(p.ws + WS_OB);
    float* LSE = (float*)(p.ws + WS_LSE);
    const int iq = 16 * wave + fr;
    const int tq = (I.blk * 128 + iq) * I.dil + I.res;
    const int offK0 = fr * 128 + (((0 + fq) ^ (fr >> 1)) * 16), offK1 = fr * 128 + (((4 + fq) ^ (fr >> 1)) * 16);
    const int kb2 = wave >> 1;
    f32x4 sc[10];
    float mx = -3.0e38f;
#pragma unroll
    for (int i = 0; i < 10; ++i) {
        const int kt = 2 * kb2 + i;
        if (kt < wave || kt > wave + 8) { sc[i] = (f32x4){-3.0e38f, -3.0e38f, -3.0e38f, -3.0e38f}; continue; }
        const bf16x8 a0 = *(const LAS bf16x8*)(lds + kt * 2048 + offK0), a1 = *(const LAS bf16x8*)(lds + kt * 2048 + offK1);
        f32x4 acc = {0.f, 0.f, 0.f, 0.f};
        acc = MFMA16(a0, Qf[0], acc); acc = MFMA16(a1, Qf[1], acc);
#pragma unroll
        for (int r = 0; r < 4; ++r) { const int kk = 16 * kt + 4 * fq + r;
            const bool valid = (kk >= iq) && (kk <= iq + 128) && (I.blk > 0 || kk >= 128);
            const float v = valid ? acc[r] * 0.125f : -3.0e38f; acc[r] = v; mx = fmaxf(mx, v); }
        sc[i] = acc;
    }
    mx = fmaxf(mx, __shfl_xor(mx, 16)); mx = fmaxf(mx, __shfl_xor(mx, 32));
    float den = 0.f;
    const float mxl = mx * 1.4426950408889634f;
#pragma unroll
    for (int i = 0; i < 10; ++i)
#pragma unroll
        for (int r = 0; r < 4; ++r) { const float v = sc[i][r]; const float e = (v > -1.0e38f) ? __builtin_amdgcn_exp2f(v * 1.4426950408889634f - mxl) : 0.f; sc[i][r] = e; den += e; }
    den += __shfl_xor(den, 16); den += __shfl_xor(den, 32);
    const float rden = __builtin_amdgcn_rcpf(den);
    bf16_t* orow = OB + (size_t)(I.b * SEQ + tq) * 768 + I.head * 64;
    f32x4 oacc[4];
#pragma unroll
    for (int dt = 0; dt < 4; ++dt) oacc[dt] = (f32x4){0.f, 0.f, 0.f, 0.f};
#pragma unroll
    for (int si = 0; si < 5; ++si) {
        const int s = kb2 + si;
        const bf16x8 Pf = pack8(sc[2 * si], sc[2 * si + 1]);
#pragma unroll
        for (int dt = 0; dt < 4; ++dt) {
            const u32x2 lo = *(const LAS u32x2*)(lds + AT_VT + (16 * dt + fr) * 512 + (((8 * s + fq) ^ (fr << 2)) * 8));
            const u32x2 hi = *(const LAS u32x2*)(lds + AT_VT + (16 * dt + fr) * 512 + (((8 * s + 4 + fq) ^ (fr << 2)) * 8));
            u32x4 av; av[0] = lo[0]; av[1] = lo[1]; av[2] = hi[0]; av[3] = hi[1];
            oacc[dt] = MFMA16(__builtin_bit_cast(bf16x8, av), Pf, oacc[dt]);
        }
    }
#pragma unroll
    for (int dt = 0; dt < 4; ++dt) { u32x2 o; o[0] = pk_bf16(oacc[dt][0] * rden, oacc[dt][1] * rden); o[1] = pk_bf16(oacc[dt][2] * rden, oacc[dt][3] * rden);
        *(u32x2*)(orow + 16 * dt + 4 * fq) = o; }
    if (fq == 0) LSE[(size_t)(I.b * SEQ + tq) * 12 + I.head] = mx + __logf(den);
}
DI void attn_phase(const Params& p, LAS unsigned char* lds, int it, int it_end) {
    int tid = threadIdx.x; asm volatile("" : "+v"(tid));
    if (it >= it_end) return;
    AtRaw R;
    at_load(R, p, it, tid);
    for (; it < it_end; ++it) {
        at_store_lds(R, lds, tid);
        __syncthreads();
        bf16x8 Qf[2]; Qf[0] = R.q[0]; Qf[1] = R.q[1];
        if (it + 1 < it_end) at_load(R, p, it + 1, tid);
        at_compute(p, lds, it, Qf, tid);
        __syncthreads();
    }
}

DI void ya_phase(const Params& p) {
    int tid = threadIdx.x; asm volatile("" : "+v"(tid));
    const int lane = tid & 63, wave = tid >> 6;
    const bf16_t* Z = (const bf16_t*)p.out + (size_t)MTOK * D;
    bf16_t* YA = (bf16_t*)(p.ws + WS_YA);
    const float nw0 = p.dn_norm_w[lane], nw1 = p.dn_norm_w[lane + 64];
    for (int task = blockIdx.x * 8 + wave; task < 2048 * 8; task += gridDim.x * 8) {
        const int item = task >> 3, tg = task & 7;
        const int bh = item >> 5, n = item & 31, b = bh >> 3, h = bh & 7;
        const bf16_t* OA = (const bf16_t*)p.out + (size_t)item * 8192 + (size_t)(((lane >> 4) * 4 + (tg >> 1)) * 64 + 2 * (tg & 1) * 16 + (lane & 15)) * 4;
        const u32x2 p00 = __builtin_nontemporal_load((const u32x2*)OA), p01 = __builtin_nontemporal_load((const u32x2*)(OA + 64)), p10 = __builtin_nontemporal_load((const u32x2*)(OA + 4 * 4 * 256)), p11 = __builtin_nontemporal_load((const u32x2*)(OA + 4 * 4 * 256 + 64));
        u32x4 o0, o1; o0[0] = p00[0]; o0[1] = p00[1]; o0[2] = p01[0]; o0[3] = p01[1]; o1[0] = p10[0]; o1[1] = p10[1]; o1[2] = p11[0]; o1[3] = p11[1];
        const size_t row0 = (size_t)(b * SEQ + n * 64 + tg * 8);
        const bf16_t* zp = Z + row0 * 1024 + h * 128 + lane;
        bf16_t z0[8], z1[8];
#pragma unroll
        for (int e = 0; e < 8; ++e) { z0[e] = __builtin_nontemporal_load(zp + (size_t)e * 1024); z1[e] = __builtin_nontemporal_load(zp + (size_t)e * 1024 + 64); }
        float a0[8], a1[8];
#pragma unroll
        for (int e = 0; e < 4; ++e) { a0[2 * e] = bflo(o0[e]); a0[2 * e + 1] = bfhi(o0[e]); a1[2 * e] = bflo(o1[e]); a1[2 * e + 1] = bfhi(o1[e]); }
        bf16_t* yp = YA + row0 * D + h * 128 + lane;
#pragma unroll
        for (int e = 0; e < 8; ++e) {
            const float ss = wave_sum(a0[e] * a0[e] + a1[e] * a1[e]);
            const float rstd = rsqrtf(ss * (1.f / 128.f) + EPS);
            yp[(size_t)e * D] = f2bf(a0[e] * rstd * nw0 * bf2f(z0[e]));
            yp[(size_t)e * D + 64] = f2bf(a1[e] * rstd * nw1 * bf2f(z1[e]));
        }
    }
}
DI void yb_rows(const Params& p) {
    int tid = threadIdx.x; asm volatile("" : "+v"(tid));
    const int lane = tid & 63, wave = tid >> 6;
    bf16_t* OB = (bf16_t*)(p.ws + WS_OB);
    const bf16_t* Z = (const bf16_t*)(p.ws + WS_ZB);
    const float* LSE = (const float*)(p.ws + WS_LSE);
    const int c0 = lane, c1 = lane + 64;
    const int j0 = (c0 >> 3) & 3, j1 = (c1 >> 3) & 3, g0 = c0 >> 5, g1 = c1 >> 5;
    for (int rq = blockIdx.x * 8 + wave; rq < MTOK / 4; rq += gridDim.x * 8) {
        float l0[4][3], l1[4][3]; u32x4 o0[4], o1[4], z0[4], z1[4];
#pragma unroll
        for (int r = 0; r < 4; ++r) { const size_t row = (size_t)rq * 4 + r;
#pragma unroll
            for (int g = 0; g < 3; ++g) { l0[r][g] = LSE[row * 12 + 4 * g + j0]; l1[r][g] = LSE[row * 12 + 4 * g + j1]; }
            o0[r] = __builtin_nontemporal_load((const u32x4*)(OB + row * 768 + c0 * 8)); z0[r] = __builtin_nontemporal_load((const u32x4*)(Z + row * 768 + c0 * 8));
            if (c1 < 96) { o1[r] = __builtin_nontemporal_load((const u32x4*)(OB + row * 768 + c1 * 8)); z1[r] = __builtin_nontemporal_load((const u32x4*)(Z + row * 768 + c1 * 8)); }
            else { o1[r] = (u32x4){0u, 0u, 0u, 0u}; z1[r] = (u32x4){0u, 0u, 0u, 0u}; } }
#pragma unroll
        for (int r = 0; r < 4; ++r) { const size_t row = (size_t)rq * 4 + r;
            { const float m = fmaxf(l0[r][0], fmaxf(l0[r][1], l0[r][2]));
              const float e0 = __expf(l0[r][0] - m), e1 = __expf(l0[r][1] - m), e2 = __expf(l0[r][2] - m);
              const float w = (g0 == 0 ? e0 : (g0 == 1 ? e1 : e2)) * __builtin_amdgcn_rcpf(e0 + e1 + e2);
              u32x4 rr;
#pragma unroll
              for (int e = 0; e < 4; ++e) rr[e] = pk_bf16(bflo(o0[r][e]) * w * bflo(z0[r][e]), bfhi(o0[r][e]) * w * bfhi(z0[r][e]));
              *(u32x4*)(OB + row * 768 + c0 * 8) = rr; }
            if (c1 < 96) { const float m = fmaxf(l1[r][0], fmaxf(l1[r][1], l1[r][2]));
              const float e0 = __expf(l1[r][0] - m), e1 = __expf(l1[r][1] - m), e2 = __expf(l1[r][2] - m);
              const float w = (g1 == 0 ? e0 : (g1 == 1 ? e1 : e2)) * __builtin_amdgcn_rcpf(e0 + e1 + e2);
              u32x4 rr;
#pragma unroll
              for (int e = 0; e < 4; ++e) rr[e] = pk_bf16(bflo(o1[r][e]) * w * bflo(z1[r][e]), bfhi(o1[r][e]) * w * bfhi(z1[r][e]));
              *(u32x4*)(OB + row * 768 + c1 * 8) = rr; }
        }
    }
}

DI void final_norm(const Params& p) {
    int tid = threadIdx.x; asm volatile("" : "+v"(tid));
    const int lane = tid & 63, wave = tid >> 6;
    f32x4 w[4];
#pragma unroll
    for (int i = 0; i < 4; ++i) w[i] = *(const f32x4*)(p.fnw + i * 256 + lane * 4);
    for (int rq = blockIdx.x * 8 + wave; rq < MTOK / 4; rq += gridDim.x * 8) {
        f32x4 xv[4][4];
#pragma unroll
        for (int r = 0; r < 4; ++r)
#pragma unroll
            for (int i = 0; i < 4; ++i) xv[r][i] = *(const f32x4*)(p.out + ((size_t)rq * 4 + r) * D + i * 256 + lane * 4);
#pragma unroll
        for (int r = 0; r < 4; ++r) { float ss = 0.f;
#pragma unroll
            for (int i = 0; i < 4; ++i) ss += xv[r][i][0] * xv[r][i][0] + xv[r][i][1] * xv[r][i][1] + xv[r][i][2] * xv[r][i][2] + xv[r][i][3] * xv[r][i][3];
            ss = wave_sum(ss);
            const float rstd = rsqrtf(ss * (1.f / 1024.f) + EPS);
#pragma unroll
            for (int i = 0; i < 4; ++i) *(f32x4*)(p.out + ((size_t)rq * 4 + r) * D + i * 256 + lane * 4) = xv[r][i] * rstd * w[i]; }
    }
}

__global__ void __launch_bounds__(512, 2) fwd_megakernel(Params p) {
    extern __shared__ __attribute__((aligned(16))) unsigned char lds_raw[];
    LAS unsigned char* lds = (LAS unsigned char*)lds_raw;
    cg::grid_group grid = cg::this_grid();
    unsigned char* ws = p.ws;
    const int G = gridDim.x, bid = blockIdx.x;

    unsigned* barp = (unsigned*)(ws + WS_BAR);
    if (threadIdx.x < 4) ((LAS unsigned*)(lds + 138240))[threadIdx.x] = 0u;
    __syncthreads();
    XcdBarrier xb = xcd_barrier_post(barp, (volatile LAS unsigned*)(lds + 138240), (unsigned)G);
    if (p.ws == nullptr) grid.sync();
    phase0(p, lds);
    __syncthreads();
    phase1(p, lds);
    xcd_barrier(xb);
    {
        pg8::Gemm g{(const bf16_t*)(ws + WS_H), (const bf16_t*)(ws + WS_WT_IN), MTOK, 3072, 1024};
        pg8::StaticOrder S; S.init(MTOK, 3072, G, bid);
        pg8::EpiProj1<3072> E{(bf16_t*)(ws + WS_R1)};
        pg8::gemm_phase<pg8::EpiProj1<3072>, true>(lds, g, S, E);
    }
    xcd_barrier(xb);
    for (int base = bid; base < 2048; base += 8 * G) { int cnt = (2048 - base + G - 1) / G; if (cnt > 8) cnt = 8; chunk_prep_batch(p, lds, base, G, cnt); }
    xcd_barrier(xb);
    if (bid < 64) dn_scan(p, lds, bid);
    else {
        pg8::Gemm g{(const bf16_t*)(ws + WS_H), (const bf16_t*)(ws + WS_WT_IN) + (size_t)3072 * 1024, MTOK, 2304, 1024};
        pg8::StaticOrder S; S.init(MTOK, 2304, G - 64, bid - 64);
        pg8::EpiProj1<2304> E{(bf16_t*)(ws + WS_R1)};
        pg8::gemm_phase<pg8::EpiProj1<2304>, true>(lds, g, S, E);
        if (G == 256) {
            { XcdBarrier sb = xcd_barrier_post((unsigned*)(ws + WS_BAR + 32768), (volatile LAS unsigned*)(lds + 138248), 192u); xcd_barrier(sb); }
            attn_phase(p, lds, (bid - 64) * 4, (bid - 64) * 4 + 4);
        }
    }
    xcd_barrier(xb);
    {
        int a0, a1;
        if (G == 256) { if (bid < 192) { a0 = 768 + bid * 2; a1 = a0 + 2; } else { a0 = 1152 + (bid - 192) * 6; a1 = a0 + 6; } }
        else { const int per = (1536 + G - 1) / G; a0 = bid * per; a1 = a0 + per; if (a1 > 1536) a1 = 1536; }
        pg8::Gemm g{(const bf16_t*)(ws + WS_H), (const bf16_t*)(ws + WS_WT_IN) + (size_t)5376 * 1024, MTOK, 3840, 1024};
        pg8::StaticOrder S; S.init(MTOK, 3840, G, bid);
        pg8::EpiProjC E{ws, p.out};
        if (bid & 1) attn_phase(p, lds, a0, a1);
        pg8::gemm_phase<pg8::EpiProjC, true>(lds, g, S, E);
        if (!(bid & 1)) attn_phase(p, lds, a0, a1);
    }
    xcd_barrier(xb);
    ya_phase(p);
    yb_rows(p);
    xcd_barrier(xb);
    {
        pg8::StaticOrder S; S.init(MTOK, 1024, G, bid);
        pg8::Gemm g1{(const bf16_t*)(ws + WS_YA), (const bf16_t*)(ws + WS_WT_PA), MTOK, 1024, 1024};
        pg8::Gemm g2{(const bf16_t*)(ws + WS_OB), (const bf16_t*)(ws + WS_WT_PB), MTOK, 1024, 768};
        pg8::EpiMerge2 E{(bf16_t*)(ws + WS_H), (const bf16_t*)(ws + WS_R2)};
        pg8::Unit u; S.next(0, u);
        unsigned* pw = (unsigned*)(ws + WS_BAR + 49152) + u.pm * 64;
        panel_post_xcc(pw);
        pg8::gemm_phase2(lds, g1, g2, S, E);
        panel_handoff(pw);
    }
    {
        pg8::StaticOrder S; S.init(MTOK, 1024, G, bid);
        pg8::Gemm g{(const bf16_t*)(ws + WS_H), (const bf16_t*)(ws + WS_WT_O), MTOK, 1024, 1024};
        pg8::EpiOutNorm E{p.x, (const float*)(ws + WS_MOD), p.fnw, p.out, (float*)(ws + WS_RS), (unsigned*)(ws + WS_BAR + 16384)};
        pg8::gemm_phase(lds, g, S, E);
    }
}

extern "C" void kernel_launch(void* const* d_in, const int* in_sizes, int n_in, void* d_out, int out_size, void* d_ws, size_t ws_size, hipStream_t stream) {
    static int grid_blocks = 0;
    if (!grid_blocks) {
        int dev = 0, cus = 0, per_cu = 0;
        hipGetDevice(&dev);
        hipDeviceGetAttribute(&cus, hipDeviceAttributeMultiprocessorCount, dev);
        hipFuncSetAttribute((const void*)fwd_megakernel, hipFuncAttributeMaxDynamicSharedMemorySize, LDS_BYTES);
        hipOccupancyMaxActiveBlocksPerMultiprocessor(&per_cu, (const void*)fwd_megakernel, 512, LDS_BYTES);
        if (per_cu < 1) per_cu = 1;
        grid_blocks = cus;
        if (ws_size < WS_END) fprintf(stderr, "kernel_launch: workspace too small (%zu < %zu)\n", ws_size, (size_t)WS_END);
        (void)hipGetLastError();
    }
    Params p{};
    p.x = (const float*)d_in[0]; p.c = (const float*)d_in[1]; p.norm_w = (const float*)d_in[2]; p.ada_w = (const float*)d_in[3]; p.ada_b = (const float*)d_in[4];
    p.w_in = (const float*)d_in[5]; p.conv_w = (const float*)d_in[6]; p.a_log = (const float*)d_in[7]; p.dt_bias = (const float*)d_in[8]; p.dn_norm_w = (const float*)d_in[9];
    p.w_pa = (const float*)d_in[10]; p.w_pb = (const float*)d_in[11]; p.w_out = (const float*)d_in[12]; p.fnw = (const float*)d_in[13];
    p.out = (float*)d_out; p.ws = (unsigned char*)d_ws;
    (void)hipMemsetAsync((unsigned char*)d_ws + WS_BAR, 0, 65536, stream);
    void* args[] = {&p};
    hipError_t e = hipLaunchCooperativeKernel((const void*)fwd_megakernel, dim3(grid_blocks), dim3(512), args, LDS_BYTES, stream);
    if (e != hipSuccess) fprintf(stderr, "cooperative launch failed: %s (grid %d)\n", hipGetErrorString(e), grid_blocks);
}
```

```cpp
#include <hip/hip_runtime.h>
#include <hip/hip_cooperative_groups.h>
#include <cstdio>
namespace cg = cooperative_groups;

#define LAS __attribute__((address_space(3)))
typedef unsigned short bf16_t;
typedef short bf16x8 __attribute__((ext_vector_type(8)));
typedef float f32x4 __attribute__((ext_vector_type(4)));
typedef float f32x2 __attribute__((ext_vector_type(2)));
typedef unsigned u32x4 __attribute__((ext_vector_type(4)));
typedef unsigned u32x2 __attribute__((ext_vector_type(2)));
typedef __bf16 bf2_t __attribute__((ext_vector_type(2)));
#define DI __device__ __forceinline__

constexpr int D = 1024, NB = 8, SEQ = 2048, MTOK = NB * SEQ;
constexpr int N_IN = 9232;
constexpr float EPS = 1e-6f;
constexpr size_t MiB = 1048576;
constexpr size_t WS_WT_IN = 0;
constexpr size_t WS_WT_PA = 18 * MiB;
constexpr size_t WS_WT_PB = 20 * MiB;
constexpr size_t WS_WT_O  = 21 * MiB + 512 * 1024;
constexpr size_t WS_MOD   = 23 * MiB + 512 * 1024;
constexpr size_t WS_BETA  = WS_MOD + 128 * 1024;
constexpr size_t WS_G     = WS_BETA + 512 * 1024;
constexpr size_t WS_GL    = WS_G + 512 * 1024;
constexpr size_t WS_BAR   = WS_GL + 64 * 1024;
constexpr size_t WS_LSE   = 24 * MiB + 768 * 1024;
static_assert(WS_BAR + 4096 <= WS_LSE && WS_LSE + 768 * 1024 <= 26 * MiB, "ws map");
constexpr size_t WS_H     = 26 * MiB;
constexpr size_t WS_R1    = 58 * MiB;
constexpr size_t WS_OB    = WS_R1 + 72 * MiB;
constexpr size_t WS_R2    = 154 * MiB;
constexpr size_t WS_QD    = WS_R2;
constexpr size_t WS_KDT   = WS_R2 + 32 * MiB;
constexpr size_t WS_AG    = WS_R2 + 64 * MiB;
constexpr size_t WS_MODP  = 234 * MiB;
constexpr size_t WS_RS    = 25 * MiB + 512 * 1024;
constexpr size_t WS_ZB    = 218 * MiB;
constexpr size_t WS_YA    = WS_R1;
constexpr size_t WS_END   = 235 * MiB;
constexpr int LDS_BYTES = 138240 + 16;

struct Params {
    const float *x, *c, *norm_w, *ada_w, *ada_b, *w_in, *conv_w, *a_log, *dt_bias, *dn_norm_w, *w_pa, *w_pb, *w_out, *fnw;
    float* out; unsigned char* ws;
};

DI unsigned pk_bf16(float lo, float hi) { f32x2 v = {lo, hi}; bf2_t b = __builtin_convertvector(v, bf2_t); return __builtin_bit_cast(unsigned, b); }
DI bf16_t f2bf(float x) { return (bf16_t)(pk_bf16(x, 0.f) & 0xffffu); }
DI float bf2f(bf16_t b) { return __uint_as_float(((unsigned)b) << 16); }
DI float bflo(unsigned u) { return __uint_as_float(u << 16); }
DI float bfhi(unsigned u) { return __uint_as_float(u & 0xffff0000u); }
DI float sigmoidf_(float v) { return __builtin_amdgcn_rcpf(1.f + __builtin_amdgcn_exp2f(v * -1.4426950408889634f)); }
DI float siluf_(float v) { return v * __builtin_amdgcn_rcpf(1.f + __builtin_amdgcn_exp2f(v * -1.4426950408889634f)); }
template <int CTRL> DI float dpp_f(float v) { return __builtin_bit_cast(float, __builtin_amdgcn_update_dpp(0, __builtin_bit_cast(int, v), CTRL, 0xf, 0xf, false)); }
DI float wave_sum(float v) {
    v += dpp_f<0x128>(v); v += dpp_f<0x124>(v); v += dpp_f<0x122>(v); v += dpp_f<0x121>(v);
    const int iv = __builtin_bit_cast(int, v);
    return __builtin_bit_cast(float, __builtin_amdgcn_readlane(iv, 0)) + __builtin_bit_cast(float, __builtin_amdgcn_readlane(iv, 16))
         + __builtin_bit_cast(float, __builtin_amdgcn_readlane(iv, 32)) + __builtin_bit_cast(float, __builtin_amdgcn_readlane(iv, 48));
}
DI void reduce8(const float (&p)[8], float (&tot)[8], int lane) {
    const bool b5 = (lane & 32) != 0, b4 = (lane & 16) != 0, b3 = (lane & 8) != 0;
    float q[4], r2[2];
#pragma unroll
    for (int e = 0; e < 4; ++e) { const float send = b5 ? p[e] : p[e + 4], keep = b5 ? p[e + 4] : p[e]; q[e] = keep + __shfl_xor(send, 32); }
#pragma unroll
    for (int e = 0; e < 2; ++e) { const float send = b4 ? q[e] : q[e + 2], keep = b4 ? q[e + 2] : q[e]; r2[e] = keep + __shfl_xor(send, 16); }
    const float send = b3 ? r2[0] : r2[1], keep = b3 ? r2[1] : r2[0];
    float s = keep + dpp_f<0x128>(send);
    s += dpp_f<0xB1>(s);
    s += dpp_f<0x4E>(s);
    s += dpp_f<0x141>(s);
    const int iv = __builtin_bit_cast(int, s);
#pragma unroll
    for (int e = 0; e < 8; ++e) tot[e] = __builtin_bit_cast(float, __builtin_amdgcn_readlane(iv, 8 * e));
}
DI bf16x8 pack8(const f32x4& a, const f32x4& b) {
    u32x4 p; p[0] = pk_bf16(a[0], a[1]); p[1] = pk_bf16(a[2], a[3]); p[2] = pk_bf16(b[0], b[1]); p[3] = pk_bf16(b[2], b[3]);
    return __builtin_bit_cast(bf16x8, p);
}

#define XB_TMO      128
#define XB_XCNT(j)  (256  + 64 * (j))
#define XB_XSUB(j)  (1280 + 64 * (j))
#define XB_XGEN(j)  (2304 + 64 * (j))
#define XB_TOP      3328
#define XB_TOPGEN   3392
#define XCD_BAR_WORDS 3456
#define XB_SPIN_CAP (1u << 18)
DI unsigned xb_ld(unsigned* p)              { return __hip_atomic_load(p, __ATOMIC_RELAXED, __HIP_MEMORY_SCOPE_AGENT); }
DI unsigned xb_add(unsigned* p, unsigned v) { return __hip_atomic_fetch_add(p, v, __ATOMIC_RELAXED, __HIP_MEMORY_SCOPE_AGENT); }
DI unsigned xb_xcc_id() { return (unsigned)__builtin_amdgcn_s_getreg((3 << 11) | 20) & 0xFu; }
#define XB_SPIN(cond, bar) do { unsigned _sp = 0; while (cond) { __builtin_amdgcn_s_sleep(1); \
    if ((++_sp & 255u) == 0u) { if (xb_ld(&(bar)[XB_TMO])) break; if (_sp > XB_SPIN_CAP) { atomicAdd(&(bar)[XB_TMO], 1u); break; } } } } while (0)
struct XcdBarrier { unsigned* bar; unsigned x; volatile LAS unsigned* st; unsigned total; };
DI XcdBarrier xcd_barrier_post(unsigned* bar, volatile LAS unsigned* st, unsigned total) {
    XcdBarrier b; b.bar = bar; b.x = xb_xcc_id(); b.st = st; b.total = total;
    if (threadIdx.x == 0) (void)xb_add(&bar[XB_XCNT(b.x)], 1u);
    return b;
}
DI void xcd_barrier_complete(unsigned* bar, unsigned x, unsigned G, unsigned& nloc, unsigned& nx) {
    unsigned sum, cnt, mine, sp = 0u;
    for (;;) {
        sum = 0u; cnt = 0u; mine = 0u;
#pragma unroll
        for (unsigned j = 0; j < 16; ++j) { const unsigned c = xb_ld(&bar[XB_XCNT(j)]); sum += c; cnt += (c > 0u) ? 1u : 0u; mine = (j == x) ? c : mine; }
        if (sum == G) break;
        __builtin_amdgcn_s_sleep(1);
        if ((++sp & 255u) == 0u) { if (xb_ld(&bar[XB_TMO])) break; if (sp > XB_SPIN_CAP) { atomicAdd(&bar[XB_TMO], 1u); break; } }
    }
    nloc = mine > 0u ? mine : 1u; nx = cnt > 0u ? cnt : 1u;
}
DI void xcd_barrier(const XcdBarrier& b) {
    asm volatile("s_waitcnt vmcnt(0)" ::: "memory");
    __syncthreads();
    if (threadIdx.x == 0) {
        unsigned* bar = b.bar;
        __builtin_amdgcn_s_waitcnt(0);
        unsigned nloc = b.st[0], nx = b.st[1];
        if (nloc == 0u) { xcd_barrier_complete(bar, b.x, b.total, nloc, nx); b.st[0] = nloc; b.st[1] = nx; }
        const unsigned old = xb_add(&bar[XB_XSUB(b.x)], 1u);
        const unsigned gen = old / nloc;
        if (old + 1u == (gen + 1u) * nloc) {
            __builtin_amdgcn_fence(__ATOMIC_RELEASE, "agent");
            asm volatile("s_waitcnt vmcnt(0)" ::: "memory");
            const unsigned og = xb_add(&bar[XB_TOP], 1u);
            const unsigned tg = og / nx;
            if (og + 1u == (tg + 1u) * nx) xb_add(&bar[XB_TOPGEN], 1u);
            else XB_SPIN(xb_ld(&bar[XB_TOPGEN]) == tg, bar);
            __builtin_amdgcn_fence(__ATOMIC_ACQUIRE, "agent");
            xb_add(&bar[XB_XGEN(b.x)], 1u);
            asm volatile("s_waitcnt vmcnt(0)" ::: "memory");
        } else {
            XB_SPIN(xb_ld(&bar[XB_XGEN(b.x)]) == gen, bar);
            __builtin_amdgcn_fence(__ATOMIC_ACQUIRE, "agent");
            asm volatile("s_waitcnt vmcnt(0)" ::: "memory");
        }
    }
    __syncthreads();
}
DI void subset_barrier(unsigned* ctr, unsigned nblk) {
    asm volatile("s_waitcnt vmcnt(0)" ::: "memory");
    __syncthreads();
    if (threadIdx.x == 0) {
        __builtin_amdgcn_fence(__ATOMIC_RELEASE, "agent");
        asm volatile("s_waitcnt vmcnt(0)" ::: "memory");
        __hip_atomic_fetch_add(ctr, 1u, __ATOMIC_RELAXED, __HIP_MEMORY_SCOPE_AGENT);
        unsigned sp = 0;
        while (__hip_atomic_load(ctr, __ATOMIC_RELAXED, __HIP_MEMORY_SCOPE_AGENT) < nblk) { __builtin_amdgcn_s_sleep(2); if (++sp > (1u << 24)) break; }
        __builtin_amdgcn_fence(__ATOMIC_ACQUIRE, "agent");
        asm volatile("s_waitcnt vmcnt(0)" ::: "memory");
    }
    __syncthreads();
}
DI void panel_post_xcc(unsigned* w) {
    if (threadIdx.x == 0) { __hip_atomic_fetch_add(w, 1u << (3u * (xb_xcc_id() & 7u)), __ATOMIC_RELAXED, __HIP_MEMORY_SCOPE_AGENT); __hip_atomic_fetch_add(w + 16, 1u, __ATOMIC_RELAXED, __HIP_MEMORY_SCOPE_AGENT); }
}
DI void panel_handoff(unsigned* w) {
    asm volatile("s_waitcnt vmcnt(0)" ::: "memory");
    __syncthreads();
    if (threadIdx.x == 0) {
        unsigned sp = 0;
        while (__hip_atomic_load(w + 16, __ATOMIC_RELAXED, __HIP_MEMORY_SCOPE_AGENT) < 4u) { __builtin_amdgcn_s_sleep(1); if (++sp > (1u << 24)) break; }
        const bool same = __hip_atomic_load(w, __ATOMIC_RELAXED, __HIP_MEMORY_SCOPE_AGENT) == (4u << (3u * (xb_xcc_id() & 7u)));
        if (!same) { __builtin_amdgcn_fence(__ATOMIC_RELEASE, "agent"); asm volatile("s_waitcnt vmcnt(0)" ::: "memory"); }
        __hip_atomic_fetch_add(w + 32, 1u, __ATOMIC_RELAXED, __HIP_MEMORY_SCOPE_AGENT);
        sp = 0;
        while (__hip_atomic_load(w + 32, __ATOMIC_RELAXED, __HIP_MEMORY_SCOPE_AGENT) < 4u) { __builtin_amdgcn_s_sleep(1); if (++sp > (1u << 24)) break; }
        if (!same) { __builtin_amdgcn_fence(__ATOMIC_ACQUIRE, "agent"); asm volatile("s_waitcnt vmcnt(0)" ::: "memory"); }
    }
    __syncthreads();
}
#define MFMA16(a, b, c) __builtin_amdgcn_mfma_f32_16x16x32_bf16((a), (b), (c), 0, 0, 0)

namespace pg8 {
constexpr int BM = 256, BK = 64, HALF = 128, HTB = HALF * BK * 2, STAGE_BYTES = 8 * HTB, NXCD = 8, WGM = 8;
DI int lds_byte(int r, int c) { const int st = (r >> 4) * 2 + (c >> 5), rr = r & 15, cc = c & 31, ob = rr * 64 + cc * 2; return st * 1024 + (ob ^ (((ob >> 9) & 1) << 5)); }
DI void stage_rc(int b, int& R, int& C) { const int st = b / 1024, sb = b % 1024, swz = sb ^ (((sb >> 9) & 1) << 5); R = (st >> 1) * 16 + swz / 64; C = (st & 1) * 32 + (swz % 64) / 2; }
DI int perm32(int rho) { const int n = rho >> 4, i = rho & 15; return 8 * (i >> 2) + 4 * n + (i & 3); }
struct Unit { int pm, pn; };
struct Gemm { const bf16_t* A; const bf16_t* Bt; int M, N, K; };
struct StaticOrder {
    int nM, nN, nwg, G, c;
    DI void init(int M, int N, int G_, int c_) { nM = M / BM; nN = N / BM; nwg = nM * nN; G = G_; c = c_; }
    DI bool next(int i, Unit& u) const {
        const long L = (long)i * G + c; if (L >= nwg) return false;
        int wgid = (int)L; { const int q = nwg / NXCD, r = nwg % NXCD, xcd = wgid % NXCD, off = wgid / NXCD; wgid = (xcd < r ? xcd * (q + 1) : r * (q + 1) + (xcd - r) * q) + off; }
        const int nig = WGM * nN, gid = wgid / nig, fm = gid * WGM, gsz = (nM - fm) < WGM ? (nM - fm) : WGM;
        u.pm = fm + ((wgid % nig) % gsz); u.pn = (wgid % nig) / gsz; return true;
    }
};

template <class Epi, bool ALIGN_EPI = false>
DI void gemm_phase(LAS unsigned char* lds, const Gemm g, const StaticOrder& S, const Epi& E) {
    int tid = threadIdx.x; asm volatile("" : "+v"(tid));
    const int wid = __builtin_amdgcn_readfirstlane(tid >> 6), lane = tid & 63, wr = wid >> 2, wc = wid & 3, fr = lane & 15, fq = lane >> 4;
    const int K = g.K, nt = K / BK;
    unsigned voffA[2], voffB[2];
#pragma unroll
    for (int i = 0; i < 2; ++i) { int R, C; stage_rc(tid * 16 + i * 8192, R, C); const int Rb = Epi::PERM ? ((R & ~31) + perm32(R & 31)) : R;
        voffA[i] = (unsigned)(R * K + C) * 2u; voffB[i] = (unsigned)(Rb * K + C) * 2u; }
    const size_t kstep = (size_t)(BK * 2);
    const size_t hstep = (size_t)HALF * K * 2;
    const size_t tstep = 2 * hstep;
    const unsigned ldsw = (unsigned)wid * 1024u;
    const int aoff = lds_byte(wr * 64 + fr, fq * 8), boff = lds_byte(wc * 32 + fr, fq * 8);
#define PG8_SA(b, h) (((b) * 2 + (h)) * HTB)
#define PG8_SB(b, h) ((4 + (b) * 2 + (h)) * HTB)
#define PG8_STAGE(bufoff, gbase, voff) do { _Pragma("unroll") for (int _i = 0; _i < 2; ++_i) \
        __builtin_amdgcn_global_load_lds((const unsigned*)((const char*)(gbase) + (voff)[_i]), (LAS unsigned*)(lds + (bufoff) + ldsw + _i * 8192), 16, 0, 0); } while (0)
#define PG8_LDA(dst, b, h) do { _Pragma("unroll") for (int m = 0; m < 4; ++m) _Pragma("unroll") for (int k = 0; k < 2; ++k) dst[m][k] = *(const LAS bf16x8*)(lds + PG8_SA(b, h) + aoff + m * 2048 + k * 1024); } while (0)
#define PG8_LDB(dst, b, h) do { _Pragma("unroll") for (int n = 0; n < 2; ++n) _Pragma("unroll") for (int k = 0; k < 2; ++k) dst[n][k] = *(const LAS bf16x8*)(lds + PG8_SB(b, h) + boff + n * 2048 + k * 1024); } while (0)
#define PG8_MMA(ai, bj, At, Bt) do { __builtin_amdgcn_s_setprio(1); _Pragma("unroll") for (int m = 0; m < 4; ++m) _Pragma("unroll") for (int n = 0; n < 2; ++n) _Pragma("unroll") for (int k = 0; k < 2; ++k) \
        acc[ai][bj][m][n] = __builtin_amdgcn_mfma_f32_16x16x32_bf16(Bt[n][k], At[m][k], acc[ai][bj][m][n], 0, 0, 0); __builtin_amdgcn_s_setprio(0); } while (0)
#define PG8_WAIT_V(n) asm volatile("s_waitcnt vmcnt(" #n ")" ::: "memory")
#define PG8_WAIT_L(n) asm volatile("s_waitcnt lgkmcnt(" #n ")" ::: "memory")
#define PG8_BAR __builtin_amdgcn_s_barrier()
#define PG8_SCHED __builtin_amdgcn_sched_barrier(0)
    Unit cur, nxt; int ui = 0;
    if (!S.next(0, cur)) return;
    f32x4 acc[2][2][4][2];
#pragma unroll
    for (int a = 0; a < 2; ++a)
#pragma unroll
        for (int b = 0; b < 2; ++b)
#pragma unroll
            for (int m = 0; m < 4; ++m)
#pragma unroll
                for (int n = 0; n < 2; ++n) acc[a][b][m][n] = (f32x4){0.f, 0.f, 0.f, 0.f};
    bf16x8 At[4][2], B0[2][2], B1[2][2];
    const char* cA = (const char*)g.A + (size_t)cur.pm * tstep; const char* cB = (const char*)g.Bt + (size_t)cur.pn * tstep;
    PG8_STAGE(PG8_SB(0, 0), cB, voffB); PG8_STAGE(PG8_SB(0, 1), cB + hstep, voffB); PG8_STAGE(PG8_SA(0, 0), cA, voffA); PG8_STAGE(PG8_SA(0, 1), cA + hstep, voffA);
    if (wr == 1) PG8_BAR;
    PG8_WAIT_V(2); PG8_BAR;
    PG8_STAGE(PG8_SB(1, 0), cB + kstep, voffB); PG8_STAGE(PG8_SA(1, 0), cA + kstep, voffA); PG8_STAGE(PG8_SB(1, 1), cB + hstep + kstep, voffB);
    PG8_WAIT_V(6); PG8_BAR;
    for (;;) {
        const bool has_next = S.next(ui + 1, nxt);
        const char* nA = has_next ? (const char*)g.A + (size_t)nxt.pm * tstep : cA; const char* nB = has_next ? (const char*)g.Bt + (size_t)nxt.pn * tstep : cB;
        for (int t = 0; t < nt; t += 2) {
            const bool last = (t == nt - 2);
            const char* a1 = cA + (size_t)(t + 1) * kstep;
            const char* a2 = last ? nA : cA + (size_t)(t + 2) * kstep; const char* b2 = last ? nB : cB + (size_t)(t + 2) * kstep;
            const char* a3 = a2 + kstep; const char* b3 = b2 + kstep;
            PG8_LDB(B0, 0, 0); PG8_LDB(B1, 0, 1); PG8_SCHED; PG8_LDA(At, 0, 0); PG8_STAGE(PG8_SA(1, 1), a1 + hstep, voffA);
            PG8_WAIT_V(8); PG8_WAIT_L(0); PG8_BAR; PG8_MMA(0, 0, At, B0); PG8_MMA(0, 1, At, B1); PG8_BAR; PG8_SCHED;
            PG8_LDA(At, 0, 1); PG8_STAGE(PG8_SB(0, 0), b2, voffB); PG8_STAGE(PG8_SB(0, 1), b2 + hstep, voffB); PG8_STAGE(PG8_SA(0, 0), a2, voffA);
            PG8_WAIT_V(8); PG8_WAIT_L(0); PG8_BAR; PG8_MMA(1, 0, At, B0); PG8_MMA(1, 1, At, B1); PG8_BAR; PG8_SCHED;
            PG8_LDB(B0, 1, 0); PG8_LDB(B1, 1, 1); PG8_SCHED; PG8_LDA(At, 1, 0); PG8_STAGE(PG8_SA(0, 1), a2 + hstep, voffA);
            PG8_WAIT_V(8); PG8_WAIT_L(0); PG8_BAR; PG8_MMA(0, 0, At, B0); PG8_MMA(0, 1, At, B1); PG8_BAR; PG8_SCHED;
            PG8_LDA(At, 1, 1); PG8_STAGE(PG8_SB(1, 0), b3, voffB); PG8_STAGE(PG8_SB(1, 1), b3 + hstep, voffB); PG8_STAGE(PG8_SA(1, 0), a3, voffA);
            PG8_WAIT_V(8); PG8_WAIT_L(0); PG8_BAR; PG8_MMA(1, 0, At, B0); PG8_MMA(1, 1, At, B1); PG8_BAR; PG8_SCHED;
        }
        if constexpr (ALIGN_EPI) { if (wr == 0) PG8_BAR; }
        if constexpr (!Epi::AFTER_DRAIN) E(acc, cur, wr, wc, fr, fq);
        if (!has_next) break;
#pragma unroll
        for (int a = 0; a < 2; ++a)
#pragma unroll
            for (int b = 0; b < 2; ++b)
#pragma unroll
                for (int m = 0; m < 4; ++m)
#pragma unroll
                    for (int n = 0; n < 2; ++n) acc[a][b][m][n] = (f32x4){0.f, 0.f, 0.f, 0.f};
        cur = nxt; cA = nA; cB = nB; ++ui;
        if constexpr (ALIGN_EPI) { if (wr == 1) PG8_BAR; }
    }
    PG8_WAIT_V(0);
    if constexpr (!ALIGN_EPI) { if (wr == 0) PG8_BAR; }
    PG8_BAR;
    if constexpr (Epi::AFTER_DRAIN) E.fused(acc, cur, wr, wc, fr, fq, lds);
#undef PG8_SA
#undef PG8_SB
#undef PG8_STAGE
#undef PG8_LDA
#undef PG8_LDB
#undef PG8_MMA
#undef PG8_WAIT_V
#undef PG8_WAIT_L
#undef PG8_BAR
#undef PG8_SCHED
}

template <class Epi>
DI void gemm_phase2(LAS unsigned char* lds, const Gemm g0, const Gemm g1, const StaticOrder& S, const Epi& E) {
    int tid = threadIdx.x; asm volatile("" : "+v"(tid));
    const int wid = __builtin_amdgcn_readfirstlane(tid >> 6), lane = tid & 63, wr = wid >> 2, wc = wid & 3, fr = lane & 15, fq = lane >> 4;
    unsigned rA[2], rB[2], c2[2];
#pragma unroll
    for (int i = 0; i < 2; ++i) { int R, C; stage_rc(tid * 16 + i * 8192, R, C); const int Rb = Epi::PERM ? ((R & ~31) + perm32(R & 31)) : R;
        rA[i] = (unsigned)R; rB[i] = (unsigned)Rb; c2[i] = (unsigned)C * 2u; }
    const unsigned k20 = (unsigned)g0.K * 2u, k21 = (unsigned)g1.K * 2u;
    const size_t kstep = (size_t)(BK * 2);
    const size_t hs0 = (size_t)HALF * g0.K * 2, hs1 = (size_t)HALF * g1.K * 2;
    const unsigned ldsw = (unsigned)wid * 1024u;
    const int aoff = lds_byte(wr * 64 + fr, fq * 8), boff = lds_byte(wc * 32 + fr, fq * 8);
#define PG8_SA(b, h) (((b) * 2 + (h)) * HTB)
#define PG8_SB(b, h) ((4 + (b) * 2 + (h)) * HTB)
#define PG8_STAGE(bufoff, gbase, rowv, k2) do { _Pragma("unroll") for (int _i = 0; _i < 2; ++_i) \
        __builtin_amdgcn_global_load_lds((const unsigned*)((const char*)(gbase) + ((rowv)[_i] * (k2) + c2[_i])), (LAS unsigned*)(lds + (bufoff) + ldsw + _i * 8192), 16, 0, 0); } while (0)
#define PG8_LDA(dst, b, h) do { _Pragma("unroll") for (int m = 0; m < 4; ++m) _Pragma("unroll") for (int k = 0; k < 2; ++k) dst[m][k] = *(const LAS bf16x8*)(lds + PG8_SA(b, h) + aoff + m * 2048 + k * 1024); } while (0)
#define PG8_LDB(dst, b, h) do { _Pragma("unroll") for (int n = 0; n < 2; ++n) _Pragma("unroll") for (int k = 0; k < 2; ++k) dst[n][k] = *(const LAS bf16x8*)(lds + PG8_SB(b, h) + boff + n * 2048 + k * 1024); } while (0)
#define PG8_MMA(ai, bj, At, Bt) do { __builtin_amdgcn_s_setprio(1); _Pragma("unroll") for (int m = 0; m < 4; ++m) _Pragma("unroll") for (int n = 0; n < 2; ++n) _Pragma("unroll") for (int k = 0; k < 2; ++k) \
        acc[ai][bj][m][n] = __builtin_amdgcn_mfma_f32_16x16x32_bf16(Bt[n][k], At[m][k], acc[ai][bj][m][n], 0, 0, 0); __builtin_amdgcn_s_setprio(0); } while (0)
#define PG8_WAIT_V(n) asm volatile("s_waitcnt vmcnt(" #n ")" ::: "memory")
#define PG8_WAIT_L(n) asm volatile("s_waitcnt lgkmcnt(" #n ")" ::: "memory")
#define PG8_BAR __builtin_amdgcn_s_barrier()
#define PG8_SCHED __builtin_amdgcn_sched_barrier(0)
    Unit cur;
    if (!S.next(0, cur)) return;
    f32x4 acc[2][2][4][2];
#pragma unroll
    for (int a = 0; a < 2; ++a)
#pragma unroll
        for (int b = 0; b < 2; ++b)
#pragma unroll
            for (int m = 0; m < 4; ++m)
#pragma unroll
                for (int n = 0; n < 2; ++n) acc[a][b][m][n] = (f32x4){0.f, 0.f, 0.f, 0.f};
    bf16x8 At[4][2], B0[2][2], B1[2][2];
    const char* cA = (const char*)g0.A + (size_t)cur.pm * 2 * hs0; const char* cB = (const char*)g0.Bt + (size_t)cur.pn * 2 * hs0;
    {   PG8_STAGE(PG8_SB(0, 0), cB, rB, k20); PG8_STAGE(PG8_SB(0, 1), cB + hs0, rB, k20); PG8_STAGE(PG8_SA(0, 0), cA, rA, k20); PG8_STAGE(PG8_SA(0, 1), cA + hs0, rA, k20);
        if (wr == 1) PG8_BAR;
        PG8_WAIT_V(2); PG8_BAR;
        PG8_STAGE(PG8_SB(1, 0), cB + kstep, rB, k20); PG8_STAGE(PG8_SA(1, 0), cA + kstep, rA, k20); PG8_STAGE(PG8_SB(1, 1), cB + hs0 + kstep, rB, k20);
        PG8_WAIT_V(6); PG8_BAR; }
#define PG8_KLOOP(ntc, hsc, k2c, nA, nB, hsn, k2n) \
        for (int t = 0; t < (ntc); t += 2) { \
            const bool last = (t == (ntc) - 2); \
            const char* a1 = cA + (size_t)(t + 1) * kstep; \
            const char* a2 = last ? (nA) : cA + (size_t)(t + 2) * kstep; const char* b2 = last ? (nB) : cB + (size_t)(t + 2) * kstep; \
            const char* a3 = a2 + kstep; const char* b3 = b2 + kstep; \
            const size_t hs2 = last ? (hsn) : (hsc); const unsigned k22 = last ? (k2n) : (k2c); \
            PG8_LDB(B0, 0, 0); PG8_LDB(B1, 0, 1); PG8_SCHED; PG8_LDA(At, 0, 0); PG8_STAGE(PG8_SA(1, 1), a1 + (hsc), rA, (k2c)); \
            PG8_WAIT_V(8); PG8_WAIT_L(0); PG8_BAR; PG8_MMA(0, 0, At, B0); PG8_MMA(0, 1, At, B1); PG8_BAR; PG8_SCHED; \
            PG8_LDA(At, 0, 1); PG8_STAGE(PG8_SB(0, 0), b2, rB, k22); PG8_STAGE(PG8_SB(0, 1), b2 + hs2, rB, k22); PG8_STAGE(PG8_SA(0, 0), a2, rA, k22); \
            PG8_WAIT_V(8); PG8_WAIT_L(0); PG8_BAR; PG8_MMA(1, 0, At, B0); PG8_MMA(1, 1, At, B1); PG8_BAR; PG8_SCHED; \
            PG8_LDB(B0, 1, 0); PG8_LDB(B1, 1, 1); PG8_SCHED; PG8_LDA(At, 1, 0); PG8_STAGE(PG8_SA(0, 1), a2 + hs2, rA, k22); \
            PG8_WAIT_V(8); PG8_WAIT_L(0); PG8_BAR; PG8_MMA(0, 0, At, B0); PG8_MMA(0, 1, At, B1); PG8_BAR; PG8_SCHED; \
            PG8_LDA(At, 1, 1); PG8_STAGE(PG8_SB(1, 0), b3, rB, k22); PG8_STAGE(PG8_SB(1, 1), b3 + hs2, rB, k22); PG8_STAGE(PG8_SA(1, 0), a3, rA, k22); \
            PG8_WAIT_V(8); PG8_WAIT_L(0); PG8_BAR; PG8_MMA(1, 0, At, B0); PG8_MMA(1, 1, At, B1); PG8_BAR; PG8_SCHED; \
        }
    const int nt0 = g0.K / BK, nt1 = g1.K / BK;
    {
        const char* pA1 = (const char*)g1.A + (size_t)cur.pm * 2 * hs1; const char* pB1 = (const char*)g1.Bt + (size_t)cur.pn * 2 * hs1;
        PG8_KLOOP(nt0, hs0, k20, pA1, pB1, hs1, k21)
        E.mid(acc, cur, wr, wc, fr, fq);
        cA = pA1; cB = pB1;
        PG8_KLOOP(nt1, hs1, k21, cA, cB, hs1, k21)
        E(acc, cur, wr, wc, fr, fq);
    }
#undef PG8_KLOOP
    PG8_WAIT_V(0);
    if (wr == 0) PG8_BAR;
    PG8_BAR;
#undef PG8_SA
#undef PG8_SB
#undef PG8_STAGE
#undef PG8_LDA
#undef PG8_LDB
#undef PG8_MMA
#undef PG8_WAIT_V
#undef PG8_WAIT_L
#undef PG8_BAR
#undef PG8_SCHED
}

template <int ACT> DI void epi_store8(bf16_t* dstp, f32x4 v0, f32x4 v1) {
    if (ACT == 1) {
#pragma unroll
        for (int e = 0; e < 4; ++e) { v0[e] = siluf_(v0[e]); v1[e] = siluf_(v1[e]); }
    } else if (ACT == 2) {
#pragma unroll
        for (int e = 0; e < 4; ++e) { v0[e] = sigmoidf_(v0[e]); v1[e] = sigmoidf_(v1[e]); }
    }
    u32x4 o; o[0] = pk_bf16(v0[0], v0[1]); o[1] = pk_bf16(v0[2], v0[3]); o[2] = pk_bf16(v1[0], v1[1]); o[3] = pk_bf16(v1[2], v1[3]);
    *(u32x4*)dstp = o;
}
template <int LD> struct EpiProj1 {
    static constexpr bool PERM = true, AFTER_DRAIN = false;
    bf16_t* dst;
    DI void operator()(const f32x4 (&acc)[2][2][4][2], const Unit& u, int wr, int wc, int fr, int fq) const {
        const int row0 = u.pm * BM + wr * 64 + fr, col0 = u.pn * BM + wc * 32 + 8 * fq;
#pragma unroll
        for (int ai = 0; ai < 2; ++ai)
#pragma unroll
            for (int m = 0; m < 4; ++m) { bf16_t* rowp = dst + (size_t)(row0 + ai * HALF + m * 16) * LD + col0;
#pragma unroll
                for (int bj = 0; bj < 2; ++bj) epi_store8<0>(rowp + bj * HALF, acc[ai][bj][m][0], acc[ai][bj][m][1]); }
    }
};
struct EpiProjC {
    static constexpr bool PERM = true, AFTER_DRAIN = false;
    unsigned char* ws; float* out;
    DI void operator()(const f32x4 (&acc)[2][2][4][2], const Unit& u, int wr, int wc, int fr, int fq) const {
        const int row0 = u.pm * BM + wr * 64 + fr, cw = wc * 32 + 8 * fq;
        if (u.pn < 4) { bf16_t* base = (bf16_t*)out + (size_t)MTOK * D + u.pn * BM + cw;
#pragma unroll
            for (int ai = 0; ai < 2; ++ai)
#pragma unroll
                for (int m = 0; m < 4; ++m)
#pragma unroll
                    for (int bj = 0; bj < 2; ++bj) epi_store8<1>(base + (size_t)(row0 + ai * HALF + m * 16) * 1024 + bj * HALF, acc[ai][bj][m][0], acc[ai][bj][m][1]);
        } else if (u.pn < 7) { bf16_t* base = (bf16_t*)(ws + WS_ZB) + (u.pn - 4) * BM + cw;
#pragma unroll
            for (int ai = 0; ai < 2; ++ai)
#pragma unroll
                for (int m = 0; m < 4; ++m)
#pragma unroll
                    for (int bj = 0; bj < 2; ++bj) epi_store8<1>(base + (size_t)(row0 + ai * HALF + m * 16) * 768 + bj * HALF, acc[ai][bj][m][0], acc[ai][bj][m][1]);
        } else { bf16_t* base = (bf16_t*)(ws + WS_R2) + (u.pn - 7) * BM + cw;
#pragma unroll
            for (int ai = 0; ai < 2; ++ai)
#pragma unroll
                for (int m = 0; m < 4; ++m)
#pragma unroll
                    for (int bj = 0; bj < 2; ++bj) epi_store8<2>(base + (size_t)(row0 + ai * HALF + m * 16) * 2048 + bj * HALF, acc[ai][bj][m][0], acc[ai][bj][m][1]);
        }
    }
};
struct EpiGate {
    static constexpr bool PERM = true, AFTER_DRAIN = false;
    bf16_t* T; const bf16_t* sg; int ldsg; int mode;
    DI void operator()(const f32x4 (&acc)[2][2][4][2], const Unit& u, int wr, int wc, int fr, int fq) const {
        const int row0 = u.pm * BM + wr * 64 + fr, col0 = u.pn * BM + wc * 32 + 8 * fq;
#pragma unroll
        for (int ai = 0; ai < 2; ++ai)
#pragma unroll
            for (int m = 0; m < 4; ++m) { const size_t row = (size_t)(row0 + ai * HALF + m * 16);
#pragma unroll
                for (int bj = 0; bj < 2; ++bj) { const f32x4 v0 = acc[ai][bj][m][0], v1 = acc[ai][bj][m][1];
                    const u32x4 s = *(const u32x4*)(sg + row * ldsg + col0 + bj * HALF);
                    float r[8] = { bflo(s[0]) * v0[0], bfhi(s[0]) * v0[1], bflo(s[1]) * v0[2], bfhi(s[1]) * v0[3], bflo(s[2]) * v1[0], bfhi(s[2]) * v1[1], bflo(s[3]) * v1[2], bfhi(s[3]) * v1[3] };
                    bf16_t* tp = T + row * D + col0 + bj * HALF;
                    if (mode == 1) { const u32x4 t = *(const u32x4*)tp;
                        r[0] += bflo(t[0]); r[1] += bfhi(t[0]); r[2] += bflo(t[1]); r[3] += bfhi(t[1]); r[4] += bflo(t[2]); r[5] += bfhi(t[2]); r[6] += bflo(t[3]); r[7] += bfhi(t[3]); }
                    u32x4 o; o[0] = pk_bf16(r[0], r[1]); o[1] = pk_bf16(r[2], r[3]); o[2] = pk_bf16(r[4], r[5]); o[3] = pk_bf16(r[6], r[7]);
                    *(u32x4*)tp = o; } }
    }
};
struct EpiMerge2 {
    static constexpr bool PERM = true, AFTER_DRAIN = false;
    bf16_t* out; const bf16_t* gt;
    DI void mid(f32x4 (&acc)[2][2][4][2], const Unit& u, int wr, int wc, int fr, int fq) const {
        int row0 = u.pm * BM + wr * 64 + fr, col0 = u.pn * BM + wc * 32 + 8 * fq;
        asm volatile("" : "+v"(row0), "+v"(col0));
#pragma unroll
        for (int ai = 0; ai < 2; ++ai)
#pragma unroll
            for (int m = 0; m < 4; ++m) { const bf16_t* gp = gt + (size_t)(row0 + ai * HALF + m * 16) * 2048 + col0;
#pragma unroll
                for (int bj = 0; bj < 2; ++bj) { const u32x4 sa = *(const u32x4*)(gp + bj * HALF), sb = *(const u32x4*)(gp + 1024 + bj * HALF);
#pragma unroll
                    for (int e = 0; e < 2; ++e) {
                        acc[ai][bj][m][0][2 * e]     *= bflo(sa[e]) * __builtin_amdgcn_rcpf(fmaxf(bflo(sb[e]), 1e-20f));
                        acc[ai][bj][m][0][2 * e + 1] *= bfhi(sa[e]) * __builtin_amdgcn_rcpf(fmaxf(bfhi(sb[e]), 1e-20f));
                        acc[ai][bj][m][1][2 * e]     *= bflo(sa[2 + e]) * __builtin_amdgcn_rcpf(fmaxf(bflo(sb[2 + e]), 1e-20f));
                        acc[ai][bj][m][1][2 * e + 1] *= bfhi(sa[2 + e]) * __builtin_amdgcn_rcpf(fmaxf(bfhi(sb[2 + e]), 1e-20f)); } }
                if (m & 1) __builtin_amdgcn_sched_barrier(0); }
    }
    DI void operator()(const f32x4 (&acc)[2][2][4][2], const Unit& u, int wr, int wc, int fr, int fq) const {
        int row0 = u.pm * BM + wr * 64 + fr, col0 = u.pn * BM + wc * 32 + 8 * fq;
        asm volatile("" : "+v"(row0), "+v"(col0));
#pragma unroll
        for (int ai = 0; ai < 2; ++ai)
#pragma unroll
            for (int m = 0; m < 4; ++m) { const size_t row = (size_t)(row0 + ai * HALF + m * 16);
#pragma unroll
                for (int bj = 0; bj < 2; ++bj) { const f32x4 v0 = acc[ai][bj][m][0], v1 = acc[ai][bj][m][1];
                    const u32x4 sb = *(const u32x4*)(gt + row * 2048 + 1024 + col0 + bj * HALF);
                    u32x4 o;
                    o[0] = pk_bf16(v0[0] * fmaxf(bflo(sb[0]), 1e-20f), v0[1] * fmaxf(bfhi(sb[0]), 1e-20f)); o[1] = pk_bf16(v0[2] * fmaxf(bflo(sb[1]), 1e-20f), v0[3] * fmaxf(bfhi(sb[1]), 1e-20f));
                    o[2] = pk_bf16(v1[0] * fmaxf(bflo(sb[2]), 1e-20f), v1[1] * fmaxf(bfhi(sb[2]), 1e-20f)); o[3] = pk_bf16(v1[2] * fmaxf(bflo(sb[3]), 1e-20f), v1[3] * fmaxf(bfhi(sb[3]), 1e-20f));
                    *(u32x4*)(out + row * D + col0 + bj * HALF) = o; } }
    }
};
struct EpiOutNorm {
    static constexpr bool PERM = false, AFTER_DRAIN = true;
    const float* x; const float* mod; const float* fnw; float* out; float* rs; unsigned* cnt;
    DI void operator()(const f32x4 (&)[2][2][4][2], const Unit&, int, int, int, int) const {}
    DI void fused(f32x4 (&acc)[2][2][4][2], const Unit& u, int wr, int wc, int fr, int fq, LAS unsigned char* lds) const {
        const int tid = threadIdx.x;
        const int row0 = u.pm * BM + wr * 64 + fr, col0 = u.pn * BM + wc * 32 + 4 * fq;
        const int b = (u.pm * BM) / SEQ;
        LAS float* part = (LAS float*)lds;
        LAS float* rstd_l = (LAS float*)(lds + 4096);
        f32x4 gv[2][2];
#pragma unroll
        for (int bj = 0; bj < 2; ++bj)
#pragma unroll
            for (int n = 0; n < 2; ++n) gv[bj][n] = *(const f32x4*)(mod + b * 3072 + 2048 + col0 + bj * HALF + n * 16);
#pragma unroll
        for (int ai = 0; ai < 2; ++ai)
#pragma unroll
            for (int m = 0; m < 4; ++m) { const size_t ro = (size_t)(row0 + ai * HALF + m * 16) * D + col0;
                float ss = 0.f;
#pragma unroll
                for (int bj = 0; bj < 2; ++bj)
#pragma unroll
                    for (int n = 0; n < 2; ++n) { const f32x4 xv = __builtin_nontemporal_load((const f32x4*)(x + ro + bj * HALF + n * 16));
                        const f32x4 v = xv + gv[bj][n] * acc[ai][bj][m][n]; acc[ai][bj][m][n] = v;
                        ss += v[0] * v[0] + v[1] * v[1] + v[2] * v[2] + v[3] * v[3]; }
                ss += __shfl_xor(ss, 16); ss += __shfl_xor(ss, 32);
                if (fq == 0) part[wc * 256 + ai * HALF + wr * 64 + m * 16 + fr] = ss; }
        __syncthreads();
        if (tid < 256) __hip_atomic_store(rs + (size_t)(u.pm * 4 + u.pn) * 256 + tid, part[tid] + part[256 + tid] + part[512 + tid] + part[768 + tid], __ATOMIC_RELAXED, __HIP_MEMORY_SCOPE_AGENT);
        asm volatile("s_waitcnt vmcnt(0)" ::: "memory");
        __syncthreads();
        if (tid == 0) {
            unsigned* c = cnt + u.pm * 16;
            __hip_atomic_fetch_add(c, 1u, __ATOMIC_RELAXED, __HIP_MEMORY_SCOPE_AGENT);
            unsigned sp = 0;
            while (__hip_atomic_load(c, __ATOMIC_RELAXED, __HIP_MEMORY_SCOPE_AGENT) < 4u) { __builtin_amdgcn_s_sleep(1); if (++sp > (1u << 24)) break; }
        }
        __syncthreads();
        if (tid < 256) { float* rp = rs + (size_t)(u.pm * 4) * 256 + tid;
            const float tot = __hip_atomic_load(rp, __ATOMIC_RELAXED, __HIP_MEMORY_SCOPE_AGENT) + __hip_atomic_load(rp + 256, __ATOMIC_RELAXED, __HIP_MEMORY_SCOPE_AGENT)
                            + __hip_atomic_load(rp + 512, __ATOMIC_RELAXED, __HIP_MEMORY_SCOPE_AGENT) + __hip_atomic_load(rp + 768, __ATOMIC_RELAXED, __HIP_MEMORY_SCOPE_AGENT);
            rstd_l[tid] = rsqrtf(tot * (1.f / 1024.f) + EPS); }
        __syncthreads();
        f32x4 wv[2][2];
#pragma unroll
        for (int bj = 0; bj < 2; ++bj)
#pragma unroll
            for (int n = 0; n < 2; ++n) wv[bj][n] = *(const f32x4*)(fnw + col0 + bj * HALF + n * 16);
#pragma unroll
        for (int ai = 0; ai < 2; ++ai)
#pragma unroll
            for (int m = 0; m < 4; ++m) { const size_t ro = (size_t)(row0 + ai * HALF + m * 16) * D + col0;
                const float r = rstd_l[ai * HALF + wr * 64 + m * 16 + fr];
#pragma unroll
                for (int bj = 0; bj < 2; ++bj)
#pragma unroll
                    for (int n = 0; n < 2; ++n) *(f32x4*)(out + ro + bj * HALF + n * 16) = acc[ai][bj][m][n] * r * wv[bj][n]; }
    }
};
}

DI int map_n_in(int np) {
    if (np < 3072) return np;
    if (np < 5376) return 4112 + (np - 3072);
    if (np < 6400) return 3072 + (np - 5376);
    if (np < 7168) return 6416 + (np - 6400);
    return 7184 + (np - 7168);
}
struct TileDesc { const float* src; bf16_t* dst; int ld, col0, K, n0, k0; };
DI TileDesc tile_desc(const Params& p, int t) {
    TileDesc d; unsigned char* ws = p.ws;
    if (t < 2304) { const int tn = t >> 4, tk = t & 15; d.src = p.w_in; d.ld = N_IN; d.col0 = map_n_in(tn * 64); d.dst = (bf16_t*)(ws + WS_WT_IN); d.K = 1024; d.n0 = tn * 64; d.k0 = tk * 64; }
    else if (t < 2560) { const int u = t - 2304, tn = u >> 4, tk = u & 15; d.src = p.w_pa; d.ld = 1024; d.col0 = tn * 64; d.dst = (bf16_t*)(ws + WS_WT_PA); d.K = 1024; d.n0 = tn * 64; d.k0 = tk * 64; }
    else if (t < 2752) { const int u = t - 2560, tn = u / 12, tk = u % 12; d.src = p.w_pb; d.ld = 1024; d.col0 = tn * 64; d.dst = (bf16_t*)(ws + WS_WT_PB); d.K = 768; d.n0 = tn * 64; d.k0 = tk * 64; }
    else { const int u = t - 2752, tn = u >> 4, tk = u & 15; d.src = p.w_out; d.ld = 1024; d.col0 = tn * 64; d.dst = (bf16_t*)(ws + WS_WT_O); d.K = 1024; d.n0 = tn * 64; d.k0 = tk * 64; }
    return d;
}
DI void tile_load(float (&v)[8], const TileDesc& d, int tid) {
#pragma unroll
    for (int i = 0; i < 8; ++i) { const int r = (tid >> 6) + 8 * i, c = tid & 63; v[i] = __builtin_nontemporal_load(d.src + (size_t)(d.k0 + r) * d.ld + d.col0 + c); }
}
DI void phase0(const Params& p, LAS unsigned char* lds) {
    int tid = threadIdx.x; asm volatile("" : "+v"(tid));
    const int nb = gridDim.x;
    unsigned char* ws = p.ws;
    {
        const int task = nb - 1 - (int)blockIdx.x;
        if (task < 192) {
            LAS float* sc = (LAS float*)lds;
            LAS float* red = (LAS float*)(lds + 8192);
            const int cg = task % 48, ks = task / 48, k0 = ks * 256;
            for (int i = tid; i < 2048; i += 512) sc[i] = siluf_(p.c[(i >> 8) * 1024 + k0 + (i & 255)]);
            __syncthreads();
            const int col = cg * 64 + (tid & 63), kq = tid >> 6;
            float a[8] = {0.f, 0.f, 0.f, 0.f, 0.f, 0.f, 0.f, 0.f};
            const float* wp = p.ada_w + (size_t)(k0 + kq * 32) * 3072 + col;
#pragma unroll
            for (int kk = 0; kk < 32; kk += 8) {
                float w[8];
#pragma unroll
                for (int u = 0; u < 8; ++u) w[u] = __builtin_nontemporal_load(wp + (size_t)(kk + u) * 3072);
#pragma unroll
                for (int u = 0; u < 8; ++u)
#pragma unroll
                    for (int b = 0; b < 8; ++b) a[b] += sc[b * 256 + kq * 32 + kk + u] * w[u];
            }
#pragma unroll
            for (int b = 0; b < 8; ++b) red[(kq * 8 + b) * 64 + (tid & 63)] = a[b];
            __syncthreads();
            { const int b = tid >> 6, cl = tid & 63; float s = 0.f;
#pragma unroll
                for (int q = 0; q < 8; ++q) s += red[(q * 8 + b) * 64 + cl];
                __hip_atomic_store((float*)(ws + WS_MODP) + (size_t)(ks * 8 + b) * 3072 + cg * 64 + cl, s, __ATOMIC_RELAXED, __HIP_MEMORY_SCOPE_AGENT); }
            asm volatile("s_waitcnt vmcnt(0)" ::: "memory");
            __syncthreads();
            if (tid == 0)
                __hip_atomic_fetch_add((unsigned*)(ws + WS_BAR + 28672), 1u, __ATOMIC_RELAXED, __HIP_MEMORY_SCOPE_AGENT);
        }
    }
    LAS float* tile = (LAS float*)lds;
    int t = blockIdx.x;
    if (t < 3008) {
        TileDesc d = tile_desc(p, t);
        float v[8];
        tile_load(v, d, tid);
        for (;;) {
#pragma unroll
            for (int i = 0; i < 8; ++i) { const int r = (tid >> 6) + 8 * i, c = tid & 63; tile[r * 65 + c] = v[i]; }
            __syncthreads();
            const int tn = t + nb;
            TileDesc dn = d;
            if (tn < 3008) { dn = tile_desc(p, tn); tile_load(v, dn, tid); }
#pragma unroll
            for (int i = 0; i < 4; ++i) { const int rr = (tid >> 5) + 16 * i, cc = (tid & 31) * 2;
                *(unsigned*)(d.dst + (size_t)(d.n0 + rr) * d.K + d.k0 + cc) = pk_bf16(tile[cc * 65 + rr], tile[(cc + 1) * 65 + rr]); }
            __syncthreads();
            if (tn >= 3008) break;
            t = tn; d = dn;
        }
    }
}

DI void phase1(const Params& p, LAS unsigned char* lds) {
    LAS float* wT = (LAS float*)lds;
    LAS float* lmod = (LAS float*)(lds + 65536);
    int tid = threadIdx.x; asm volatile("" : "+v"(tid));
    const int lane = tid & 63, wave = tid >> 6;
    for (int i = tid; i < 16384; i += 512) { const int k = i >> 4, j = i & 15; wT[j * 1024 + k] = p.w_in[(size_t)k * N_IN + 4096 + j]; }
    float* mod = (float*)(p.ws + WS_MOD);
    const float* modp = (const float*)(p.ws + WS_MODP);
    bf16_t* H = (bf16_t*)(p.ws + WS_H);
    float* BETA = (float*)(p.ws + WS_BETA); float* GG = (float*)(p.ws + WS_G);
    if (tid == 0) {
        unsigned* c = (unsigned*)(p.ws + WS_BAR + 28672); unsigned sp = 0;
        while (__hip_atomic_load(c, __ATOMIC_RELAXED, __HIP_MEMORY_SCOPE_AGENT) < 192u) { __builtin_amdgcn_s_sleep(2); if (++sp > (1u << 24)) break; }
    }
    for (int rb = blockIdx.x; rb < MTOK / 64; rb += gridDim.x) {
        const int b = rb >> 5;
        __syncthreads();
        for (int i = tid; i < 3072; i += 512) {
            float v = p.ada_b[i];
#pragma unroll
            for (int ks = 0; ks < 4; ++ks) v += __hip_atomic_load((float*)modp + (size_t)(ks * 8 + b) * 3072 + i, __ATOMIC_RELAXED, __HIP_MEMORY_SCOPE_AGENT);
            if (i < 2048) lmod[i] = v;
            if ((rb & 31) == 0) mod[b * 3072 + i] = v;
        }
        __syncthreads();
        const float ea = expf(p.a_log[lane & 7]), dtb = p.dt_bias[lane & 7];
        for (int j = 0; j < 8; j += 4) {
            const int row = rb * 64 + wave * 8 + j;
            f32x4 xv[4][4]; float ss[4] = {0.f, 0.f, 0.f, 0.f};
#pragma unroll
            for (int r = 0; r < 4; ++r)
#pragma unroll
                for (int i = 0; i < 4; ++i) { xv[r][i] = __builtin_nontemporal_load((const f32x4*)(p.x + (size_t)(row + r) * D + i * 256 + lane * 4));
                    ss[r] += xv[r][i][0] * xv[r][i][0] + xv[r][i][1] * xv[r][i][1] + xv[r][i][2] * xv[r][i][2] + xv[r][i][3] * xv[r][i][3]; }
#pragma unroll
            for (int r = 0; r < 4; ++r) {
                const float rstd = rsqrtf(wave_sum(ss[r]) * (1.f / 1024.f) + EPS);
#pragma unroll
                for (int i = 0; i < 4; ++i) { const int k = i * 256 + lane * 4;
                    const f32x4 nw = *(const f32x4*)(p.norm_w + k), sh = *(const LAS f32x4*)(lmod + k), scl = *(const LAS f32x4*)(lmod + 1024 + k);
#pragma unroll
                    for (int e = 0; e < 4; ++e) xv[r][i][e] = xv[r][i][e] * rstd * nw[e] * (1.f + scl[e]) + sh[e];
                    u32x2 o; o[0] = pk_bf16(xv[r][i][0], xv[r][i][1]); o[1] = pk_bf16(xv[r][i][2], xv[r][i][3]);
                    *(u32x2*)(H + (size_t)(row + r) * D + k) = o; }
            }
            float myv[4] = {0.f, 0.f, 0.f, 0.f};
#pragma unroll 2
            for (int jj = 0; jj < 16; ++jj) { float a[4] = {0.f, 0.f, 0.f, 0.f};
#pragma unroll
                for (int i = 0; i < 4; ++i) { const f32x4 w = *(const LAS f32x4*)(wT + jj * 1024 + i * 256 + lane * 4);
#pragma unroll
                    for (int r = 0; r < 4; ++r) a[r] += xv[r][i][0] * w[0] + xv[r][i][1] * w[1] + xv[r][i][2] * w[2] + xv[r][i][3] * w[3]; }
#pragma unroll
                for (int r = 0; r < 4; ++r) { const float s = wave_sum(a[r]); if (lane == jj) myv[r] = s; } }
#pragma unroll
            for (int r = 0; r < 4; ++r) {
                if (lane < 8) BETA[(size_t)(row + r) * 8 + lane] = sigmoidf_(myv[r]);
                else if (lane < 16) { const float z = myv[r] + dtb; const float sp = z > 20.f ? z : log1pf(expf(z));
                    GG[(size_t)(row + r) * 8 + (lane - 8)] = -ea * sp; } }
        }
    }
}

constexpr int CP_SLOT_B = 8448;
constexpr int CP_BUF0 = 8 * CP_SLOT_B;
constexpr int CP_BUF_B = 17408 * 2 + 512;
constexpr int CP_LDS_TOTAL = CP_BUF0 + 2 * CP_BUF_B;
DI int permpos4(int t) { return 32 * (t >> 1) + 4 * (t & 1); }
DI int lrow_off(int a, int bq) { return bq == 0 ? (8 * a * a + 4 * a) : (8 * a * a + 8 * a + 4 * (bq - 1) * (a + 1)); }
struct CpRaw { unsigned q[11], k[11], v[11]; float g, beta; };
DI void cp_load_raw(CpRaw& R, const Params& p, int item, int wave, int lane) {
    const int bh = item >> 5, n = item & 31, b = bh >> 3, h = bh & 7, tl0 = wave * 8;
    const bf16_t* PA = (const bf16_t*)(p.ws + WS_R1);
#pragma unroll
    for (int r = 0; r < 11; ++r) { const int tb = n * 64 + tl0 - 3 + r;
        if (tb >= 0) { const bf16_t* rp = PA + (size_t)(b * SEQ + tb) * 3072 + h * 128 + 2 * lane;
            R.q[r] = __builtin_nontemporal_load((const unsigned*)rp); R.k[r] = __builtin_nontemporal_load((const unsigned*)(rp + 1024)); R.v[r] = __builtin_nontemporal_load((const unsigned*)(rp + 2048)); }
        else { R.q[r] = 0u; R.k[r] = 0u; R.v[r] = 0u; } }
    const size_t grow = (size_t)(b * SEQ + n * 64 + lane) * 8 + h;
    R.g = ((const float*)(p.ws + WS_G))[grow]; R.beta = ((const float*)(p.ws + WS_BETA))[grow];
}
DI void cp_conv(const unsigned (&raw)[11], const float* cw, float (&y0)[8], float (&y1)[8]) {
    float w0[4], w1[4];
#pragma unroll
    for (int j = 0; j < 4; ++j) { const f32x2 w = *(const f32x2*)(cw + j * 3072); w0[j] = w[0]; w1[j] = w[1]; }
#pragma unroll
    for (int e = 0; e < 8; ++e) { float a0 = 0.f, a1 = 0.f;
#pragma unroll
        for (int j = 0; j < 4; ++j) { a0 += w0[j] * bflo(raw[e + j]); a1 += w1[j] * bfhi(raw[e + j]); }
        y0[e] = siluf_(a0); y1[e] = siluf_(a1); }
}
DI void cp_stage_a1(const CpRaw& R, const Params& p, LAS unsigned char* lds, int item, int buf, int wave, int lane) {
    const int bh = item >> 5, h = bh & 7, tl0 = wave * 8;
    LAS bf16_t* qs = (LAS bf16_t*)(lds + CP_BUF0 + buf * CP_BUF_B); LAS bf16_t* ks = qs + 64 * 136;
    LAS float* gcs = (LAS float*)(lds + CP_BUF0 + buf * CP_BUF_B + 34816); LAS float* betas = gcs + 64;
    bf16_t* UT = (bf16_t*)p.out + (size_t)item * 8192;
    bf16_t* Wg = (bf16_t*)p.out + (size_t)MTOK * D + (size_t)item * 8192;
    bf16_t* QD = (bf16_t*)(p.ws + WS_QD) + (size_t)item * 8192;
    bf16_t* KDT = (bf16_t*)(p.ws + WS_KDT) + (size_t)item * 8192;
    float v = R.g;
#pragma unroll
    for (int o = 1; o < 64; o <<= 1) { const float u = __shfl_up(v, o); if (lane >= o) v += u; }
    const float gcl = __shfl(v, 63);
    float egc[8], bet[8], ekd[8];
#pragma unroll
    for (int e = 0; e < 8; ++e) { const float gce = __shfl(v, tl0 + e); egc[e] = __expf(gce); ekd[e] = __expf(gcl - gce); bet[e] = __shfl(R.beta, tl0 + e); }
    if (wave == 0) { gcs[lane] = v; betas[lane] = R.beta; if (lane == 63) ((float*)(p.ws + WS_GL))[item] = __expf(v); }
    float y0[8], y1[8];
    {
        cp_conv(R.q, p.conv_w + h * 128 + 2 * lane, y0, y1);
        { float pp[8], tt[8];
#pragma unroll
          for (int e = 0; e < 8; ++e) pp[e] = y0[e] * y0[e] + y1[e] * y1[e];
          reduce8(pp, tt, lane);
#pragma unroll
          for (int e = 0; e < 8; ++e) { const float ri = rsqrtf(tt[e] + EPS); y0[e] *= ri; y1[e] *= ri; } }
        const int dk = 2 * lane, loc = dk & 31, pp = 32 * (dk >> 5) + 8 * ((loc >> 2) & 3) + 4 * (loc >> 4) + (loc & 3);
#pragma unroll
        for (int e = 0; e < 8; ++e) { *(LAS unsigned*)(qs + (tl0 + e) * 136 + 2 * lane) = pk_bf16(y0[e], y1[e]);
            const float s = 0.08838834764831845f * egc[e];
            *(unsigned*)(QD + (tl0 + e) * 128 + pp) = pk_bf16(y0[e] * s, y1[e] * s); }
    }
    {
        cp_conv(R.k, p.conv_w + 1024 + h * 128 + 2 * lane, y0, y1);
        { float pp[8], tt[8];
#pragma unroll
          for (int e = 0; e < 8; ++e) pp[e] = y0[e] * y0[e] + y1[e] * y1[e];
          reduce8(pp, tt, lane);
#pragma unroll
          for (int e = 0; e < 8; ++e) { const float ri = rsqrtf(tt[e] + EPS); y0[e] *= ri; y1[e] *= ri; } }
#pragma unroll
        for (int e = 0; e < 8; ++e) *(LAS unsigned*)(ks + (tl0 + e) * 136 + 2 * lane) = pk_bf16(y0[e], y1[e]);
        float be[8];
#pragma unroll
        for (int e = 0; e < 8; ++e) be[e] = bet[e] * egc[e];
        u32x4 a, c;
        a[0] = pk_bf16(y0[0] * be[0], y0[1] * be[1]); a[1] = pk_bf16(y0[2] * be[2], y0[3] * be[3]); a[2] = pk_bf16(y0[4] * be[4], y0[5] * be[5]); a[3] = pk_bf16(y0[6] * be[6], y0[7] * be[7]);
        c[0] = pk_bf16(y1[0] * be[0], y1[1] * be[1]); c[1] = pk_bf16(y1[2] * be[2], y1[3] * be[3]); c[2] = pk_bf16(y1[4] * be[4], y1[5] * be[5]); c[3] = pk_bf16(y1[6] * be[6], y1[7] * be[7]);
        *(u32x4*)(Wg + (size_t)(wave * 128 + 2 * lane) * 8) = a; *(u32x4*)(Wg + (size_t)(wave * 128 + 2 * lane + 1) * 8) = c;
        u32x4 ka, kc;
        ka[0] = pk_bf16(y0[0] * ekd[0], y0[1] * ekd[1]); ka[1] = pk_bf16(y0[2] * ekd[2], y0[3] * ekd[3]); ka[2] = pk_bf16(y0[4] * ekd[4], y0[5] * ekd[5]); ka[3] = pk_bf16(y0[6] * ekd[6], y0[7] * ekd[7]);
        kc[0] = pk_bf16(y1[0] * ekd[0], y1[1] * ekd[1]); kc[1] = pk_bf16(y1[2] * ekd[2], y1[3] * ekd[3]); kc[2] = pk_bf16(y1[4] * ekd[4], y1[5] * ekd[5]); kc[3] = pk_bf16(y1[6] * ekd[6], y1[7] * ekd[7]);
        *(u32x4*)(KDT + (size_t)(wave * 128 + 2 * lane) * 8) = ka; *(u32x4*)(KDT + (size_t)(wave * 128 + 2 * lane + 1) * 8) = kc;
    }
    {
        cp_conv(R.v, p.conv_w + 2048 + h * 128 + 2 * lane, y0, y1);
        u32x4 a, c;
        a[0] = pk_bf16(y0[0] * bet[0], y0[1] * bet[1]); a[1] = pk_bf16(y0[2] * bet[2], y0[3] * bet[3]); a[2] = pk_bf16(y0[4] * bet[4], y0[5] * bet[5]); a[3] = pk_bf16(y0[6] * bet[6], y0[7] * bet[7]);
        c[0] = pk_bf16(y1[0] * bet[0], y1[1] * bet[1]); c[1] = pk_bf16(y1[2] * bet[2], y1[3] * bet[3]); c[2] = pk_bf16(y1[4] * bet[4], y1[5] * bet[5]); c[3] = pk_bf16(y1[6] * bet[6], y1[7] * bet[7]);
        *(u32x4*)(UT + (size_t)(wave * 128 + 2 * lane) * 8) = a; *(u32x4*)(UT + (size_t)(wave * 128 + 2 * lane + 1) * 8) = c;
    }
}
DI void cp_stage_a2(const Params& p, LAS unsigned char* lds, int item, int buf, int slot, int wave, int lane) {
    const int fr = lane & 15, fq = lane >> 4;
    LAS bf16_t* qs = (LAS bf16_t*)(lds + CP_BUF0 + buf * CP_BUF_B); LAS bf16_t* ks = qs + 64 * 136;
    LAS float* gcs = (LAS float*)(lds + CP_BUF0 + buf * CP_BUF_B + 34816); LAS float* betas = gcs + 64;
    LAS float* Lp = (LAS float*)(lds + slot * CP_SLOT_B);
    bf16_t* AG = (bf16_t*)(p.ws + WS_AG) + (size_t)item * 4096;
    if (wave < 4) {
#pragma unroll
        for (int tn = 0; tn < 4; ++tn) {
            f32x4 acc = {0.f, 0.f, 0.f, 0.f};
#pragma unroll
            for (int s = 0; s < 4; ++s) {
                const bf16x8 a = *(const LAS bf16x8*)(ks + (16 * wave + fr) * 136 + 32 * s + 8 * fq);
                const bf16x8 bb = *(const LAS bf16x8*)(ks + (16 * tn + fr) * 136 + 32 * s + 8 * fq);
                acc = MFMA16(a, bb, acc);
            }
            const int j = 16 * tn + fr; const float gj = gcs[j]; const int arow = 4 * wave + fq;
#pragma unroll
            for (int r = 0; r < 4; ++r) { const int i = 16 * wave + 4 * fq + r;
                if (i > j) Lp[lrow_off(arow, r) + j] = betas[i] * acc[r] * __expf(gcs[i] - gj); }
        }
    } else {
        const int s2 = (wave - 4) >> 1;
#pragma unroll
        for (int ti = 0; ti < 2; ++ti) {
            const int tn = 2 * ((wave - 4) & 1) + ti;
            const int i = 16 * tn + fr; const float gi = gcs[i];
            float v[8];
#pragma unroll
            for (int hh = 0; hh < 2; ++hh) {
                const int tm = 2 * s2 + hh;
                f32x4 acc = {0.f, 0.f, 0.f, 0.f};
#pragma unroll
                for (int s = 0; s < 4; ++s) {
                    const bf16x8 a = *(const LAS bf16x8*)(ks + (16 * tm + fr) * 136 + 32 * s + 8 * fq);
                    const bf16x8 bb = *(const LAS bf16x8*)(qs + (16 * tn + fr) * 136 + 32 * s + 8 * fq);
                    acc = MFMA16(a, bb, acc);
                }
#pragma unroll
                for (int r = 0; r < 4; ++r) { const int j = 16 * tm + 4 * fq + r;
                    v[4 * hh + r] = (i >= j) ? 0.08838834764831845f * acc[r] * __expf(gi - gcs[j]) : 0.f; }
            }
            u32x4 o; o[0] = pk_bf16(v[0], v[1]); o[1] = pk_bf16(v[2], v[3]); o[2] = pk_bf16(v[4], v[5]); o[3] = pk_bf16(v[6], v[7]);
            *(u32x4*)(AG + (size_t)((tn * 2 + s2) * 64 + lane) * 8) = o;
        }
    }
}
DI void cp_solve(LAS unsigned char* lds, int slot, int lane) {
    unsigned zero_v; asm volatile("v_mov_b32 %0, 0" : "=v"(zero_v));
    LAS float* Lp = (LAS float*)(lds + slot * CP_SLOT_B) + zero_v;
    float t[64];
#pragma unroll
    for (int i = 0; i < 64; ++i) t[i] = 0.f;
#pragma unroll
    for (int i = 0; i < 64; ++i) {
        LAS float* lp = Lp;
        if (i >= 2) asm volatile("" : "+v"(lp) : "v"(t[i - 2]));
        const int ro = (i & 3) == 0 ? (8 * (i >> 2) * (i >> 2) + 4 * (i >> 2)) : (8 * (i >> 2) * (i >> 2) + 8 * (i >> 2) + 4 * ((i & 3) - 1) * ((i >> 2) + 1));
        float s0 = (lane == i) ? 1.f : 0.f, s1 = 0.f;
#pragma unroll
        for (int j4 = 0; j4 < (i + 3) / 4; ++j4) {
            const f32x4 l = *(const LAS f32x4*)(lp + ro + j4 * 4);
            if (4 * j4 + 0 < i) s0 -= l[0] * t[4 * j4 + 0];
            if (4 * j4 + 1 < i) s1 -= l[1] * t[4 * j4 + 1];
            if (4 * j4 + 2 < i) s0 -= l[2] * t[4 * j4 + 2];
            if (4 * j4 + 3 < i) s1 -= l[3] * t[4 * j4 + 3];
        }
        t[i] = s0 + s1;
    }
    LAS unsigned char* Tb = lds + slot * CP_SLOT_B + zero_v;
#pragma unroll
    for (int i = 0; i < 64; ++i) *(LAS bf16_t*)(Tb + i * 128 + ((((lane >> 3) ^ ((i >> 1) & 7))) * 16) + (lane & 7) * 2) = f2bf(t[i]);
}
DI void chunk_prep_batch(const Params& p, LAS unsigned char* lds, int first, int stride, int cnt) {
    int tid = threadIdx.x; asm volatile("" : "+v"(tid));
    const int lane = tid & 63, wave = __builtin_amdgcn_readfirstlane(tid >> 6), fr = lane & 15, fq = lane >> 4;
    CpRaw R;
    cp_load_raw(R, p, first, wave, lane);
    for (int k = 0; k < cnt; ++k) {
        const int item = first + k * stride;
        cp_stage_a1(R, p, lds, item, k & 1, wave, lane);
        __syncthreads();
        if (k + 1 < cnt) cp_load_raw(R, p, item + stride, wave, lane);
        cp_stage_a2(p, lds, item, k & 1, k, wave, lane);
    }
    __syncthreads();
    if (wave < cnt) cp_solve(lds, wave, lane);
    __syncthreads();
    const int offK0 = fr * 128 + (((0 + fq) ^ (fr >> 1)) * 16), offK1 = fr * 128 + (((4 + fq) ^ (fr >> 1)) * 16);
    const int ws2 = wave >> 1, wt0 = 2 * (wave & 1);
    for (int half = 0; half < 2; ++half) {
        bf16x8 vbA[4][2], kbA[4][4];
#pragma unroll
        for (int kk = 0; kk < 4; ++kk) {
            const int k = half * 4 + kk;
            if (k < cnt) { const int item = first + k * stride;
                const bf16_t* UT = (const bf16_t*)p.out + (size_t)item * 8192; const bf16_t* Wg = (const bf16_t*)p.out + (size_t)MTOK * D + (size_t)item * 8192;
                vbA[kk][0] = *(const bf16x8*)(UT + (size_t)(fq * 128 + 16 * wave + fr) * 8); vbA[kk][1] = *(const bf16x8*)(UT + (size_t)((4 + fq) * 128 + 16 * wave + fr) * 8);
#pragma unroll
                for (int hh = 0; hh < 2; ++hh) { kbA[kk][2 * hh] = *(const bf16x8*)(Wg + (size_t)(fq * 128 + 16 * (2 * ws2 + hh) + fr) * 8); kbA[kk][2 * hh + 1] = *(const bf16x8*)(Wg + (size_t)((4 + fq) * 128 + 16 * (2 * ws2 + hh) + fr) * 8); } }
            else { vbA[kk][0] = vbA[kk][1] = kbA[kk][0] = kbA[kk][1] = kbA[kk][2] = kbA[kk][3] = (bf16x8){0, 0, 0, 0, 0, 0, 0, 0}; }
        }
        asm volatile("s_waitcnt vmcnt(0)" ::: "memory");
        __syncthreads();
#pragma unroll
        for (int kk = 0; kk < 4; ++kk) {
            const int k = half * 4 + kk;
            if (k >= cnt) break;
            const int item = first + k * stride;
            bf16_t* UT = (bf16_t*)p.out + (size_t)item * 8192; bf16_t* Wg = (bf16_t*)p.out + (size_t)MTOK * D + (size_t)item * 8192;
            LAS unsigned char* Tb = lds + k * CP_SLOT_B;
#pragma unroll
            for (int t4 = 0; t4 < 4; ++t4) {
                const bf16x8 t0 = *(const LAS bf16x8*)(Tb + t4 * 2048 + offK0), t1 = *(const LAS bf16x8*)(Tb + t4 * 2048 + offK1);
                f32x4 acc = {0.f, 0.f, 0.f, 0.f};
                acc = MFMA16(t0, vbA[kk][0], acc); acc = MFMA16(t1, vbA[kk][1], acc);
                u32x2 o; o[0] = pk_bf16(acc[0], acc[1]); o[1] = pk_bf16(acc[2], acc[3]);
                *(u32x2*)(UT + (size_t)((wave * 4 + t4) * 64 + lane) * 4) = o; }
#pragma unroll
            for (int ti = 0; ti < 2; ++ti) {
                const int tn = wt0 + ti;
                const bf16x8 t0 = *(const LAS bf16x8*)(Tb + tn * 2048 + offK0), t1 = *(const LAS bf16x8*)(Tb + tn * 2048 + offK1);
                f32x4 a0 = {0.f, 0.f, 0.f, 0.f}, a1 = {0.f, 0.f, 0.f, 0.f};
                a0 = MFMA16(kbA[kk][0], t0, a0); a0 = MFMA16(kbA[kk][1], t1, a0);
                a1 = MFMA16(kbA[kk][2], t0, a1); a1 = MFMA16(kbA[kk][3], t1, a1);
                u32x4 o; o[0] = pk_bf16(a0[0], a0[1]); o[1] = pk_bf16(a0[2], a0[3]); o[2] = pk_bf16(a1[0], a1[1]); o[3] = pk_bf16(a1[2], a1[3]);
                *(u32x4*)(Wg + (size_t)((tn * 4 + ws2) * 64 + lane) * 8) = o; }
        }
    }
    asm volatile("s_waitcnt vmcnt(0)" ::: "memory");
    __syncthreads();
}

constexpr int SC_W = 0, SC_QD = 16384, SC_KDT = 32768, SC_A = 49152, SC_BUF = 57344;
DI void scan_stage(LAS unsigned char* lds, int buf, const Params& p, int item, int wave, int lane) {
    const unsigned char* Wp = (const unsigned char*)((const bf16_t*)p.out + (size_t)MTOK * D + (size_t)item * 8192);
    const unsigned char* QDp = (const unsigned char*)((const bf16_t*)(p.ws + WS_QD) + (size_t)item * 8192);
    const unsigned char* KDTp = (const unsigned char*)((const bf16_t*)(p.ws + WS_KDT) + (size_t)item * 8192);
    const unsigned char* Ap = (const unsigned char*)((const bf16_t*)(p.ws + WS_AG) + (size_t)item * 4096);
    const int r4 = lane >> 4, c4 = lane & 15, r8 = lane >> 3, c8 = lane & 7;
#pragma unroll
    for (int k = 0; k < 7; ++k) {
        const int i = wave + 8 * k;
        const unsigned char* g; int loff;
        if (i < 16) { g = Wp + i * 1024 + lane * 16; loff = SC_W + i * 1024; }
        else if (i < 32) { const int ii = i & 15, r = 4 * ii + r4, c = c4 ^ (r & 15);
            g = QDp + r * 256 + c * 16; loff = SC_QD + ii * 1024; }
        else if (i < 48) { const int ii = i - 32; g = KDTp + ii * 1024 + lane * 16; loff = SC_KDT + ii * 1024; }
        else { const int ii = i - 48; g = Ap + ii * 1024 + lane * 16; loff = SC_A + ii * 1024; }
        __builtin_amdgcn_global_load_lds((const unsigned*)g, (LAS unsigned*)(lds + buf * SC_BUF + loff), 16, 0, 2);
    }
}
DI void dn_scan(const Params& p, LAS unsigned char* lds, int bh) {
    int tid = threadIdx.x; asm volatile("" : "+v"(tid));
    const int lane = tid & 63, wave = __builtin_amdgcn_readfirstlane(tid >> 6), fr = lane & 15, fq = lane >> 4;
    unsigned char* ws = p.ws;
    f32x4 S[8];
#pragma unroll
    for (int t = 0; t < 8; ++t) S[t] = (f32x4){0.f, 0.f, 0.f, 0.f};
    const float glv = ((const float*)(ws + WS_GL))[bh * 32 + (lane & 31)];
    int offW[4], offK[2];
#pragma unroll
    for (int s = 0; s < 4; ++s) offW[s] = fr * 256 + (((4 * s + fq) ^ fr) * 16);
#pragma unroll
    for (int s = 0; s < 2; ++s) offK[s] = fr * 128 + (((4 * s + fq) ^ (fr >> 1)) * 16);
    bf16_t* UT0 = (bf16_t*)p.out + (size_t)(bh * 32) * 8192 + (size_t)(wave * 4 * 64 + lane) * 4;
    scan_stage(lds, 0, p, bh * 32, wave, lane);
    u32x2 ucur[4];
#pragma unroll
    for (int tm = 0; tm < 4; ++tm) ucur[tm] = *(const u32x2*)(UT0 + 256 * tm);
    for (int n = 0; n < 32; ++n) {
        const int item = bh * 32 + n, buf = n & 1;
        asm volatile("s_waitcnt vmcnt(0)" ::: "memory");
        __syncthreads();
        u32x2 unext[4];
        if (n + 1 < 32) {
            scan_stage(lds, buf ^ 1, p, item + 1, wave, lane);
#pragma unroll
            for (int tm = 0; tm < 4; ++tm) unext[tm] = *(const u32x2*)(UT0 + (size_t)(n + 1) * 8192 + 256 * tm);
        } else {
#pragma unroll
            for (int tm = 0; tm < 4; ++tm) unext[tm] = (u32x2){0u, 0u};
        }
        const float gl = __builtin_bit_cast(float, __builtin_amdgcn_readlane(__builtin_bit_cast(int, glv), n));
        LAS unsigned char* B = lds + buf * SC_BUF;
        bf16_t* UTp = UT0 + (size_t)n * 8192;
        bf16x8 Sf[4];
#pragma unroll
        for (int s = 0; s < 4; ++s) Sf[s] = pack8(S[2 * s], S[2 * s + 1]);
        f32x4 vn[4];
#pragma unroll
        for (int tm = 0; tm < 4; ++tm) {
            f32x4 acc = {0.f, 0.f, 0.f, 0.f};
#pragma unroll
            for (int s = 0; s < 4; ++s) { const bf16x8 a = *(const LAS bf16x8*)(B + SC_W + (tm * 4 + s) * 1024 + lane * 16); acc = MFMA16(a, Sf[s], acc); }
            const u32x2 u = ucur[tm];
            vn[tm][0] = bflo(u[0]) - acc[0]; vn[tm][1] = bfhi(u[0]) - acc[1]; vn[tm][2] = bflo(u[1]) - acc[2]; vn[tm][3] = bfhi(u[1]) - acc[3];
        }
        bf16x8 Vf[2];
        Vf[0] = pack8(vn[0], vn[1]); Vf[1] = pack8(vn[2], vn[3]);
#pragma unroll
        for (int tm = 0; tm < 4; ++tm) {
            f32x4 acc = {0.f, 0.f, 0.f, 0.f};
#pragma unroll
            for (int s = 0; s < 4; ++s) { const bf16x8 a = *(const LAS bf16x8*)(B + SC_QD + tm * 4096 + offW[s]); acc = MFMA16(a, Sf[s], acc); }
#pragma unroll
            for (int s = 0; s < 2; ++s) { const bf16x8 a = *(const LAS bf16x8*)(B + SC_A + (tm * 2 + s) * 1024 + lane * 16); acc = MFMA16(a, Vf[s], acc); }
            u32x2 o; o[0] = pk_bf16(acc[0], acc[1]); o[1] = pk_bf16(acc[2], acc[3]);
            *(u32x2*)(UTp + 256 * tm) = o;
        }
#pragma unroll
        for (int t = 0; t < 8; ++t) {
            f32x4 acc = S[t] * gl;
#pragma unroll
            for (int s = 0; s < 2; ++s) {
                const u32x2 lo = *(const LAS u32x2*)(B + SC_KDT + ((4 * s + (fq >> 1)) * 128 + 16 * t + fr) * 16 + (fq & 1) * 8);
                const u32x2 hi = *(const LAS u32x2*)(B + SC_KDT + ((4 * s + 2 + (fq >> 1)) * 128 + 16 * t + fr) * 16 + (fq & 1) * 8);
                u32x4 av; av[0] = lo[0]; av[1] = lo[1]; av[2] = hi[0]; av[3] = hi[1];
                acc = MFMA16(__builtin_bit_cast(bf16x8, av), Vf[s], acc); }
            S[t] = acc;
        }
#pragma unroll
        for (int tm = 0; tm < 4; ++tm) ucur[tm] = unext[tm];
    }
    asm volatile("s_waitcnt vmcnt(0)" ::: "memory");
    __syncthreads();
}

constexpr int AT_VT = 32768;
struct AtRaw { u32x4 k[4], v[4]; bf16x8 q[2]; };
struct AtItem { int b, head, dil, res, blk; };
DI AtItem at_decode(int item) {
    AtItem I; const int sub = item & 15; I.head = (item >> 4) % 12; I.b = item / 192;
    const int grp = I.head >> 2; I.dil = grp == 0 ? 1 : (grp == 1 ? 4 : 16); const int nbk = 16 / I.dil;
    I.res = sub / nbk; I.blk = sub % nbk; return I;
}
DI void at_load(AtRaw& R, const Params& p, int item, int tid) {
    const AtItem I = at_decode(item);
    const bf16_t* PB = (const bf16_t*)(p.ws + WS_R1);
    const int kk = tid >> 1, half = tid & 1, lk = (I.blk - 1) * 128 + kk;
    if (lk >= 0) { const bf16_t* rp = PB + (size_t)(I.b * SEQ + lk * I.dil + I.res) * 2304 + I.head * 64 + half * 32;
#pragma unroll
        for (int i = 0; i < 4; ++i) { R.k[i] = *(const u32x4*)(rp + 768 + 8 * i); R.v[i] = *(const u32x4*)(rp + 1536 + 8 * i); }
    } else {
#pragma unroll
        for (int i = 0; i < 4; ++i) { R.k[i] = (u32x4){0u, 0u, 0u, 0u}; R.v[i] = (u32x4){0u, 0u, 0u, 0u}; }
    }
    const int lane = tid & 63, wave = tid >> 6, fr = lane & 15, fq = lane >> 4;
    const int tq = (I.blk * 128 + 16 * wave + fr) * I.dil + I.res;
    const bf16_t* qrow = PB + (size_t)(I.b * SEQ + tq) * 2304 + I.head * 64;
    R.q[0] = *(const bf16x8*)(qrow + 8 * fq); R.q[1] = *(const bf16x8*)(qrow + 32 + 8 * fq);
}
DI void at_store_lds(const AtRaw& R, LAS unsigned char* lds, int tid) {
    const int kk = tid >> 1, half = tid & 1;
#pragma unroll
    for (int i = 0; i < 4; ++i) { const int c = half * 4 + i; *(LAS u32x4*)(lds + kk * 128 + ((c ^ ((kk >> 1) & 7)) * 16)) = R.k[i]; }
#pragma unroll
    for (int i = 0; i < 4; ++i)
#pragma unroll
        for (int e = 0; e < 4; ++e) { const int d0 = half * 32 + 8 * i + 2 * e, d1 = d0 + 1;
            *(LAS bf16_t*)(lds + AT_VT + d0 * 512 + (((kk >> 2) ^ ((d0 & 15) << 2)) * 8) + (kk & 3) * 2) = (bf16_t)(R.v[i][e] & 0xffffu);
            *(LAS bf16_t*)(lds + AT_VT + d1 * 512 + (((kk >> 2) ^ ((d1 & 15) << 2)) * 8) + (kk & 3) * 2) = (bf16_t)(R.v[i][e] >> 16); }
}
DI void at_compute(const Params& p, LAS unsigned char* lds, int item, const bf16x8 (&Qf)[2], int tid) {
    const int lane = tid & 63, wave = __builtin_amdgcn_readfirstlane(tid >> 6), fr = lane & 15, fq = lane >> 4;
    const AtItem I = at_decode(item);
    bf16_t* OB = (bf16_t*)(p.ws + WS_OB);
    float* LSE = (float*)(p.ws + WS_LSE);
    const int iq = 16 * wave + fr;
    const int tq = (I.blk * 128 + iq) * I.dil + I.res;
    const int offK0 = fr * 128 + (((0 + fq) ^ (fr >> 1)) * 16), offK1 = fr * 128 + (((4 + fq) ^ (fr >> 1)) * 16);
    const int kb2 = wave >> 1;
    f32x4 sc[10];
    float mx = -3.0e38f;
#pragma unroll
    for (int i = 0; i < 10; ++i) {
        const int kt = 2 * kb2 + i;
        if (kt < wave || kt > wave + 8) { sc[i] = (f32x4){-3.0e38f, -3.0e38f, -3.0e38f, -3.0e38f}; continue; }
        const bf16x8 a0 = *(const LAS bf16x8*)(lds + kt * 2048 + offK0), a1 = *(const LAS bf16x8*)(lds + kt * 2048 + offK1);
        f32x4 acc = {0.f, 0.f, 0.f, 0.f};
        acc = MFMA16(a0, Qf[0], acc); acc = MFMA16(a1, Qf[1], acc);
#pragma unroll
        for (int r = 0; r < 4; ++r) { const int kk = 16 * kt + 4 * fq + r;
            const bool valid = (kk >= iq) && (kk <= iq + 128) && (I.blk > 0 || kk >= 128);
            const float v = valid ? acc[r] * 0.125f : -3.0e38f; acc[r] = v; mx = fmaxf(mx, v); }
        sc[i] = acc;
    }
    mx = fmaxf(mx, __shfl_xor(mx, 16)); mx = fmaxf(mx, __shfl_xor(mx, 32));
    float den = 0.f;
    const float mxl = mx * 1.4426950408889634f;
#pragma unroll
    for (int i = 0; i < 10; ++i)
#pragma unroll
        for (int r = 0; r < 4; ++r) { const float v = sc[i][r]; const float e = (v > -1.0e38f) ? __builtin_amdgcn_exp2f(v * 1.4426950408889634f - mxl) : 0.f; sc[i][r] = e; den += e; }
    den += __shfl_xor(den, 16); den += __shfl_xor(den, 32);
    const float rden = __builtin_amdgcn_rcpf(den);
    bf16_t* orow = OB + (size_t)(I.b * SEQ + tq) * 768 + I.head * 64;
    f32x4 oacc[4];
#pragma unroll
    for (int dt = 0; dt < 4; ++dt) oacc[dt] = (f32x4){0.f, 0.f, 0.f, 0.f};
#pragma unroll
    for (int si = 0; si < 5; ++si) {
        const int s = kb2 + si;
        const bf16x8 Pf = pack8(sc[2 * si], sc[2 * si + 1]);
#pragma unroll
        for (int dt = 0; dt < 4; ++dt) {
            const u32x2 lo = *(const LAS u32x2*)(lds + AT_VT + (16 * dt + fr) * 512 + (((8 * s + fq) ^ (fr << 2)) * 8));
            const u32x2 hi = *(const LAS u32x2*)(lds + AT_VT + (16 * dt + fr) * 512 + (((8 * s + 4 + fq) ^ (fr << 2)) * 8));
            u32x4 av; av[0] = lo[0]; av[1] = lo[1]; av[2] = hi[0]; av[3] = hi[1];
            oacc[dt] = MFMA16(__builtin_bit_cast(bf16x8, av), Pf, oacc[dt]);
        }
    }
#pragma unroll
    for (int dt = 0; dt < 4; ++dt) { u32x2 o; o[0] = pk_bf16(oacc[dt][0] * rden, oacc[dt][1] * rden); o[1] = pk_bf16(oacc[dt][2] * rden, oacc[dt][3] * rden);
        *(u32x2*)(orow + 16 * dt + 4 * fq) = o; }
    if (fq == 0) LSE[(size_t)(I.b * SEQ + tq) * 12 + I.head] = mx + __logf(den);
}
DI void attn_phase(const Params& p, LAS unsigned char* lds, int it, int it_end) {
    int tid = threadIdx.x; asm volatile("" : "+v"(tid));
    if (it >= it_end) return;
    AtRaw R;
    at_load(R, p, it, tid);
    for (; it < it_end; ++it) {
        at_store_lds(R, lds, tid);
        __syncthreads();
        bf16x8 Qf[2]; Qf[0] = R.q[0]; Qf[1] = R.q[1];
        if (it + 1 < it_end) at_load(R, p, it + 1, tid);
        at_compute(p, lds, it, Qf, tid);
        __syncthreads();
    }
}

DI void ya_phase(const Params& p) {
    int tid = threadIdx.x; asm volatile("" : "+v"(tid));
    const int lane = tid & 63, wave = tid >> 6;
    const bf16_t* Z = (const bf16_t*)p.out + (size_t)MTOK * D;
    bf16_t* YA = (bf16_t*)(p.ws + WS_YA);
    const float nw0 = p.dn_norm_w[lane], nw1 = p.dn_norm_w[lane + 64];
    for (int task = blockIdx.x * 8 + wave; task < 2048 * 8; task += gridDim.x * 8) {
        const int item = task >> 3, tg = task & 7;
        const int bh = item >> 5, n = item & 31, b = bh >> 3, h = bh & 7;
        const bf16_t* OA = (const bf16_t*)p.out + (size_t)item * 8192 + (size_t)(((lane >> 4) * 4 + (tg >> 1)) * 64 + 2 * (tg & 1) * 16 + (lane & 15)) * 4;
        const u32x2 p00 = __builtin_nontemporal_load((const u32x2*)OA), p01 = __builtin_nontemporal_load((const u32x2*)(OA + 64)), p10 = __builtin_nontemporal_load((const u32x2*)(OA + 4 * 4 * 256)), p11 = __builtin_nontemporal_load((const u32x2*)(OA + 4 * 4 * 256 + 64));
        u32x4 o0, o1; o0[0] = p00[0]; o0[1] = p00[1]; o0[2] = p01[0]; o0[3] = p01[1]; o1[0] = p10[0]; o1[1] = p10[1]; o1[2] = p11[0]; o1[3] = p11[1];
        const size_t row0 = (size_t)(b * SEQ + n * 64 + tg * 8);
        const bf16_t* zp = Z + row0 * 1024 + h * 128 + lane;
        bf16_t z0[8], z1[8];
#pragma unroll
        for (int e = 0; e < 8; ++e) { z0[e] = __builtin_nontemporal_load(zp + (size_t)e * 1024); z1[e] = __builtin_nontemporal_load(zp + (size_t)e * 1024 + 64); }
        float a0[8], a1[8];
#pragma unroll
        for (int e = 0; e < 4; ++e) { a0[2 * e] = bflo(o0[e]); a0[2 * e + 1] = bfhi(o0[e]); a1[2 * e] = bflo(o1[e]); a1[2 * e + 1] = bfhi(o1[e]); }
        bf16_t* yp = YA + row0 * D + h * 128 + lane;
#pragma unroll
        for (int e = 0; e < 8; ++e) {
            const float ss = wave_sum(a0[e] * a0[e] + a1[e] * a1[e]);
            const float rstd = rsqrtf(ss * (1.f / 128.f) + EPS);
            yp[(size_t)e * D] = f2bf(a0[e] * rstd * nw0 * bf2f(z0[e]));
            yp[(size_t)e * D + 64] = f2bf(a1[e] * rstd * nw1 * bf2f(z1[e]));
        }
    }
}
DI void yb_rows(const Params& p) {
    int tid = threadIdx.x; asm volatile("" : "+v"(tid));
    const int lane = tid & 63, wave = tid >> 6;
    bf16_t* OB = (bf16_t*)(p.ws + WS_OB);
    const bf16_t* Z = (const bf16_t*)(p.ws + WS_ZB);
    const float* LSE = (const float*)(p.ws + WS_LSE);
    const int c0 = lane, c1 = lane + 64;
    const int j0 = (c0 >> 3) & 3, j1 = (c1 >> 3) & 3, g0 = c0 >> 5, g1 = c1 >> 5;
    for (int rq = blockIdx.x * 8 + wave; rq < MTOK / 4; rq += gridDim.x * 8) {
        float l0[4][3], l1[4][3]; u32x4 o0[4], o1[4], z0[4], z1[4];
#pragma unroll
        for (int r = 0; r < 4; ++r) { const size_t row = (size_t)rq * 4 + r;
#pragma unroll
            for (int g = 0; g < 3; ++g) { l0[r][g] = LSE[row * 12 + 4 * g + j0]; l1[r][g] = LSE[row * 12 + 4 * g + j1]; }
            o0[r] = __builtin_nontemporal_load((const u32x4*)(OB + row * 768 + c0 * 8)); z0[r] = __builtin_nontemporal_load((const u32x4*)(Z + row * 768 + c0 * 8));
            if (c1 < 96) { o1[r] = __builtin_nontemporal_load((const u32x4*)(OB + row * 768 + c1 * 8)); z1[r] = __builtin_nontemporal_load((const u32x4*)(Z + row * 768 + c1 * 8)); }
            else { o1[r] = (u32x4){0u, 0u, 0u, 0u}; z1[r] = (u32x4){0u, 0u, 0u, 0u}; } }
#pragma unroll
        for (int r = 0; r < 4; ++r) { const size_t row = (size_t)rq * 4 + r;
            { const float m = fmaxf(l0[r][0], fmaxf(l0[r][1], l0[r][2]));
              const float e0 = __expf(l0[r][0] - m), e1 = __expf(l0[r][1] - m), e2 = __expf(l0[r][2] - m);
              const float w = (g0 == 0 ? e0 : (g0 == 1 ? e1 : e2)) * __builtin_amdgcn_rcpf(e0 + e1 + e2);
              u32x4 rr;
#pragma unroll
              for (int e = 0; e < 4; ++e) rr[e] = pk_bf16(bflo(o0[r][e]) * w * bflo(z0[r][e]), bfhi(o0[r][e]) * w * bfhi(z0[r][e]));
              *(u32x4*)(OB + row * 768 + c0 * 8) = rr; }
            if (c1 < 96) { const float m = fmaxf(l1[r][0], fmaxf(l1[r][1], l1[r][2]));
              const float e0 = __expf(l1[r][0] - m), e1 = __expf(l1[r][1] - m), e2 = __expf(l1[r][2] - m);
              const float w = (g1 == 0 ? e0 : (g1 == 1 ? e1 : e2)) * __builtin_amdgcn_rcpf(e0 + e1 + e2);
              u32x4 rr;
#pragma unroll
              for (int e = 0; e < 4; ++e) rr[e] = pk_bf16(bflo(o1[r][e]) * w * bflo(z1[r][e]), bfhi(o1[r][e]) * w * bfhi(z1[r][e]));
              *(u32x4*)(OB + row * 768 + c1 * 8) = rr; }
        }
    }
}

DI void final_norm(const Params& p) {
    int tid = threadIdx.x; asm volatile("" : "+v"(tid));
    const int lane = tid & 63, wave = tid >> 6;
    f32x4 w[4];
#pragma unroll
    for (int i = 0; i < 4; ++i) w[i] = *(const f32x4*)(p.fnw + i * 256 + lane * 4);
    for (int rq = blockIdx.x * 8 + wave; rq < MTOK / 4; rq += gridDim.x * 8) {
        f32x4 xv[4][4];
#pragma unroll
        for (int r = 0; r < 4; ++r)
#pragma unroll
            for (int i = 0; i < 4; ++i) xv[r][i] = *(const f32x4*)(p.out + ((size_t)rq * 4 + r) * D + i * 256 + lane * 4);
#pragma unroll
        for (int r = 0; r < 4; ++r) { float ss = 0.f;
#pragma unroll
            for (int i = 0; i < 4; ++i) ss += xv[r][i][0] * xv[r][i][0] + xv[r][i][1] * xv[r][i][1] + xv[r][i][2] * xv[r][i][2] + xv[r][i][3] * xv[r][i][3];
            ss = wave_sum(ss);
            const float rstd = rsqrtf(ss * (1.f / 1024.f) + EPS);
#pragma unroll
            for (int i = 0; i < 4; ++i) *(f32x4*)(p.out + ((size_t)rq * 4 + r) * D + i * 256 + lane * 4) = xv[r][i] * rstd * w[i]; }
    }
}

__global__ void __launch_bounds__(512, 2) fwd_megakernel(Params p) {
    extern __shared__ __attribute__((aligned(16))) unsigned char lds_raw[];
    LAS unsigned char* lds = (LAS unsigned char*)lds_raw;
    cg::grid_group grid = cg::this_grid();
    unsigned char* ws = p.ws;
    const int G = gridDim.x, bid = blockIdx.x;

    unsigned* barp = (unsigned*)(ws + WS_BAR);
    if (threadIdx.x < 4) ((LAS unsigned*)(lds + 138240))[threadIdx.x] = 0u;
    __syncthreads();
    XcdBarrier xb = xcd_barrier_post(barp, (volatile LAS unsigned*)(lds + 138240), (unsigned)G);
    if (p.ws == nullptr) grid.sync();
    phase0(p, lds);
    __syncthreads();
    phase1(p, lds);
    xcd_barrier(xb);
    {
        pg8::Gemm g{(const bf16_t*)(ws + WS_H), (const bf16_t*)(ws + WS_WT_IN), MTOK, 3072, 1024};
        pg8::StaticOrder S; S.init(MTOK, 3072, G, bid);
        pg8::EpiProj1<3072> E{(bf16_t*)(ws + WS_R1)};
        pg8::gemm_phase<pg8::EpiProj1<3072>, true>(lds, g, S, E);
    }
    xcd_barrier(xb);
    for (int base = bid; base < 2048; base += 8 * G) { int cnt = (2048 - base + G - 1) / G; if (cnt > 8) cnt = 8; chunk_prep_batch(p, lds, base, G, cnt); }
    xcd_barrier(xb);
    if (bid < 64) dn_scan(p, lds, bid);
    else {
        pg8::Gemm g{(const bf16_t*)(ws + WS_H), (const bf16_t*)(ws + WS_WT_IN) + (size_t)3072 * 1024, MTOK, 2304, 1024};
        pg8::StaticOrder S; S.init(MTOK, 2304, G - 64, bid - 64);
        pg8::EpiProj1<2304> E{(bf16_t*)(ws + WS_R1)};
        pg8::gemm_phase<pg8::EpiProj1<2304>, true>(lds, g, S, E);
        if (G == 256) {
            { XcdBarrier sb = xcd_barrier_post((unsigned*)(ws + WS_BAR + 32768), (volatile LAS unsigned*)(lds + 138248), 192u); xcd_barrier(sb); }
            attn_phase(p, lds, (bid - 64) * 4, (bid - 64) * 4 + 4);
        }
    }
    xcd_barrier(xb);
    {
        int a0, a1;
        if (G == 256) { if (bid < 192) { a0 = 768 + bid * 2; a1 = a0 + 2; } else { a0 = 1152 + (bid - 192) * 6; a1 = a0 + 6; } }
        else { const int per = (1536 + G - 1) / G; a0 = bid * per; a1 = a0 + per; if (a1 > 1536) a1 = 1536; }
        pg8::Gemm g{(const bf16_t*)(ws + WS_H), (const bf16_t*)(ws + WS_WT_IN) + (size_t)5376 * 1024, MTOK, 3840, 1024};
        pg8::StaticOrder S; S.init(MTOK, 3840, G, bid);
        pg8::EpiProjC E{ws, p.out};
        if (bid & 1) attn_phase(p, lds, a0, a1);
        pg8::gemm_phase<pg8::EpiProjC, true>(lds, g, S, E);
        if (!(bid & 1)) attn_phase(p, lds, a0, a1);
    }
    xcd_barrier(xb);
    ya_phase(p);
    yb_rows(p);
    xcd_barrier(xb);
    {
        pg8::StaticOrder S; S.init(MTOK, 1024, G, bid);
        pg8::Gemm g1{(const bf16_t*)(ws + WS_YA), (const bf16_t*)(ws + WS_WT_PA), MTOK, 1024, 1024};
        pg8::Gemm g2{(const bf16_t*)(ws + WS_OB), (const bf16_t*)(ws + WS_WT_PB), MTOK, 1024, 768};
        pg8::EpiMerge2 E{(bf16_t*)(ws + WS_H), (const bf16_t*)(ws + WS_R2)};
        pg8::Unit u; S.next(0, u);
        unsigned* pw = (unsigned*)(ws + WS_BAR + 49152) + u.pm * 64;
        panel_post_xcc(pw);
        pg8::gemm_phase2(lds, g1, g2, S, E);
        panel_handoff(pw);
    }
    {
        pg8::StaticOrder S; S.init(MTOK, 1024, G, bid);
        pg8::Gemm g{(const bf16_t*)(ws + WS_H), (const bf16_t*)(ws + WS_WT_O), MTOK, 1024, 1024};
        pg8::EpiOutNorm E{p.x, (const float*)(ws + WS_MOD), p.fnw, p.out, (float*)(ws + WS_RS), (unsigned*)(ws + WS_BAR + 16384)};
        pg8::gemm_phase(lds, g, S, E);
    }
}

extern "C" void kernel_launch(void* const* d_in, const int* in_sizes, int n_in, void* d_out, int out_size, void* d_ws, size_t ws_size, hipStream_t stream) {
    static int grid_blocks = 0;
    if (!grid_blocks) {
        int dev = 0, cus = 0, per_cu = 0;
        hipGetDevice(&dev);
        hipDeviceGetAttribute(&cus, hipDeviceAttributeMultiprocessorCount, dev);
        hipFuncSetAttribute((const void*)fwd_megakernel, hipFuncAttributeMaxDynamicSharedMemorySize, LDS_BYTES);
        hipOccupancyMaxActiveBlocksPerMultiprocessor(&per_cu, (const void*)fwd_megakernel, 512, LDS_BYTES);
        if (per_cu < 1) per_cu = 1;
        grid_blocks = cus;
        if (ws_size < WS_END) fprintf(stderr, "kernel_launch: workspace too small (%zu < %zu)\n", ws_size, (size_t)WS_END);
        (void)hipGetLastError();
    }
    Params p{};
    p.x = (const float*)d_in[0]; p.c = (const float*)d_in[1]; p.norm_w = (const float*)d_in[2]; p.ada_w = (const float*)d_in[3]; p.ada_b = (const float*)d_in[4];
    p.w_in = (const float*)d_in[5]; p.conv_w = (const float*)d_in[6]; p.a_log = (const float*)d_in[7]; p.dt_bias = (const float*)d_in[8]; p.dn_norm_w = (const float*)d_in[9];
    p.w_pa = (const float*)d_in[10]; p.w_pb = (const float*)d_in[11]; p.w_out = (const float*)d_in[12]; p.fnw = (const float*)d_in[13];
    p.out = (float*)d_out; p.ws = (unsigned char*)d_ws;
    (void)hipMemsetAsync((unsigned char*)d_ws + WS_BAR, 0, 65536, stream);
    void* args[] = {&p};
    hipError_t e = hipLaunchCooperativeKernel((const void*)fwd_megakernel, dim3(grid_blocks), dim3(512), args, LDS_BYTES, stream);
    if (e != hipSuccess) fprintf(stderr, "cooperative launch failed: %s (grid %d)\n", hipGetErrorString(e), grid_blocks);
}
```
